# Optimizing an MI355X kernel written in HIP

```python
import jax, jax.numpy as jnp
from jax import lax
import numpy as np

D_MODEL = 1024
BATCH = 2
SEQ = 8192
DEPTH = 4
DEC_BATCH = 128
DEC_SEQ = 1
PAST_LEN = 8192
PAGE_SIZE = 128

N_MIXERS = 2
N_ATTN_LAYERS = (DEPTH + N_MIXERS - 1) // N_MIXERS
N_RET_LAYERS = DEPTH // N_MIXERS
ATTN_HEAD_DIM = 64
ATTN_HEADS = D_MODEL // ATTN_HEAD_DIM
ATTN_KV_HEADS = 4
WINDOW = 128
ROPE_THETA = 10000.0
RET_KEY_DIM = 256
RET_HEADS = D_MODEL // RET_KEY_DIM
RET_VALUE_DIM = 2 * RET_KEY_DIM
RET_CHUNK = 128
D_FF = 256 * ((8 * D_MODEL // 3 + 255) // 256)
CONV_WIDTH = 3
LN_EPS = 1e-5
GN_EPS = 1e-5
DEEPNORM_ALPHA = (2.0 * DEPTH) ** 0.25
DEEPNORM_BETA = (8.0 * DEPTH) ** -0.25

kernel_name = 'swa_sink_retention_convffn_step'


def layer_norm(x, g, b):
    xf = x.astype(jnp.float32)
    mu = jnp.mean(xf, axis=-1, keepdims=True)
    var = jnp.mean(jnp.square(xf - mu), axis=-1, keepdims=True)
    return ((xf - mu) * lax.rsqrt(var + LN_EPS) * g + b).astype(x.dtype)


def rope(x, pos):
    half = x.shape[-1] // 2
    inv_freq = ROPE_THETA ** (-jnp.arange(half, dtype=jnp.float32) / half)
    ang = pos.astype(jnp.float32)[:, None] * inv_freq[None, :]
    cos = jnp.cos(ang)[:, None, :]
    sin = jnp.sin(ang)[:, None, :]
    xf = x.astype(jnp.float32)
    x1, x2 = xf[..., :half], xf[..., half:]
    return jnp.concatenate([x1 * cos - x2 * sin, x2 * cos + x1 * sin], axis=-1).astype(x.dtype)


def retention_rotate(x, pos):
    d = x.shape[-1]
    angle = 1.0 / (10000.0 ** jnp.linspace(0.0, 1.0, d // 2, dtype=jnp.float32))
    ang = pos.astype(jnp.float32)[:, None] * angle[None, :]
    cos = jnp.cos(ang)[:, None, :]
    sin = jnp.sin(ang)[:, None, :]
    x1, x2 = x[..., 0::2], x[..., 1::2]
    return jnp.stack([x1 * cos - x2 * sin, x2 * cos + x1 * sin], axis=-1).reshape(x.shape)


def sink_attention(q, k, v, qpos, kpos, sinks):
    lead = q.shape[:-3]
    tq = q.shape[-3]
    group = ATTN_HEADS // ATTN_KV_HEADS
    qg = q.reshape(*lead, tq, ATTN_KV_HEADS, group, ATTN_HEAD_DIM)
    s = jnp.einsum('...qkgd,...skd->...kgqs', qg, k).astype(jnp.float32) * (ATTN_HEAD_DIM ** -0.5)
    rel = qpos[..., :, None] - kpos[..., None, :]
    valid = (kpos[..., None, :] >= 0) & (rel >= 0) & (rel <= WINDOW)
    s = jnp.where(valid[..., None, None, :, :], s, -jnp.inf)
    sink = sinks.astype(jnp.float32).reshape(ATTN_KV_HEADS, group, 1, 1)
    m = jnp.maximum(jnp.max(s, axis=-1, keepdims=True), sink)
    p = jnp.exp(s - m)
    w = p / (jnp.sum(p, axis=-1, keepdims=True) + jnp.exp(sink - m))
    o = jnp.einsum('...kgqs,...skd->...qkgd', w.astype(v.dtype), v)
    return o.reshape(*lead, tq, ATTN_HEADS, ATTN_HEAD_DIM)


def attn_project(x, w_qkv):
    b, t, _ = x.shape
    qkv = x @ w_qkv
    nq = ATTN_HEADS * ATTN_HEAD_DIM
    nkv = ATTN_KV_HEADS * ATTN_HEAD_DIM
    q = qkv[..., :nq].reshape(b, t, ATTN_HEADS, ATTN_HEAD_DIM)
    k = qkv[..., nq:nq + nkv].reshape(b, t, ATTN_KV_HEADS, ATTN_HEAD_DIM)
    v = qkv[..., nq + nkv:].reshape(b, t, ATTN_KV_HEADS, ATTN_HEAD_DIM)
    return q, k, v


def swa_prompt(x, w_qkv, sinks, w_o):
    b, t, _ = x.shape
    nb = t // WINDOW
    pos = jnp.arange(t)
    q, k, v = attn_project(x, w_qkv)
    q = rope(q, pos)
    k = rope(k, pos)

    def band(z):
        zb = z.reshape(b, nb, WINDOW, ATTN_KV_HEADS, ATTN_HEAD_DIM)
        prev = jnp.concatenate([jnp.zeros_like(zb[:, :1]), zb[:, :-1]], axis=1)
        return jnp.concatenate([prev, zb], axis=2)

    qb = q.reshape(b, nb, WINDOW, ATTN_HEADS, ATTN_HEAD_DIM)
    qpos = pos.reshape(nb, WINDOW)
    kpos = qpos[:, :1] - WINDOW + jnp.arange(2 * WINDOW)[None, :]
    o = sink_attention(qb, band(k), band(v), qpos, kpos, sinks)
    out = o.reshape(b, t, ATTN_HEADS * ATTN_HEAD_DIM) @ w_o
    return out, k[:, t - WINDOW:], v[:, t - WINDOW:]


def swa_sample(x, k_buf, v_buf, w_qkv, sinks, w_o):
    b, t, _ = x.shape
    pos = PAST_LEN + jnp.arange(t)
    q, k, v = attn_project(x, w_qkv)
    q = rope(q, pos)
    k = rope(k, pos)
    kc = jnp.concatenate([k_buf.astype(k.dtype), k], axis=1)
    vc = jnp.concatenate([v_buf.astype(v.dtype), v], axis=1)
    kpos = PAST_LEN - WINDOW + jnp.arange(WINDOW + t)
    o = sink_attention(q, kc, vc, pos, kpos, sinks)
    out = o.reshape(b, t, ATTN_HEADS * ATTN_HEAD_DIM) @ w_o
    return out, kc[:, t:], vc[:, t:]


def retention_chunkwise(q, k, v, s0, chunk):
    b, t, h, dk = q.shape
    dv = v.shape[-1]
    nc = t // chunk
    log_gamma = jnp.log(1.0 - 2.0 ** (-5.0 - jnp.arange(RET_HEADS, dtype=jnp.float32)))
    idx = jnp.arange(chunk, dtype=jnp.float32)
    rel = idx[:, None] - idx[None, :]
    decay_in = jnp.where(rel[None] >= 0, jnp.exp(log_gamma[:, None, None] * jnp.maximum(rel, 0.0)[None]), 0.0)
    q_decay = jnp.exp(log_gamma[None, :] * (idx[:, None] + 1.0))
    k_decay = jnp.exp(log_gamma[None, :] * (chunk - 1.0 - idx[:, None]))
    chunk_decay = jnp.exp(log_gamma * chunk)
    qc = jnp.moveaxis(q.reshape(b, nc, chunk, h, dk), 1, 0)
    kc = jnp.moveaxis(k.reshape(b, nc, chunk, h, dk), 1, 0)
    vc = jnp.moveaxis(v.reshape(b, nc, chunk, h, dv), 1, 0)

    def step(s, inp):
        qi, ki, vi = inp
        inner = jnp.einsum('bihd,bjhd->bhij', qi, ki) * decay_in
        o = jnp.einsum('bhij,bjhe->bihe', inner, vi)
        o = o + jnp.einsum('bihd,bhde->bihe', qi, s) * q_decay[None, :, :, None]
        s = s * chunk_decay[None, :, None, None] + jnp.einsum('bjhd,bjhe->bhde', ki * k_decay[None, :, :, None], vi)
        return s, o

    s_new, o = lax.scan(step, s0, (qc, kc, vc))
    return jnp.moveaxis(o, 0, 1).reshape(b, t, h, dv), s_new


def retention_mixer(x, s0, pos, chunk, w_in, w_o):
    b, t, _ = x.shape
    hcat = x @ w_in
    nqk = RET_HEADS * RET_KEY_DIM
    nv = RET_HEADS * RET_VALUE_DIM
    q = hcat[..., :nqk].reshape(b, t, RET_HEADS, RET_KEY_DIM).astype(jnp.float32)
    k = hcat[..., nqk:2 * nqk].reshape(b, t, RET_HEADS, RET_KEY_DIM).astype(jnp.float32)
    v = hcat[..., 2 * nqk:2 * nqk + nv].reshape(b, t, RET_HEADS, RET_VALUE_DIM).astype(jnp.float32)
    g = hcat[..., 2 * nqk + nv:].astype(jnp.float32)
    q = retention_rotate(q, pos)
    k = retention_rotate(k, pos) * (RET_KEY_DIM ** -0.5)
    o, s_new = retention_chunkwise(q, k, v, s0.astype(jnp.float32), chunk)
    mu = jnp.mean(o, axis=-1, keepdims=True)
    var = jnp.mean(jnp.square(o - mu), axis=-1, keepdims=True)
    o = ((o - mu) * lax.rsqrt(var + GN_EPS)).reshape(b, t, nv)
    out = (jax.nn.silu(g) * o).astype(x.dtype) @ w_o
    return out, s_new


def conv_ffn(x, buf, w_in, conv_w, conv_b, w_out):
    t = x.shape[1]
    u = x @ w_in
    a, g = u[..., :D_FF], u[..., D_FF:]
    ext = jnp.concatenate([buf.astype(a.dtype), a], axis=1)
    c = conv_b + ext[:, 0:t] * conv_w[0]
    for j in range(1, CONV_WIDTH):
        c = c + ext[:, j:j + t] * conv_w[j]
    h = jax.nn.silu(c) * g
    return h @ w_out, ext[:, t:]


def setup_inputs(seed: int = 0) -> dict:
    key = jax.random.key(seed)
    ks = jax.random.split(key, 20)

    def nrm(k, shape, scale):
        return jax.random.normal(k, shape, jnp.float32) * scale

    qkv_dim = (ATTN_HEADS + 2 * ATTN_KV_HEADS) * ATTN_HEAD_DIM
    ret_in_dim = 2 * RET_HEADS * RET_KEY_DIM + 2 * RET_HEADS * RET_VALUE_DIM
    return {
        'x_prompt': nrm(ks[0], (BATCH, SEQ, D_MODEL), 1.0),
        'x_sample': nrm(ks[1], (DEC_BATCH, DEC_SEQ, D_MODEL), 1.0),
        'cache_k_win': nrm(ks[2], (N_ATTN_LAYERS, DEC_BATCH, WINDOW, ATTN_KV_HEADS, ATTN_HEAD_DIM), 1.0),
        'cache_v_win': nrm(ks[3], (N_ATTN_LAYERS, DEC_BATCH, WINDOW, ATTN_KV_HEADS, ATTN_HEAD_DIM), 1.0),
        'state_ret': nrm(ks[4], (N_RET_LAYERS, DEC_BATCH, RET_HEADS, RET_KEY_DIM, RET_VALUE_DIM), 0.1),
        'state_conv': nrm(ks[5], (DEPTH, DEC_BATCH, CONV_WIDTH - 1, D_FF), 1.0),
        'attn_w_qkv': nrm(ks[6], (N_ATTN_LAYERS, D_MODEL, qkv_dim), D_MODEL ** -0.5),
        'attn_sinks': nrm(ks[7], (N_ATTN_LAYERS, ATTN_HEADS), 0.5),
        'attn_w_o': nrm(ks[8], (N_ATTN_LAYERS, ATTN_HEADS * ATTN_HEAD_DIM, D_MODEL), DEEPNORM_BETA * (ATTN_HEADS * ATTN_HEAD_DIM) ** -0.5),
        'ret_w_in': nrm(ks[9], (N_RET_LAYERS, D_MODEL, ret_in_dim), D_MODEL ** -0.5),
        'ret_w_o': nrm(ks[10], (N_RET_LAYERS, RET_HEADS * RET_VALUE_DIM, D_MODEL), DEEPNORM_BETA * (RET_HEADS * RET_VALUE_DIM) ** -0.5),
        'ffn_w_in': nrm(ks[11], (DEPTH, D_MODEL, 2 * D_FF), D_MODEL ** -0.5),
        'ffn_conv_w': nrm(ks[12], (DEPTH, CONV_WIDTH, D_FF), CONV_WIDTH ** -0.5),
        'ffn_conv_b': nrm(ks[13], (DEPTH, D_FF), 0.02),
        'ffn_w_out': nrm(ks[14], (DEPTH, D_FF, D_MODEL), DEEPNORM_BETA * D_FF ** -0.5),
        'ln_mix_g': 1.0 + nrm(ks[15], (DEPTH, D_MODEL), 0.02),
        'ln_mix_b': nrm(ks[16], (DEPTH, D_MODEL), 0.02),
        'ln_ffn_g': 1.0 + nrm(ks[17], (DEPTH, D_MODEL), 0.02),
        'ln_ffn_b': nrm(ks[18], (DEPTH, D_MODEL), 0.02),
    }


def reference(x_prompt, x_sample, cache_k_win, cache_v_win, state_ret, state_conv,
              attn_w_qkv, attn_sinks, attn_w_o, ret_w_in, ret_w_o,
              ffn_w_in, ffn_conv_w, ffn_conv_b, ffn_w_out,
              ln_mix_g, ln_mix_b, ln_ffn_g, ln_ffn_b):
    xp, xs = x_prompt, x_sample
    bp, tp = xp.shape[0], xp.shape[1]
    ts = xs.shape[1]
    pos_p = jnp.arange(tp)
    pos_s = PAST_LEN + jnp.arange(ts)
    kp_l, vp_l, ks_l, vs_l, rp_l, rs_l, cp_l, cs_l = [], [], [], [], [], [], [], []
    for i in range(DEPTH):
        j = i // N_MIXERS
        if i % N_MIXERS == 0:
            mp, kp, vp = swa_prompt(xp, attn_w_qkv[j], attn_sinks[j], attn_w_o[j])
            ms, ksm, vsm = swa_sample(xs, cache_k_win[j], cache_v_win[j], attn_w_qkv[j], attn_sinks[j], attn_w_o[j])
            kp_l.append(kp)
            vp_l.append(vp)
            ks_l.append(ksm)
            vs_l.append(vsm)
        else:
            s0 = jnp.zeros((bp, RET_HEADS, RET_KEY_DIM, RET_VALUE_DIM), jnp.float32)
            mp, rp = retention_mixer(xp, s0, pos_p, RET_CHUNK, ret_w_in[j], ret_w_o[j])
            ms, rs = retention_mixer(xs, state_ret[j], pos_s, ts, ret_w_in[j], ret_w_o[j])
            rp_l.append(rp)
            rs_l.append(rs)
        xp = layer_norm(DEEPNORM_ALPHA * xp + mp, ln_mix_g[i], ln_mix_b[i])
        xs = layer_norm(DEEPNORM_ALPHA * xs + ms, ln_mix_g[i], ln_mix_b[i])
        buf0 = jnp.zeros((bp, CONV_WIDTH - 1, D_FF), xp.dtype)
        fp, cp = conv_ffn(xp, buf0, ffn_w_in[i], ffn_conv_w[i], ffn_conv_b[i], ffn_w_out[i])
        fs, cs = conv_ffn(xs, state_conv[i], ffn_w_in[i], ffn_conv_w[i], ffn_conv_b[i], ffn_w_out[i])
        cp_l.append(cp)
        cs_l.append(cs)
        xp = layer_norm(DEEPNORM_ALPHA * xp + fp, ln_ffn_g[i], ln_ffn_b[i])
        xs = layer_norm(DEEPNORM_ALPHA * xs + fs, ln_ffn_g[i], ln_ffn_b[i])
    return (xp, xs,
            jnp.stack(kp_l), jnp.stack(vp_l), jnp.stack(rp_l), jnp.stack(cp_l),
            jnp.stack(ks_l), jnp.stack(vs_l), jnp.stack(rs_l), jnp.stack(cs_l))
```

```cpp
#include <hip/hip_runtime.h>
#include <hip/hip_cooperative_groups.h>
#include <cstdio>
namespace cg = cooperative_groups;

#ifndef MEGA
#define MEGA 0
#endif

typedef unsigned short u16;
using bf16x8 = __attribute__((ext_vector_type(8))) short;
using f32x16 = __attribute__((ext_vector_type(16))) float;
#define DI __device__ __forceinline__
#define MFMA(a, b, c) __builtin_amdgcn_mfma_f32_32x32x16_bf16((a), (b), (c), 0, 0, 0)

constexpr int D = 1024, SEQ = 8192, MP = 16384, MS = 128, MT = MP + MS;
constexpr int DFF = 2816;
constexpr float ALPHA = 1.6817928305074290f;
constexpr float LN_EPS = 1e-5f, GN_EPS = 1e-5f;

constexpr size_t O_YP = 0;
constexpr size_t O_YS = O_YP + (size_t)MP * D;
constexpr size_t O_KWP = O_YS + (size_t)MS * D;
constexpr size_t O_VWP = O_KWP + 2ull * 2 * 128 * 256;
constexpr size_t O_RSP = O_VWP + 2ull * 2 * 128 * 256;
constexpr size_t O_CSP = O_RSP + 2ull * 2 * 4 * 256 * 512;
constexpr size_t O_KWS = O_CSP + 4ull * 2 * 2 * DFF;
constexpr size_t O_VWS = O_KWS + 2ull * 128 * 128 * 256;
constexpr size_t O_RSS = O_VWS + 2ull * 128 * 128 * 256;
constexpr size_t O_CSS = O_RSS + 2ull * 128 * 4 * 256 * 512;

constexpr size_t al(size_t x) { return (x + 255) & ~size_t(255); }
constexpr size_t WS_WQKV = 0;
constexpr size_t WS_WAO = WS_WQKV + 2ull * 1536 * 1024 * 2;
constexpr size_t WS_WRIN = WS_WAO + 2ull * 1024 * 1024 * 2;
constexpr size_t WS_WRO = WS_WRIN + 2ull * 6144 * 1024 * 2;
constexpr size_t WS_WFIN = WS_WRO + 2ull * 1024 * 2048 * 2;
constexpr size_t WS_WFOUT = WS_WFIN + 4ull * 5632 * 1024 * 2;
constexpr size_t WS_TROPE = WS_WFOUT + 4ull * 1024 * 2816 * 2;
constexpr size_t WS_TRET = WS_TROPE + al(2ull * 8193 * 32 * 4);
constexpr size_t WS_X = WS_TRET + al(2ull * 8193 * 128 * 4);
constexpr size_t WS_XB = WS_X + (size_t)MT * 1024 * 4;
constexpr size_t WS_Y = WS_XB + (size_t)MT * 1024 * 2;
constexpr size_t WS_ACT = WS_Y + (size_t)MT * 1024 * 4;
constexpr size_t WS_ACT2 = WS_ACT + 268435456ull;
constexpr size_t WS_US = WS_ACT2 + (size_t)MT * 2816 * 2;
constexpr size_t WS_SMP = WS_US + 134217728ull;
constexpr size_t WS_END = WS_SMP + 128ull * 4096 * 4;
constexpr size_t A_Q = WS_ACT;
constexpr size_t A_K = A_Q + (size_t)MT * 1024 * 2;
constexpr size_t A_VT = A_K + (size_t)MP * 256 * 2;
constexpr size_t R_Q = WS_ACT;
constexpr size_t R_K = R_Q + (size_t)MT * 1024 * 2;
constexpr size_t R_KT = R_K + (size_t)MT * 1024 * 2;
constexpr size_t R_VT = R_KT + 2ull * 1024 * 8192 * 2;
constexpr size_t R_GS = R_VT + 2ull * 2048 * 8192 * 2;
static_assert(R_GS + (size_t)MT * 2048 * 2 <= WS_ACT2, "act region");
constexpr size_t F_UA = WS_ACT;
constexpr size_t F_UG = F_UA + (size_t)MT * 2816 * 2;

struct Params {
  const float* in[19];
  float* out;
  unsigned char* ws;
};
enum { I_XP = 0, I_XS, I_CK, I_CV, I_SR, I_SC, I_WQKV, I_SINK, I_WAO, I_WRIN, I_WRO, I_WFIN, I_CW, I_CB, I_WFOUT, I_LMG, I_LMB, I_LFG, I_LFB };

DI u16 f2bf(float x) { return __builtin_bit_cast(u16, (__bf16)x); }
DI float bf2f(u16 v) { return __uint_as_float(((unsigned)v) << 16); }
DI unsigned pack2(float a, float b) { return (unsigned)f2bf(a) | ((unsigned)f2bf(b) << 16); }
DI int crow(int reg, int h) { return (reg & 3) + 8 * (reg >> 2) + 4 * h; }
DI float silu(float x) { return x / (1.f + __expf(-x)); }
DI float lg2gamma(int hh) { return (float)log2(1.0 - exp2(-5.0 - (double)hh)); }

DI void sincos_d(double x, float& s, float& c) {
  const double n = rint(x * 0.63661977236758134308);
  double r = fma(-n, 1.57079632673412561417e+00, x);
  r = fma(-n, 6.07710050650619224932e-11, r);
  const double r2 = r * r;
  double sp = 1.0 / 6227020800.0;
  sp = fma(sp, r2, -1.0 / 39916800.0); sp = fma(sp, r2, 1.0 / 362880.0); sp = fma(sp, r2, -1.0 / 5040.0);
  sp = fma(sp, r2, 1.0 / 120.0); sp = fma(sp, r2, -1.0 / 6.0); sp = fma(sp, r2, 1.0);
  const double sn = sp * r;
  double cp = -1.0 / 87178291200.0;
  cp = fma(cp, r2, 1.0 / 479001600.0); cp = fma(cp, r2, -1.0 / 3628800.0); cp = fma(cp, r2, 1.0 / 40320.0);
  cp = fma(cp, r2, -1.0 / 720.0); cp = fma(cp, r2, 1.0 / 24.0); cp = fma(cp, r2, -0.5); cp = fma(cp, r2, 1.0);
  const int q = ((int)n) & 3;
  const double ss = (q & 1) ? cp : sn, cc = (q & 1) ? sn : cp;
  s = (float)((q == 2 || q == 3) ? -ss : ss);
  c = (float)((q == 1 || q == 2) ? -cc : cc);
}

constexpr int LSTR = 72;
constexpr int TILE_E = 128 * LSTR;
constexpr int LDS_BYTES = 4 * TILE_E * 2;

DI void gemm_core(const u16* __restrict__ A, size_t lda, const u16* __restrict__ Bt, size_t ldb, int K, u16* lds, f32x16 (&acc)[2][2]) {
  const int t = threadIdx.x, lane = t & 63, w = t >> 6, wm = w >> 1, wn = w & 1, r = lane & 31, h = lane >> 5;
  u16* As = lds; u16* Bs = lds + 2 * TILE_E;
  const int lrow = t >> 3, lk = (t & 7) * 8;
  const u16* Ag = A + (size_t)lrow * lda + lk;
  const u16* Bg = Bt + (size_t)lrow * ldb + lk;
#define GLOAD(ko) \
  ra0 = *(const uint4*)(Ag + (ko)); ra1 = *(const uint4*)(Ag + (size_t)32 * lda + (ko)); ra2 = *(const uint4*)(Ag + (size_t)64 * lda + (ko)); ra3 = *(const uint4*)(Ag + (size_t)96 * lda + (ko)); \
  rb0 = *(const uint4*)(Bg + (ko)); rb1 = *(const uint4*)(Bg + (size_t)32 * ldb + (ko)); rb2 = *(const uint4*)(Bg + (size_t)64 * ldb + (ko)); rb3 = *(const uint4*)(Bg + (size_t)96 * ldb + (ko));
#define LSTORE(ad, bd) \
  *(uint4*)((ad) + (lrow) * LSTR + lk) = ra0; *(uint4*)((ad) + (lrow + 32) * LSTR + lk) = ra1; *(uint4*)((ad) + (lrow + 64) * LSTR + lk) = ra2; *(uint4*)((ad) + (lrow + 96) * LSTR + lk) = ra3; \
  *(uint4*)((bd) + (lrow) * LSTR + lk) = rb0; *(uint4*)((bd) + (lrow + 32) * LSTR + lk) = rb1; *(uint4*)((bd) + (lrow + 64) * LSTR + lk) = rb2; *(uint4*)((bd) + (lrow + 96) * LSTR + lk) = rb3;
  uint4 ra0, ra1, ra2, ra3, rb0, rb1, rb2, rb3;
  GLOAD(0)
#pragma unroll
  for (int a = 0; a < 2; ++a)
#pragma unroll
    for (int b = 0; b < 2; ++b)
#pragma unroll
      for (int i = 0; i < 16; ++i) acc[a][b][i] = 0.f;
  __syncthreads();
  LSTORE(As, Bs)
  __syncthreads();
  const int nk = K >> 6;
  for (int kt = 0; kt < nk; ++kt) {
    const int buf = kt & 1;
    const bool more = (kt + 1 < nk);
    if (more) { const int ko = (kt + 1) << 6; GLOAD(ko) }
    const u16* as = As + buf * TILE_E + (wm * 64 + r) * LSTR + h * 8;
    const u16* bs = Bs + buf * TILE_E + (wn * 64 + r) * LSTR + h * 8;
#pragma unroll
    for (int kk = 0; kk < 4; ++kk) {
      const bf16x8 a0 = *(const bf16x8*)(as + kk * 16), a1 = *(const bf16x8*)(as + 32 * LSTR + kk * 16);
      const bf16x8 b0 = *(const bf16x8*)(bs + kk * 16), b1 = *(const bf16x8*)(bs + 32 * LSTR + kk * 16);
      acc[0][0] = MFMA(a0, b0, acc[0][0]); acc[0][1] = MFMA(a0, b1, acc[0][1]);
      acc[1][0] = MFMA(a1, b0, acc[1][0]); acc[1][1] = MFMA(a1, b1, acc[1][1]);
    }
    if (more) { u16* ad = As + (buf ^ 1) * TILE_E; u16* bd = Bs + (buf ^ 1) * TILE_E; LSTORE(ad, bd) }
    __syncthreads();
  }
#undef GLOAD
#undef LSTORE
}

DI void epi_qkv(const Params& p, int j, f32x16 (&acc)[2][2], int mb, int nb, int lane) {
  const int r = lane & 31, h = lane >> 5, slot = nb >> 6;
  const float* cosT = (const float*)(p.ws + WS_TROPE); const float* sinT = cosT + 8193 * 32;
  const bool smp = mb >= MP;
  if (slot < 20) {
    u16* Q = (u16*)(p.ws + A_Q); u16* KB = (u16*)(p.ws + A_K);
#pragma unroll
    for (int mi = 0; mi < 2; ++mi)
#pragma unroll
      for (int reg = 0; reg < 16; ++reg) {
        const int row = mb + mi * 32 + crow(reg, h);
        const int pos = smp ? 8192 : (row & 8191);
        const float c = cosT[pos * 32 + r], s = sinT[pos * 32 + r];
        const float x1 = acc[mi][0][reg], x2 = acc[mi][1][reg];
        const float o1 = x1 * c - x2 * s, o2 = x2 * c + x1 * s;
        if (slot < 16) {
          Q[(size_t)row * 1024 + nb + r] = f2bf(o1 * 0.125f); Q[(size_t)row * 1024 + nb + 32 + r] = f2bf(o2 * 0.125f);
        } else {
          const int kvh = slot - 16;
          if (!smp) {
            KB[(size_t)row * 256 + kvh * 64 + r] = f2bf(o1); KB[(size_t)row * 256 + kvh * 64 + 32 + r] = f2bf(o2);
            if (pos >= 8064) { const int b = row >> 13; float* o = p.out + O_KWP + ((size_t)((j * 2 + b) * 128 + (pos - 8064)) * 4 + kvh) * 64; o[r] = o1; o[32 + r] = o2; }
          } else {
            const int b = row - MP; float* o = p.out + O_KWS + ((size_t)((j * 128 + b) * 128 + 127) * 4 + kvh) * 64; o[r] = o1; o[32 + r] = o2;
          }
        }
      }
  } else {
    const int kvh = slot - 20;
    if (!smp) {
      u16* VT = (u16*)(p.ws + A_VT);
      const int b = mb >> 13;
#pragma unroll
      for (int mi = 0; mi < 2; ++mi)
#pragma unroll
        for (int ni = 0; ni < 2; ++ni)
#pragma unroll
          for (int g4 = 0; g4 < 4; ++g4) {
            const int t0 = (mb & 8191) + mi * 32 + 8 * g4 + 4 * h, d = ni * 32 + r;
            uint2 v; v.x = pack2(acc[mi][ni][4 * g4], acc[mi][ni][4 * g4 + 1]); v.y = pack2(acc[mi][ni][4 * g4 + 2], acc[mi][ni][4 * g4 + 3]);
            *(uint2*)(VT + (size_t)(b * 256 + kvh * 64 + d) * 8192 + t0) = v;
            if (t0 >= 8064) {
#pragma unroll
              for (int q = 0; q < 4; ++q) p.out[O_VWP + ((size_t)((j * 2 + b) * 128 + (t0 + q - 8064)) * 4 + kvh) * 64 + d] = acc[mi][ni][4 * g4 + q];
            }
          }
    } else {
#pragma unroll
      for (int mi = 0; mi < 2; ++mi)
#pragma unroll
        for (int ni = 0; ni < 2; ++ni)
#pragma unroll
          for (int reg = 0; reg < 16; ++reg) {
            const int b = mb - MP + mi * 32 + crow(reg, h);
            p.out[O_VWS + ((size_t)((j * 128 + b) * 128 + 127) * 4 + kvh) * 64 + ni * 32 + r] = acc[mi][ni][reg];
          }
    }
  }
}

DI void epi_res(const Params& p, f32x16 (&acc)[2][2], int mb, int nb, int lane) {
  const int r = lane & 31, h = lane >> 5;
  const float* X = (const float*)(p.ws + WS_X); float* Y = (float*)(p.ws + WS_Y);
#pragma unroll
  for (int mi = 0; mi < 2; ++mi)
#pragma unroll
    for (int ni = 0; ni < 2; ++ni)
#pragma unroll
      for (int reg = 0; reg < 16; ++reg) {
        const size_t o = (size_t)(mb + mi * 32 + crow(reg, h)) * 1024 + nb + ni * 32 + r;
        Y[o] = ALPHA * X[o] + acc[mi][ni][reg];
      }
}

DI void epi_rin(const Params& p, int j, f32x16 (&acc)[2][2], int mb, int nb, int lane) {
  const int r = lane & 31, h = lane >> 5, slot = nb >> 6;
  const bool smp = mb >= MP;
  const int b = mb >> 13;
  if (slot < 32) {
    const bool isq = slot < 16;
    const int hh = (slot & 15) >> 2, cbase = nb & 255, ncol = nb & 1023;
    const float lg = lg2gamma(hh);
    const float* cosR = (const float*)(p.ws + WS_TRET); const float* sinR = cosR + 8193 * 128;
#pragma unroll
    for (int mi = 0; mi < 2; ++mi)
#pragma unroll
      for (int ni = 0; ni < 2; ++ni)
#pragma unroll
        for (int reg = 0; reg < 16; ++reg) {
          const int row = mb + mi * 32 + crow(reg, h);
          const int pos = smp ? 8192 : (row & 8191);
          const int pidx = (cbase + ni * 32 + r) >> 1;
          const float c = cosR[pos * 128 + pidx], s = sinR[pos * 128 + pidx];
          const float mine = acc[mi][ni][reg], other = __shfl_xor(mine, 1);
          const float rot = (r & 1) ? (mine * c + other * s) : (mine * c - other * s);
          const float e = (float)((smp ? 0 : (pos & 127)) + 1) * lg;
          acc[mi][ni][reg] = isq ? rot * exp2f(e) : rot * 0.0625f * exp2f(-e);
        }
    if (smp) {
      float* S = (float*)(p.ws + WS_SMP) + (isq ? 0 : 128 * 1024);
#pragma unroll
      for (int mi = 0; mi < 2; ++mi)
#pragma unroll
        for (int ni = 0; ni < 2; ++ni)
#pragma unroll
          for (int reg = 0; reg < 16; ++reg)
            S[(size_t)(mb - MP + mi * 32 + crow(reg, h)) * 1024 + ncol + ni * 32 + r] = acc[mi][ni][reg];
    } else {
      u16* N = (u16*)(p.ws + (isq ? R_Q : R_K));
#pragma unroll
      for (int mi = 0; mi < 2; ++mi)
#pragma unroll
        for (int ni = 0; ni < 2; ++ni)
#pragma unroll
          for (int reg = 0; reg < 16; ++reg)
            N[(size_t)(mb + mi * 32 + crow(reg, h)) * 1024 + ncol + ni * 32 + r] = f2bf(acc[mi][ni][reg]);
      if (!isq) {
        u16* KT = (u16*)(p.ws + R_KT);
#pragma unroll
        for (int mi = 0; mi < 2; ++mi)
#pragma unroll
          for (int ni = 0; ni < 2; ++ni)
#pragma unroll
            for (int g4 = 0; g4 < 4; ++g4) {
              const int t0 = (mb & 8191) + mi * 32 + 8 * g4 + 4 * h;
              uint2 v; v.x = pack2(acc[mi][ni][4 * g4], acc[mi][ni][4 * g4 + 1]); v.y = pack2(acc[mi][ni][4 * g4 + 2], acc[mi][ni][4 * g4 + 3]);
              *(uint2*)(KT + (size_t)(b * 1024 + ncol + ni * 32 + r) * 8192 + t0) = v;
            }
      }
    }
  } else if (slot < 64) {
    const int cv = nb - 2048;
    if (smp) {
      float* SV = (float*)(p.ws + WS_SMP) + 2 * 128 * 1024;
#pragma unroll
      for (int mi = 0; mi < 2; ++mi)
#pragma unroll
        for (int ni = 0; ni < 2; ++ni)
#pragma unroll
          for (int reg = 0; reg < 16; ++reg)
            SV[(size_t)(mb - MP + mi * 32 + crow(reg, h)) * 2048 + cv + ni * 32 + r] = acc[mi][ni][reg];
    } else {
      u16* VT = (u16*)(p.ws + R_VT);
#pragma unroll
      for (int mi = 0; mi < 2; ++mi)
#pragma unroll
        for (int ni = 0; ni < 2; ++ni)
#pragma unroll
          for (int g4 = 0; g4 < 4; ++g4) {
            const int t0 = (mb & 8191) + mi * 32 + 8 * g4 + 4 * h;
            uint2 v; v.x = pack2(acc[mi][ni][4 * g4], acc[mi][ni][4 * g4 + 1]); v.y = pack2(acc[mi][ni][4 * g4 + 2], acc[mi][ni][4 * g4 + 3]);
            *(uint2*)(VT + (size_t)(b * 2048 + cv + ni * 32 + r) * 8192 + t0) = v;
          }
    }
  } else {
    u16* GS = (u16*)(p.ws + R_GS);
    const int cg_ = nb - 4096;
#pragma unroll
    for (int mi = 0; mi < 2; ++mi)
#pragma unroll
      for (int ni = 0; ni < 2; ++ni)
#pragma unroll
        for (int reg = 0; reg < 16; ++reg)
          GS[(size_t)(mb + mi * 32 + crow(reg, h)) * 2048 + cg_ + ni * 32 + r] = f2bf(silu(acc[mi][ni][reg]));
  }
}

DI void epi_fin(const Params& p, int i, f32x16 (&acc)[2][2], int mb, int nb, int lane) {
  const int r = lane & 31, h = lane >> 5;
  const bool smp = mb >= MP;
  if (nb < DFF) {
    u16* UA = (u16*)(p.ws + F_UA);
#pragma unroll
    for (int mi = 0; mi < 2; ++mi)
#pragma unroll
      for (int ni = 0; ni < 2; ++ni)
#pragma unroll
        for (int reg = 0; reg < 16; ++reg) {
          const int row = mb + mi * 32 + crow(reg, h), col = nb + ni * 32 + r;
          const float v = acc[mi][ni][reg];
          UA[(size_t)row * DFF + col] = f2bf(v);
          if (smp) {
            p.out[O_CSS + ((size_t)(i * 128 + (row - MP)) * 2 + 1) * DFF + col] = v;
          } else {
            const int pos = row & 8191;
            if (pos >= 8190) p.out[O_CSP + ((size_t)(i * 2 + (row >> 13)) * 2 + (pos - 8190)) * DFF + col] = v;
          }
        }
  } else {
    u16* UG = (u16*)(p.ws + F_UG);
#pragma unroll
    for (int mi = 0; mi < 2; ++mi)
#pragma unroll
      for (int ni = 0; ni < 2; ++ni)
#pragma unroll
        for (int reg = 0; reg < 16; ++reg)
          UG[(size_t)(mb + mi * 32 + crow(reg, h)) * DFF + (nb - DFF) + ni * 32 + r] = f2bf(acc[mi][ni][reg]);
  }
}

enum { G_QKV, G_AO, G_RIN, G_RO, G_FIN, G_FOUT };
template <int G>
DI void gemm_phase(const Params& p, int layer, u16* lds) {
  const int j = layer >> 1;
  const u16* A; const u16* Bt; int K, N;
  if (G == G_QKV) { A = (const u16*)(p.ws + WS_XB); Bt = (const u16*)(p.ws + WS_WQKV) + (size_t)j * 1536 * 1024; K = 1024; N = 1536; }
  else if (G == G_AO) { A = (const u16*)(p.ws + WS_ACT2); Bt = (const u16*)(p.ws + WS_WAO) + (size_t)j * 1024 * 1024; K = 1024; N = 1024; }
  else if (G == G_RIN) { A = (const u16*)(p.ws + WS_XB); Bt = (const u16*)(p.ws + WS_WRIN) + (size_t)j * 6144 * 1024; K = 1024; N = 6144; }
  else if (G == G_RO) { A = (const u16*)(p.ws + WS_ACT2); Bt = (const u16*)(p.ws + WS_WRO) + (size_t)j * 1024 * 2048; K = 2048; N = 1024; }
  else if (G == G_FIN) { A = (const u16*)(p.ws + WS_XB); Bt = (const u16*)(p.ws + WS_WFIN) + (size_t)layer * 5632 * 1024; K = 1024; N = 5632; }
  else { A = (const u16*)(p.ws + WS_ACT2); Bt = (const u16*)(p.ws + WS_WFOUT) + (size_t)layer * 1024 * 2816; K = 2816; N = 1024; }
  const int ntn = N >> 7, ntiles = (MT >> 7) * ntn;
  const int lane = threadIdx.x & 63, w = threadIdx.x >> 6, wm = w >> 1, wn = w & 1;
  for (int tile = blockIdx.x; tile < ntiles; tile += gridDim.x) {
    const int tm = tile / ntn, tn = tile - tm * ntn;
    f32x16 acc[2][2];
    gemm_core(A + (size_t)tm * 128 * K, K, Bt + (size_t)tn * 128 * K, K, K, lds, acc);
    const int mb = tm * 128 + wm * 64, nb = tn * 128 + wn * 64;
    if (G == G_QKV) epi_qkv(p, j, acc, mb, nb, lane);
    else if (G == G_RIN) epi_rin(p, j, acc, mb, nb, lane);
    else if (G == G_FIN) epi_fin(p, layer, acc, mb, nb, lane);
    else epi_res(p, acc, mb, nb, lane);
  }
}

DI void transpose_job(const float* __restrict__ src, u16* __restrict__ dst, int K, int N, float* tl) {
  const int t = threadIdx.x;
  const int tn = N >> 6, ntiles = (K >> 6) * tn;
  for (int tile = blockIdx.x; tile < ntiles; tile += gridDim.x) {
    const int k0 = (tile / tn) << 6, n0 = (tile % tn) << 6;
    __syncthreads();
#pragma unroll
    for (int i = 0; i < 16; ++i) { const int k = (t >> 6) + 4 * i; tl[k * 65 + (t & 63)] = src[(size_t)(k0 + k) * N + n0 + (t & 63)]; }
    __syncthreads();
    const int n = t >> 2, kq = (t & 3) * 16;
    uint4 v0, v1;
    v0.x = pack2(tl[(kq + 0) * 65 + n], tl[(kq + 1) * 65 + n]); v0.y = pack2(tl[(kq + 2) * 65 + n], tl[(kq + 3) * 65 + n]);
    v0.z = pack2(tl[(kq + 4) * 65 + n], tl[(kq + 5) * 65 + n]); v0.w = pack2(tl[(kq + 6) * 65 + n], tl[(kq + 7) * 65 + n]);
    v1.x = pack2(tl[(kq + 8) * 65 + n], tl[(kq + 9) * 65 + n]); v1.y = pack2(tl[(kq + 10) * 65 + n], tl[(kq + 11) * 65 + n]);
    v1.z = pack2(tl[(kq + 12) * 65 + n], tl[(kq + 13) * 65 + n]); v1.w = pack2(tl[(kq + 14) * 65 + n], tl[(kq + 15) * 65 + n]);
    u16* o = dst + (size_t)(n0 + n) * K + k0 + kq;
    *(uint4*)o = v0; *(uint4*)(o + 8) = v1;
  }
}

DI void phase_prep(const Params& p, u16* lds) {
  float* tl = (float*)lds;
  for (int j = 0; j < 2; ++j) {
    transpose_job(p.in[I_WQKV] + (size_t)j * 1024 * 1536, (u16*)(p.ws + WS_WQKV) + (size_t)j * 1536 * 1024, 1024, 1536, tl);
    transpose_job(p.in[I_WAO] + (size_t)j * 1024 * 1024, (u16*)(p.ws + WS_WAO) + (size_t)j * 1024 * 1024, 1024, 1024, tl);
    transpose_job(p.in[I_WRIN] + (size_t)j * 1024 * 6144, (u16*)(p.ws + WS_WRIN) + (size_t)j * 6144 * 1024, 1024, 6144, tl);
    transpose_job(p.in[I_WRO] + (size_t)j * 2048 * 1024, (u16*)(p.ws + WS_WRO) + (size_t)j * 1024 * 2048, 2048, 1024, tl);
  }
  for (int i = 0; i < 4; ++i) {
    transpose_job(p.in[I_WFIN] + (size_t)i * 1024 * 5632, (u16*)(p.ws + WS_WFIN) + (size_t)i * 5632 * 1024, 1024, 5632, tl);
    transpose_job(p.in[I_WFOUT] + (size_t)i * 2816 * 1024, (u16*)(p.ws + WS_WFOUT) + (size_t)i * 1024 * 2816, 2816, 1024, tl);
  }
  const size_t gid = (size_t)blockIdx.x * 256 + threadIdx.x, gstride = (size_t)gridDim.x * 256;
  {
    float4* X = (float4*)(p.ws + WS_X); uint2* XB = (uint2*)(p.ws + WS_XB);
    const size_t nv = (size_t)MT * 256, npv = (size_t)MP * 256;
    for (size_t v = gid; v < nv; v += gstride) {
      const float4 x = (v < npv) ? ((const float4*)p.in[I_XP])[v] : ((const float4*)p.in[I_XS])[v - npv];
      X[v] = x; uint2 o; o.x = pack2(x.x, x.y); o.y = pack2(x.z, x.w); XB[v] = o;
    }
  }
  {
    float* cosT = (float*)(p.ws + WS_TROPE); float* sinT = cosT + 8193 * 32;
    for (size_t v = gid; v < 8193ull * 32; v += gstride) {
      const int pos = (int)(v >> 5), i = (int)(v & 31);
      const double inv = exp(-9.210340371976182736 * (double)i / 32.0);
      float s, c; sincos_d((double)pos * inv, s, c); cosT[v] = c; sinT[v] = s;
    }
    float* cosR = (float*)(p.ws + WS_TRET); float* sinR = cosR + 8193 * 128;
    for (size_t v = gid; v < 8193ull * 128; v += gstride) {
      const int pos = (int)(v >> 7), i = (int)(v & 127);
      const double inv = exp(-9.210340371976182736 * (double)i / 127.0);
      float s, c; sincos_d((double)pos * inv, s, c); cosR[v] = c; sinR[v] = s;
    }
  }
}

DI void attn_prompt_item(const Params& p, int j, int item, u16* lds) {
  const int g = item & 3, kvh = (item >> 2) & 3, qb = (item >> 4) & 63, b = item >> 10;
  const int head = kvh * 4 + g;
  const int t = threadIdx.x, lane = t & 63, w = t >> 6, r = lane & 31, h = lane >> 5;
  u16* Ks = lds;
  u16* Vts = lds + 256 * 72;
  const u16* Q = (const u16*)(p.ws + A_Q); const u16* KB = (const u16*)(p.ws + A_K); const u16* VT = (const u16*)(p.ws + A_VT);
  u16* OB = (u16*)(p.ws + WS_ACT2);
  const int tok0 = qb * 128 - 128;
  __syncthreads();
#pragma unroll
  for (int i = 0; i < 8; ++i) {
    const int c = t + 256 * i, key = c >> 3, part = c & 7, tok = tok0 + key;
    uint4 v = make_uint4(0, 0, 0, 0);
    if (tok >= 0) v = *(const uint4*)(KB + (size_t)(b * 8192 + tok) * 256 + kvh * 64 + part * 8);
    *(uint4*)(Ks + key * 72 + part * 8) = v;
  }
#pragma unroll
  for (int i = 0; i < 8; ++i) {
    const int c = t + 256 * i, d = c >> 5, part = c & 31, tok = tok0 + part * 8;
    uint4 v = make_uint4(0, 0, 0, 0);
    if (tok >= 0) v = *(const uint4*)(VT + (size_t)(b * 256 + kvh * 64 + d) * 8192 + tok);
    *(uint4*)(Vts + d * 264 + part * 8) = v;
  }
  const size_t qrow = (size_t)b * 8192 + qb * 128 + 32 * w + r;
  bf16x8 bq[4];
#pragma unroll
  for (int kk = 0; kk < 4; ++kk) bq[kk] = *(const bf16x8*)(Q + qrow * 1024 + head * 64 + kk * 16 + h * 8);
  __syncthreads();
  f32x16 S[5];
#pragma unroll
  for (int jb = 0; jb < 5; ++jb) {
#pragma unroll
    for (int i = 0; i < 16; ++i) S[jb][i] = 0.f;
    const u16* kp = Ks + (32 * (w + jb) + r) * 72 + h * 8;
#pragma unroll
    for (int kk = 0; kk < 4; ++kk) S[jb] = MFMA(*(const bf16x8*)(kp + kk * 16), bq[kk], S[jb]);
  }
  const float sink = p.in[I_SINK][j * 16 + head];
  float m = -INFINITY;
#pragma unroll
  for (int jb = 0; jb < 5; ++jb)
#pragma unroll
    for (int reg = 0; reg < 16; ++reg) {
      const int cr = crow(reg, h);
      const int rel = 128 + r - 32 * jb - cr;
      const bool valid = (rel >= 0) && (rel <= 128) && (qb > 0 || (32 * (w + jb) + cr) >= 128);
      const float s = valid ? S[jb][reg] : -INFINITY;
      S[jb][reg] = s; m = fmaxf(m, s);
    }
  m = fmaxf(m, __shfl_xor(m, 32));
  m = fmaxf(m, sink);
  float l = 0.f;
#pragma unroll
  for (int jb = 0; jb < 5; ++jb)
#pragma unroll
    for (int reg = 0; reg < 16; ++reg) { const float e = __expf(S[jb][reg] - m); S[jb][reg] = e; l += e; }
  l += __shfl_xor(l, 32);
  const float inv = 1.f / (l + __expf(sink - m));
  f32x16 O[2];
#pragma unroll
  for (int db = 0; db < 2; ++db)
#pragma unroll
    for (int i = 0; i < 16; ++i) O[db][i] = 0.f;
#pragma unroll
  for (int jb = 0; jb < 5; ++jb)
#pragma unroll
    for (int s = 0; s < 2; ++s) {
      uint4 pb;
      pb.x = pack2(S[jb][8 * s + 0], S[jb][8 * s + 1]); pb.y = pack2(S[jb][8 * s + 2], S[jb][8 * s + 3]);
      pb.z = pack2(S[jb][8 * s + 4], S[jb][8 * s + 5]); pb.w = pack2(S[jb][8 * s + 6], S[jb][8 * s + 7]);
      const bf16x8 bfrag = __builtin_bit_cast(bf16x8, pb);
#pragma unroll
      for (int db = 0; db < 2; ++db) {
        const u16* vp = Vts + (32 * db + r) * 264 + 32 * (w + jb) + 16 * s + 4 * h;
        const uint2 lo = *(const uint2*)vp, hi = *(const uint2*)(vp + 8);
        uint4 av; av.x = lo.x; av.y = lo.y; av.z = hi.x; av.w = hi.y;
        O[db] = MFMA(__builtin_bit_cast(bf16x8, av), bfrag, O[db]);
      }
    }
#pragma unroll
  for (int db = 0; db < 2; ++db)
#pragma unroll
    for (int g4 = 0; g4 < 4; ++g4) {
      uint2 v; v.x = pack2(O[db][4 * g4] * inv, O[db][4 * g4 + 1] * inv); v.y = pack2(O[db][4 * g4 + 2] * inv, O[db][4 * g4 + 3] * inv);
      *(uint2*)(OB + qrow * 1024 + head * 64 + 32 * db + 8 * g4 + 4 * h) = v;
    }
}

DI float wave_max(float v) {
#pragma unroll
  for (int o = 32; o >= 1; o >>= 1) v = fmaxf(v, __shfl_xor(v, o));
  return v;
}
DI float wave_sum(float v) {
#pragma unroll
  for (int o = 32; o >= 1; o >>= 1) v += __shfl_xor(v, o);
  return v;
}

DI void attn_sample_item(const Params& p, int j, int item, u16* lds) {
  const int kvh = item & 3, b = item >> 2;
  const int t = threadIdx.x, lane = t & 63, g = t >> 6;
  float* Kc = (float*)lds;
  float* Vc = Kc + 129 * 65;
  float* qs = Vc + 129 * 65;
  float* ps = qs + 256;
  const float* ck = p.in[I_CK] + (size_t)(j * 128 + b) * 128 * 256;
  const float* cv = p.in[I_CV] + (size_t)(j * 128 + b) * 128 * 256;
  float* ok = p.out + O_KWS + (size_t)(j * 128 + b) * 128 * 256;
  float* ov = p.out + O_VWS + (size_t)(j * 128 + b) * 128 * 256;
  __syncthreads();
  for (int idx = t; idx < 128 * 64; idx += 256) {
    const int wq = idx >> 6, d = idx & 63;
    const float kv = ck[wq * 256 + kvh * 64 + d], vv = cv[wq * 256 + kvh * 64 + d];
    Kc[wq * 65 + d] = kv; Vc[wq * 65 + d] = vv;
    if (wq >= 1) { ok[(wq - 1) * 256 + kvh * 64 + d] = kv; ov[(wq - 1) * 256 + kvh * 64 + d] = vv; }
  }
  if (t < 64) { Kc[128 * 65 + t] = ok[127 * 256 + kvh * 64 + t]; Vc[128 * 65 + t] = ov[127 * 256 + kvh * 64 + t]; }
  qs[t] = bf2f(((const u16*)(p.ws + A_Q))[(size_t)(MP + b) * 1024 + (kvh * 4 + g) * 64 + lane]);
  __syncthreads();
  const float sink = p.in[I_SINK][j * 16 + kvh * 4 + g];
  float s0 = 0.f, s1 = 0.f, s2 = 0.f;
#pragma unroll 8
  for (int d = 0; d < 64; ++d) {
    const float q = qs[g * 64 + d];
    s0 += q * Kc[lane * 65 + d]; s1 += q * Kc[(lane + 64) * 65 + d]; s2 += q * Kc[128 * 65 + d];
  }
  float m = fmaxf(fmaxf(s0, s1), s2);
  m = fmaxf(wave_max(m), sink);
  const float e0 = __expf(s0 - m), e1 = __expf(s1 - m), e2 = __expf(s2 - m);
  float l = wave_sum(e0 + e1) + e2;
  const float inv = 1.f / (l + __expf(sink - m));
  ps[g * 132 + lane] = e0 * inv; ps[g * 132 + 64 + lane] = e1 * inv;
  if (lane == 0) ps[g * 132 + 128] = e2 * inv;
  __syncthreads();
  float o = 0.f;
#pragma unroll 4
  for (int k = 0; k < 129; ++k) o += ps[g * 132 + k] * Vc[k * 65 + lane];
  ((u16*)(p.ws + WS_ACT2))[(size_t)(MP + b) * 1024 + (kvh * 4 + g) * 64 + lane] = f2bf(o);
}

DI void phase_attn(const Params& p, int layer, u16* lds) {
  const int j = layer >> 1;
  for (int item = blockIdx.x; item < 2048 + 512; item += gridDim.x) {
    if (item < 2048) attn_prompt_item(p, j, item, lds);
    else attn_sample_item(p, j, item - 2048, lds);
  }
}

DI void phase_ln(const Params& p, const float* __restrict__ gam, const float* __restrict__ bet, bool last) {
  const int lane = threadIdx.x & 63;
  const int wid = blockIdx.x * 4 + (threadIdx.x >> 6), nw = gridDim.x * 4;
  const float* Y = (const float*)(p.ws + WS_Y);
  float* X = (float*)(p.ws + WS_X); u16* XB = (u16*)(p.ws + WS_XB);
  float4 gv[4], bv[4];
#pragma unroll
  for (int i = 0; i < 4; ++i) { gv[i] = ((const float4*)gam)[lane + 64 * i]; bv[i] = ((const float4*)bet)[lane + 64 * i]; }
  for (int row = wid; row < MT; row += nw) {
    const float4* y = (const float4*)(Y + (size_t)row * 1024);
    float4 v[4];
#pragma unroll
    for (int i = 0; i < 4; ++i) v[i] = y[lane + 64 * i];
    float s = 0.f;
#pragma unroll
    for (int i = 0; i < 4; ++i) s += v[i].x + v[i].y + v[i].z + v[i].w;
    const float mu = wave_sum(s) * (1.f / 1024.f);
    float q = 0.f;
#pragma unroll
    for (int i = 0; i < 4; ++i) { v[i].x -= mu; v[i].y -= mu; v[i].z -= mu; v[i].w -= mu; q += v[i].x * v[i].x + v[i].y * v[i].y + v[i].z * v[i].z + v[i].w * v[i].w; }
    const float rs = rsqrtf(wave_sum(q) * (1.f / 1024.f) + LN_EPS);
    float4* xo = last ? (float4*)(p.out + (row < MP ? O_YP + (size_t)row * 1024 : O_YS + (size_t)(row - MP) * 1024)) : (float4*)(X + (size_t)row * 1024);
#pragma unroll
    for (int i = 0; i < 4; ++i) {
      float4 o;
      o.x = v[i].x * rs * gv[i].x + bv[i].x; o.y = v[i].y * rs * gv[i].y + bv[i].y;
      o.z = v[i].z * rs * gv[i].z + bv[i].z; o.w = v[i].w * rs * gv[i].w + bv[i].w;
      xo[lane + 64 * i] = o;
      if (!last) { uint2 ob; ob.x = pack2(o.x, o.y); ob.y = pack2(o.z, o.w); *(uint2*)(XB + (size_t)row * 1024 + (lane + 64 * i) * 4) = ob; }
    }
  }
}

DI void phase_conv(const Params& p, int i) {
  const u16* UA = (const u16*)(p.ws + F_UA); const u16* UG = (const u16*)(p.ws + F_UG);
  u16* H = (u16*)(p.ws + WS_ACT2);
  const float* cw = p.in[I_CW] + (size_t)i * 3 * DFF; const float* cb = p.in[I_CB] + (size_t)i * DFF;
  const float* sc = p.in[I_SC] + (size_t)i * 128 * 2 * DFF;
  const size_t gid = (size_t)blockIdx.x * 256 + threadIdx.x, gstride = (size_t)gridDim.x * 256;
  const size_t nv = (size_t)MT * 352;
  for (size_t v = gid; v < nv; v += gstride) {
    const int row = (int)(v / 352), f = (int)(v % 352) * 8;
    float a0[8], a1[8], a2[8], gg[8];
    {
      const uint4 x = *(const uint4*)(UA + (size_t)row * DFF + f); const uint4 y = *(const uint4*)(UG + (size_t)row * DFF + f);
      const unsigned xs[4] = {x.x, x.y, x.z, x.w}, ys[4] = {y.x, y.y, y.z, y.w};
#pragma unroll
      for (int k = 0; k < 4; ++k) { a0[2 * k] = __uint_as_float(xs[k] << 16); a0[2 * k + 1] = __uint_as_float(xs[k] & 0xffff0000u); gg[2 * k] = __uint_as_float(ys[k] << 16); gg[2 * k + 1] = __uint_as_float(ys[k] & 0xffff0000u); }
    }
    if (row < MP) {
      const int pos = row & 8191;
      uint4 x1 = make_uint4(0, 0, 0, 0), x2 = make_uint4(0, 0, 0, 0);
      if (pos >= 1) x1 = *(const uint4*)(UA + (size_t)(row - 1) * DFF + f);
      if (pos >= 2) x2 = *(const uint4*)(UA + (size_t)(row - 2) * DFF + f);
      const unsigned s1[4] = {x1.x, x1.y, x1.z, x1.w}, s2[4] = {x2.x, x2.y, x2.z, x2.w};
#pragma unroll
      for (int k = 0; k < 4; ++k) { a1[2 * k] = __uint_as_float(s1[k] << 16); a1[2 * k + 1] = __uint_as_float(s1[k] & 0xffff0000u); a2[2 * k] = __uint_as_float(s2[k] << 16); a2[2 * k + 1] = __uint_as_float(s2[k] & 0xffff0000u); }
    } else {
      const int b = row - MP;
      const float* s0p = sc + (size_t)(b * 2 + 0) * DFF + f; const float* s1p = sc + (size_t)(b * 2 + 1) * DFF + f;
      float* o0 = p.out + O_CSS + ((size_t)(i * 128 + b) * 2 + 0) * DFF + f;
#pragma unroll
      for (int k = 0; k < 8; ++k) { a2[k] = s0p[k]; a1[k] = s1p[k]; o0[k] = a1[k]; }
    }
    unsigned ho[4];
#pragma unroll
    for (int k = 0; k < 4; ++k) {
      float hv[2];
#pragma unroll
      for (int u = 0; u < 2; ++u) {
        const int e = 2 * k + u;
        const float c = cb[f + e] + a2[e] * cw[f + e] + a1[e] * cw[DFF + f + e] + a0[e] * cw[2 * DFF + f + e];
        hv[u] = silu(c) * gg[e];
      }
      ho[k] = pack2(hv[0], hv[1]);
    }
    *(uint4*)(H + (size_t)row * DFF + f) = make_uint4(ho[0], ho[1], ho[2], ho[3]);
  }
}

DI void ret_u_tile(const Params& p, int tile, u16* lds) {
  const int td = tile & 1, te = (tile >> 1) & 3, hh = (tile >> 3) & 3, c = (tile >> 5) & 63, b = tile >> 11;
  const u16* VT = (const u16*)(p.ws + R_VT) + (size_t)(b * 2048 + hh * 512 + te * 128) * 8192 + c * 128;
  const u16* KT = (const u16*)(p.ws + R_KT) + (size_t)(b * 1024 + hh * 256 + td * 128) * 8192 + c * 128;
  f32x16 acc[2][2];
  gemm_core(VT, 8192, KT, 8192, 128, lds, acc);
  const int lane = threadIdx.x & 63, w = threadIdx.x >> 6, wm = w >> 1, wn = w & 1, r = lane & 31, h = lane >> 5;
  u16* UT = (u16*)(p.ws + WS_US) + (size_t)((b * 64 + c) * 4 + hh) * 512 * 256;
#pragma unroll
  for (int mi = 0; mi < 2; ++mi)
#pragma unroll
    for (int ni = 0; ni < 2; ++ni)
#pragma unroll
      for (int reg = 0; reg < 16; ++reg)
        UT[(size_t)(te * 128 + wm * 64 + mi * 32 + crow(reg, h)) * 256 + td * 128 + wn * 64 + ni * 32 + r] = f2bf(acc[mi][ni][reg]);
}

DI float block_sum(float v, float* red) {
  v = wave_sum(v);
  __syncthreads();
  if ((threadIdx.x & 63) == 0) red[threadIdx.x >> 6] = v;
  __syncthreads();
  return red[0] + red[1] + red[2] + red[3];
}

DI void ret_sample_item(const Params& p, int j, int item, u16* lds) {
  const int hh = item & 3, b = item >> 2, t = threadIdx.x;
  float* qs = (float*)lds; float* ks = qs + 256; float* red = ks + 256;
  const float* SQ = (const float*)(p.ws + WS_SMP); const float* SK = SQ + 128 * 1024; const float* SV = SK + 128 * 1024;
  __syncthreads();
  const float qv = SQ[(size_t)b * 1024 + hh * 256 + t], kv = SK[(size_t)b * 1024 + hh * 256 + t];
  qs[t] = qv; ks[t] = kv;
  const float2 vv = *(const float2*)(SV + (size_t)b * 2048 + hh * 512 + 2 * t);
  const float qk = block_sum(qv * kv, red);
  const float gamma = 1.f - exp2f(-5.f - (float)hh);
  const float2* s0 = (const float2*)(p.in[I_SR] + ((size_t)((j * 128 + b) * 4 + hh) * 256) * 512) + t;
  float2* so = (float2*)(p.out + O_RSS + ((size_t)((j * 128 + b) * 4 + hh) * 256) * 512) + t;
  float o0 = 0.f, o1 = 0.f;
#pragma unroll 8
  for (int d = 0; d < 256; ++d) {
    const float2 s = s0[(size_t)d * 256];
    const float q = qs[d], k = ks[d];
    o0 += q * s.x; o1 += q * s.y;
    float2 n; n.x = gamma * (s.x + k * vv.x); n.y = gamma * (s.y + k * vv.y);
    so[(size_t)d * 256] = n;
  }
  o0 += qk * vv.x; o1 += qk * vv.y;
  const float mu = block_sum(o0 + o1, red) * (1.f / 512.f);
  const float d0 = o0 - mu, d1 = o1 - mu;
  const float var = block_sum(d0 * d0 + d1 * d1, red) * (1.f / 512.f);
  const float rs = rsqrtf(var + GN_EPS);
  const u16* GS = (const u16*)(p.ws + R_GS) + (size_t)(MP + b) * 2048 + hh * 512 + 2 * t;
  u16* OB = (u16*)(p.ws + WS_ACT2) + (size_t)(MP + b) * 2048 + hh * 512 + 2 * t;
  *(unsigned*)OB = pack2(d0 * rs * bf2f(GS[0]), d1 * rs * bf2f(GS[1]));
}

DI void phase_ret_u(const Params& p, int layer, u16* lds) {
  const int j = layer >> 1;
  for (int item = blockIdx.x; item < 4096 + 512; item += gridDim.x) {
    if (item < 4096) ret_u_tile(p, item, lds);
    else ret_sample_item(p, j, item - 4096, lds);
  }
}

DI void phase_ret_scan(const Params& p, int layer) {
  const int j = layer >> 1;
  u16* UT = (u16*)(p.ws + WS_US);
  const size_t cstride = 4ull * 512 * 256;
  for (int v = blockIdx.x * 256 + threadIdx.x; v < 131072; v += gridDim.x * 256) {
    const int d8 = v & 31, e = (v >> 5) & 511, hh = (v >> 14) & 3, b = v >> 16;
    u16* base = UT + ((size_t)(b * 64 * 4 + hh) * 512 + e) * 256 + d8 * 8;
    const float cd = exp2f(128.f * lg2gamma(hh));
    float s[8];
#pragma unroll
    for (int k = 0; k < 8; ++k) s[k] = 0.f;
#pragma unroll 4
    for (int c = 0; c < 64; ++c) {
      const uint4 u = *(const uint4*)(base + c * cstride);
      uint4 o; o.x = pack2(s[0], s[1]); o.y = pack2(s[2], s[3]); o.z = pack2(s[4], s[5]); o.w = pack2(s[6], s[7]);
      *(uint4*)(base + c * cstride) = o;
      const unsigned us[4] = {u.x, u.y, u.z, u.w};
#pragma unroll
      for (int k = 0; k < 4; ++k) {
        s[2 * k] = cd * (s[2 * k] + __uint_as_float(us[k] << 16));
        s[2 * k + 1] = cd * (s[2 * k + 1] + __uint_as_float(us[k] & 0xffff0000u));
      }
    }
    float* o = p.out + O_RSP + ((size_t)((j * 2 + b) * 4 + hh) * 256 + d8 * 8) * 512 + e;
#pragma unroll
    for (int k = 0; k < 8; ++k) o[(size_t)k * 512] = s[k];
  }
}

DI void ret_out_item(const Params& p, int item, u16* lds) {
  const int rh = item & 1, hh = (item >> 1) & 3, c = (item >> 3) & 63, b = item >> 9;
  const int t = threadIdx.x, lane = t & 63, w = t >> 6, r = lane & 31, h = lane >> 5;
  const size_t row0 = (size_t)b * 8192 + c * 128, trow0 = row0 + rh * 64;
  const u16* QR = (const u16*)(p.ws + R_Q); const u16* KR = (const u16*)(p.ws + R_K);
  const u16* VT = (const u16*)(p.ws + R_VT) + (size_t)(b * 2048 + hh * 512) * 8192 + c * 128;
  const u16* PT = (const u16*)(p.ws + WS_US) + (size_t)((b * 64 + c) * 4 + hh) * 512 * 256;
  u16* inner = lds;
  float* red1 = (float*)lds;
  float* red2 = red1 + 64 * 132;
  float* smu = red2 + 64 * 132;
  float* srs = smu + 64;
  __syncthreads();
  {
    f32x16 T[2];
#pragma unroll
    for (int ib = 0; ib < 2; ++ib)
#pragma unroll
      for (int i = 0; i < 16; ++i) T[ib][i] = 0.f;
    if (rh == 1 || w < 2) {
      const u16* kp = KR + (row0 + 32 * w + r) * 1024 + hh * 256 + h * 8;
      const u16* qp0 = QR + (trow0 + r) * 1024 + hh * 256 + h * 8;
      const u16* qp1 = qp0 + 32 * 1024;
#pragma unroll 4
      for (int ks = 0; ks < 16; ++ks) {
        const bf16x8 a = *(const bf16x8*)(kp + ks * 16);
        T[0] = MFMA(a, *(const bf16x8*)(qp0 + ks * 16), T[0]);
        T[1] = MFMA(a, *(const bf16x8*)(qp1 + ks * 16), T[1]);
      }
    }
#pragma unroll
    for (int ib = 0; ib < 2; ++ib)
#pragma unroll
      for (int g4 = 0; g4 < 4; ++g4) {
        const int il = 32 * ib + r, ig = rh * 64 + il, j0 = 32 * w + 8 * g4 + 4 * h;
        const float v0 = (j0 + 0 <= ig) ? T[ib][4 * g4 + 0] : 0.f, v1 = (j0 + 1 <= ig) ? T[ib][4 * g4 + 1] : 0.f;
        const float v2 = (j0 + 2 <= ig) ? T[ib][4 * g4 + 2] : 0.f, v3 = (j0 + 3 <= ig) ? T[ib][4 * g4 + 3] : 0.f;
        uint2 v; v.x = pack2(v0, v1); v.y = pack2(v2, v3);
        *(uint2*)(inner + il * 136 + j0) = v;
      }
  }
  __syncthreads();
  f32x16 acc[2][4];
#pragma unroll
  for (int rb = 0; rb < 2; ++rb)
#pragma unroll
    for (int eb = 0; eb < 4; ++eb)
#pragma unroll
      for (int i = 0; i < 16; ++i) acc[rb][eb][i] = 0.f;
  {
    const u16* ap = inner + r * 136 + h * 8;
    const u16* bp = VT + (size_t)(128 * w + r) * 8192 + h * 8;
    const int nks = rh ? 8 : 4;
    for (int ks = 0; ks < nks; ++ks) {
      const bf16x8 a0 = *(const bf16x8*)(ap + ks * 16), a1 = *(const bf16x8*)(ap + 32 * 136 + ks * 16);
#pragma unroll
      for (int eb = 0; eb < 4; ++eb) {
        const bf16x8 bb = *(const bf16x8*)(bp + (size_t)(32 * eb) * 8192 + ks * 16);
        acc[0][eb] = MFMA(a0, bb, acc[0][eb]); acc[1][eb] = MFMA(a1, bb, acc[1][eb]);
      }
    }
  }
  {
    const u16* ap = QR + (trow0 + r) * 1024 + hh * 256 + h * 8;
    const u16* bp = PT + (size_t)(128 * w + r) * 256 + h * 8;
#pragma unroll 2
    for (int ks = 0; ks < 16; ++ks) {
      const bf16x8 a0 = *(const bf16x8*)(ap + ks * 16), a1 = *(const bf16x8*)(ap + 32 * 1024 + ks * 16);
#pragma unroll
      for (int eb = 0; eb < 4; ++eb) {
        const bf16x8 bb = *(const bf16x8*)(bp + (size_t)(32 * eb) * 256 + ks * 16);
        acc[0][eb] = MFMA(a0, bb, acc[0][eb]); acc[1][eb] = MFMA(a1, bb, acc[1][eb]);
      }
    }
  }
  __syncthreads();
#pragma unroll
  for (int rb = 0; rb < 2; ++rb)
#pragma unroll
    for (int reg = 0; reg < 16; ++reg) {
      float s1 = 0.f, s2 = 0.f;
#pragma unroll
      for (int eb = 0; eb < 4; ++eb) { const float v = acc[rb][eb][reg]; s1 += v; s2 += v * v; }
      const int row = 32 * rb + crow(reg, h);
      red1[row * 132 + w * 32 + r] = s1; red2[row * 132 + w * 32 + r] = s2;
    }
  __syncthreads();
  {
    const int row = t >> 2, q = t & 3;
    float s1 = 0.f, s2 = 0.f;
#pragma unroll
    for (int k = 0; k < 32; ++k) { s1 += red1[row * 132 + q * 32 + k]; s2 += red2[row * 132 + q * 32 + k]; }
    s1 += __shfl_xor(s1, 1); s2 += __shfl_xor(s2, 1);
    s1 += __shfl_xor(s1, 2); s2 += __shfl_xor(s2, 2);
    const float mu = s1 * (1.f / 512.f);
    const float var = fmaxf(s2 * (1.f / 512.f) - mu * mu, 0.f);
    if (q == 0) { smu[row] = mu; srs[row] = rsqrtf(var + GN_EPS); }
  }
  __syncthreads();
  const u16* GS = (const u16*)(p.ws + R_GS); u16* OB = (u16*)(p.ws + WS_ACT2);
#pragma unroll
  for (int rb = 0; rb < 2; ++rb)
#pragma unroll
    for (int reg = 0; reg < 16; ++reg) {
      const int row = 32 * rb + crow(reg, h);
      const float mu = smu[row], rs = srs[row];
      const size_t o = (trow0 + row) * 2048 + hh * 512 + 128 * w + r;
#pragma unroll
      for (int eb = 0; eb < 4; ++eb) OB[o + 32 * eb] = f2bf((acc[rb][eb][reg] - mu) * rs * bf2f(GS[o + 32 * eb]));
    }
}

enum { PH_PREP = 0, PH_QKV, PH_ATTN, PH_AO, PH_RIN, PH_RETU, PH_SCAN, PH_RETO, PH_RO, PH_LNM, PH_FIN, PH_CONV, PH_FOUT, PH_LNF };

DI void run_phase(const Params& p, int ph, int layer, u16* lds) {
  switch (ph) {
    case PH_PREP: phase_prep(p, lds); break;
    case PH_QKV: gemm_phase<G_QKV>(p, layer, lds); break;
    case PH_ATTN: phase_attn(p, layer, lds); break;
    case PH_AO: gemm_phase<G_AO>(p, layer, lds); break;
    case PH_RIN: gemm_phase<G_RIN>(p, layer, lds); break;
    case PH_RETU: phase_ret_u(p, layer, lds); break;
    case PH_SCAN: phase_ret_scan(p, layer); break;
    case PH_RETO: for (int item = blockIdx.x; item < 1024; item += gridDim.x) ret_out_item(p, item, lds); break;
    case PH_RO: gemm_phase<G_RO>(p, layer, lds); break;
    case PH_LNM: phase_ln(p, p.in[I_LMG] + layer * 1024, p.in[I_LMB] + layer * 1024, false); break;
    case PH_FIN: gemm_phase<G_FIN>(p, layer, lds); break;
    case PH_CONV: phase_conv(p, layer); break;
    case PH_FOUT: gemm_phase<G_FOUT>(p, layer, lds); break;
    case PH_LNF: phase_ln(p, p.in[I_LFG] + layer * 1024, p.in[I_LFB] + layer * 1024, layer == 3); break;
  }
}

#if !MEGA
__global__ void __launch_bounds__(256, 2) k_phase(Params p, int ph, int layer) {
  __shared__ __attribute__((aligned(16))) u16 lds[LDS_BYTES / 2];
  run_phase(p, ph, layer, lds);
}

#else
__global__ void __launch_bounds__(256, 2) k_mega(Params p) {
  __shared__ __attribute__((aligned(16))) u16 lds[LDS_BYTES / 2];
  cg::grid_group grid = cg::this_grid();
  run_phase(p, PH_PREP, 0, lds);
  grid.sync();
  for (int layer = 0; layer < 4; ++layer) {
    if ((layer & 1) == 0) {
      run_phase(p, PH_QKV, layer, lds); grid.sync();
      run_phase(p, PH_ATTN, layer, lds); grid.sync();
      run_phase(p, PH_AO, layer, lds); grid.sync();
    } else {
      run_phase(p, PH_RIN, layer, lds); grid.sync();
      run_phase(p, PH_RETU, layer, lds); grid.sync();
      run_phase(p, PH_SCAN, layer, lds); grid.sync();
      run_phase(p, PH_RETO, layer, lds); grid.sync();
      run_phase(p, PH_RO, layer, lds); grid.sync();
    }
    run_phase(p, PH_LNM, layer, lds); grid.sync();
    run_phase(p, PH_FIN, layer, lds); grid.sync();
    run_phase(p, PH_CONV, layer, lds); grid.sync();
    run_phase(p, PH_FOUT, layer, lds); grid.sync();
    run_phase(p, PH_LNF, layer, lds);
    if (layer < 3) grid.sync();
  }
}

#endif

extern "C" void kernel_launch(void* const* d_in, const int* in_sizes, int n_in, void* d_out, int out_size, void* d_ws, size_t ws_size, hipStream_t stream) {
  static int grid_blocks = 0;
  if (!grid_blocks) {
    int dev = 0, cus = 0, per_cu = 0;
    (void)hipGetDevice(&dev);
    (void)hipDeviceGetAttribute(&cus, hipDeviceAttributeMultiprocessorCount, dev);
#if MEGA
    (void)hipOccupancyMaxActiveBlocksPerMultiprocessor(&per_cu, k_mega, 256, 0);
#else
    (void)hipOccupancyMaxActiveBlocksPerMultiprocessor(&per_cu, k_phase, 256, 0);
#endif
    if (per_cu < 1) per_cu = 1;
    if (per_cu > 2) per_cu = 2;
    grid_blocks = cus * per_cu;
    if (n_in != 19 || ws_size < WS_END) fprintf(stderr, "kernel_launch: unexpected n_in %d or ws %zu < %zu\n", n_in, ws_size, (size_t)WS_END);
  }
  Params p{};
  for (int i = 0; i < 19; ++i) p.in[i] = (const float*)d_in[i];
  p.out = (float*)d_out; p.ws = (unsigned char*)d_ws;
#if MEGA
  void* args[] = {&p};
  hipError_t e = hipLaunchCooperativeKernel((void*)k_mega, dim3(grid_blocks), dim3(256), args, 0, stream);
  if (e != hipSuccess) fprintf(stderr, "cooperative launch failed: %s (grid %d)\n", hipGetErrorString(e), grid_blocks);
#else
  auto L = [&](int ph, int layer) { hipLaunchKernelGGL(k_phase, dim3(grid_blocks), dim3(256), 0, stream, p, ph, layer); };
  L(PH_PREP, 0);
  for (int layer = 0; layer < 4; ++layer) {
    if ((layer & 1) == 0) { L(PH_QKV, layer); L(PH_ATTN, layer); L(PH_AO, layer); }
    else { L(PH_RIN, layer); L(PH_RETU, layer); L(PH_SCAN, layer); L(PH_RETO, layer); L(PH_RO, layer); }
    L(PH_LNM, layer); L(PH_FIN, layer); L(PH_CONV, layer); L(PH_FOUT, layer); L(PH_LNF, layer);
  }
#endif
}
```

```cpp
#include <hip/hip_runtime.h>
#include <hip/hip_cooperative_groups.h>
#include <cstdio>
namespace cg = cooperative_groups;

#ifndef MEGA
#define MEGA 1
#endif

typedef unsigned short u16;
using f32x4 = __attribute__((ext_vector_type(4))) float;
using bf16x8 = __attribute__((ext_vector_type(8))) short;
using f32x16 = __attribute__((ext_vector_type(16))) float;
#define DI __device__ __forceinline__
#define MFMA(a, b, c) __builtin_amdgcn_mfma_f32_32x32x16_bf16((a), (b), (c), 0, 0, 0)

constexpr int D = 1024, SEQ = 8192, MP = 16384, MS = 128, MT = MP + MS;
constexpr int DFF = 2816;
constexpr float ALPHA = 1.6817928305074290f;
constexpr float LN_EPS = 1e-5f, GN_EPS = 1e-5f;

constexpr size_t O_YP = 0;
constexpr size_t O_YS = O_YP + (size_t)MP * D;
constexpr size_t O_KWP = O_YS + (size_t)MS * D;
constexpr size_t O_VWP = O_KWP + 2ull * 2 * 128 * 256;
constexpr size_t O_RSP = O_VWP + 2ull * 2 * 128 * 256;
constexpr size_t O_CSP = O_RSP + 2ull * 2 * 4 * 256 * 512;
constexpr size_t O_KWS = O_CSP + 4ull * 2 * 2 * DFF;
constexpr size_t O_VWS = O_KWS + 2ull * 128 * 128 * 256;
constexpr size_t O_RSS = O_VWS + 2ull * 128 * 128 * 256;
constexpr size_t O_CSS = O_RSS + 2ull * 128 * 4 * 256 * 512;

constexpr size_t al(size_t x) { return (x + 255) & ~size_t(255); }
constexpr size_t WS_WQKV = 0;
constexpr size_t WS_WAO = WS_WQKV + 2ull * 1536 * 1024 * 2;
constexpr size_t WS_WRIN = WS_WAO + 2ull * 1024 * 1024 * 2;
constexpr size_t WS_WRO = WS_WRIN + 2ull * 6144 * 1024 * 2;
constexpr size_t WS_WFIN = WS_WRO + 2ull * 1024 * 2048 * 2;
constexpr size_t WS_WFOUT = WS_WFIN + 4ull * 5632 * 1024 * 2;
constexpr size_t WS_TROPE = WS_WFOUT + 4ull * 1024 * 2816 * 2;
constexpr size_t WS_TRET = WS_TROPE + al(2ull * 8193 * 32 * 4);
constexpr size_t WS_X = WS_TRET + al(2ull * 8193 * 128 * 4);
constexpr size_t WS_XB = WS_X + (size_t)MT * 1024 * 4;
constexpr size_t WS_Y = WS_XB + (size_t)MT * 1024 * 2;
constexpr size_t WS_ACT = WS_Y + (size_t)MT * 1024 * 4;
constexpr size_t WS_ACT2 = WS_ACT + 268435456ull;
constexpr size_t WS_US = WS_ACT2 + (size_t)MT * 2816 * 2;
constexpr size_t WS_SMP = WS_US + 134217728ull;
constexpr size_t WS_BAR = WS_SMP + 128ull * 4096 * 4;
constexpr size_t WS_PART = WS_BAR + 16384;
constexpr size_t WS_PART2 = WS_PART + 4ull * 44 * 128 * 256 * 4;
constexpr size_t WS_END = WS_PART2 + 24ull * 16 * 128 * 256 * 4;
constexpr size_t A_Q = WS_ACT;
constexpr size_t A_K = A_Q + (size_t)MT * 1024 * 2;
constexpr size_t A_VT = A_K + (size_t)MP * 256 * 2;
constexpr size_t R_Q = WS_ACT;
constexpr size_t R_K = R_Q + (size_t)MT * 1024 * 2;
constexpr size_t R_KT = R_K + (size_t)MT * 1024 * 2;
constexpr size_t R_VT = R_KT + 2ull * 1024 * 8192 * 2;
constexpr size_t R_GS = R_VT + 2ull * 2048 * 8192 * 2;
static_assert(R_GS + (size_t)MT * 2048 * 2 <= WS_ACT2, "act region");
constexpr size_t F_UA = WS_ACT;
constexpr size_t F_UG = F_UA + (size_t)MT * 2816 * 2;

struct Params {
  const float* in[19];
  float* out;
  unsigned char* ws;
};
enum { I_XP = 0, I_XS, I_CK, I_CV, I_SR, I_SC, I_WQKV, I_SINK, I_WAO, I_WRIN, I_WRO, I_WFIN, I_CW, I_CB, I_WFOUT, I_LMG, I_LMB, I_LFG, I_LFB };

DI int tid512() { int t = __builtin_amdgcn_workitem_id_x(); asm volatile("" : "+v"(t)); return t; }
DI int bid_real() { int b = __builtin_amdgcn_workgroup_id_x(); asm volatile("" : "+s"(b)); return b; }
DI int tidx() { return tid512() & 255; }
DI int bidx() { return 2 * bid_real() + __builtin_amdgcn_readfirstlane(tid512() >> 8); }
#define NVB (2 * (int)gridDim.x)
DI u16 f2bf(float x) { return __builtin_bit_cast(u16, (__bf16)x); }
DI float bf2f(u16 v) { return __uint_as_float(((unsigned)v) << 16); }
DI unsigned pack2(float a, float b) { return (unsigned)f2bf(a) | ((unsigned)f2bf(b) << 16); }
DI int crow(int reg, int h) { return (reg & 3) + 8 * (reg >> 2) + 4 * h; }
DI float silu(float x) { return x / (1.f + __expf(-x)); }
DI float lg2gamma(int hh) { return hh == 0 ? -0.04580368961312479f : hh == 1 ? -0.02272007650008353f : hh == 2 ? -0.011315313227834146f : -0.005646563141142063f; }

DI float wave_max(float v) {
#pragma unroll
  for (int o = 32; o >= 1; o >>= 1) v = fmaxf(v, __shfl_xor(v, o));
  return v;
}
DI float wave_sum(float v) {
#pragma unroll
  for (int o = 32; o >= 1; o >>= 1) v += __shfl_xor(v, o);
  return v;
}

DI void sincos_d(double x, float& s, float& c) {
  const double n = rint(x * 0.63661977236758134308);
  double r = fma(-n, 1.57079632673412561417e+00, x);
  r = fma(-n, 6.07710050650619224932e-11, r);
  const double r2 = r * r;
  double sp = 1.0 / 6227020800.0;
  sp = fma(sp, r2, -1.0 / 39916800.0); sp = fma(sp, r2, 1.0 / 362880.0); sp = fma(sp, r2, -1.0 / 5040.0);
  sp = fma(sp, r2, 1.0 / 120.0); sp = fma(sp, r2, -1.0 / 6.0); sp = fma(sp, r2, 1.0);
  const double sn = sp * r;
  double cp = -1.0 / 87178291200.0;
  cp = fma(cp, r2, 1.0 / 479001600.0); cp = fma(cp, r2, -1.0 / 3628800.0); cp = fma(cp, r2, 1.0 / 40320.0);
  cp = fma(cp, r2, -1.0 / 720.0); cp = fma(cp, r2, 1.0 / 24.0); cp = fma(cp, r2, -0.5); cp = fma(cp, r2, 1.0);
  const int q = ((int)n) & 3;
  const double ss = (q & 1) ? cp : sn, cc = (q & 1) ? sn : cp;
  s = (float)((q == 2 || q == 3) ? -ss : ss);
  c = (float)((q == 1 || q == 2) ? -cc : cc);
}

constexpr int LSTR = 72;
constexpr int TILE_E = 256 * LSTR;
constexpr int LDS_BYTES = 4 * TILE_E * 2;
constexpr int LDS_HALF_E = LDS_BYTES / 4;

DI void gemm_core(const u16* __restrict__ A, size_t lda, const u16* __restrict__ Bt, size_t ldb, int K, u16* lds, f32x16 (&acc)[4][2]) {
  const int t = tid512(), lane = t & 63, w = t >> 6, wm = w >> 2, wn = w & 3, r = lane & 31, h = lane >> 5;
  u16* As = lds; u16* Bs = lds + 2 * TILE_E;
  const int lrow = t >> 3, lk = (t & 7) * 8;
  const u16* Ag = A + (size_t)lrow * lda + lk;
  const u16* Bg = Bt + (size_t)lrow * ldb + lk;
#define GLOAD(P, ko) \
  P##a0 = *(const uint4*)(Ag + (ko)); P##a1 = *(const uint4*)(Ag + (size_t)64 * lda + (ko)); P##a2 = *(const uint4*)(Ag + (size_t)128 * lda + (ko)); P##a3 = *(const uint4*)(Ag + (size_t)192 * lda + (ko)); \
  P##b0 = *(const uint4*)(Bg + (ko)); P##b1 = *(const uint4*)(Bg + (size_t)64 * ldb + (ko)); P##b2 = *(const uint4*)(Bg + (size_t)128 * ldb + (ko)); P##b3 = *(const uint4*)(Bg + (size_t)192 * ldb + (ko));
#define LSTORE(P, buf) { u16* ad_ = As + (buf) * TILE_E + lrow * LSTR + lk; u16* bd_ = Bs + (buf) * TILE_E + lrow * LSTR + lk; \
  *(uint4*)(ad_) = P##a0; *(uint4*)(ad_ + 64 * LSTR) = P##a1; *(uint4*)(ad_ + 128 * LSTR) = P##a2; *(uint4*)(ad_ + 192 * LSTR) = P##a3; \
  *(uint4*)(bd_) = P##b0; *(uint4*)(bd_ + 64 * LSTR) = P##b1; *(uint4*)(bd_ + 128 * LSTR) = P##b2; *(uint4*)(bd_ + 192 * LSTR) = P##b3; }
#define COMPUTE(buf) { \
    const u16* as = As + (buf) * TILE_E + (wm * 128 + r) * LSTR + h * 8; \
    const u16* bs = Bs + (buf) * TILE_E + (wn * 64 + r) * LSTR + h * 8; \
    _Pragma("unroll") for (int kk = 0; kk < 4; ++kk) { \
      const bf16x8 b0 = *(const bf16x8*)(bs + kk * 16), b1 = *(const bf16x8*)(bs + 32 * LSTR + kk * 16); \
      _Pragma("unroll") for (int mi = 0; mi < 4; ++mi) { \
        const bf16x8 a = *(const bf16x8*)(as + mi * 32 * LSTR + kk * 16); \
        acc[mi][0] = MFMA(a, b0, acc[mi][0]); acc[mi][1] = MFMA(a, b1, acc[mi][1]); } } }
  uint4 pa0, pa1, pa2, pa3, pb0, pb1, pb2, pb3;
  const int nk = K >> 6;
  {
    uint4 qa0, qa1, qa2, qa3, qb0, qb1, qb2, qb3;
    GLOAD(q, 0)
    if (nk > 1) { GLOAD(p, 64) }
    __syncthreads();
    LSTORE(q, 0)
  }
#pragma unroll
  for (int a = 0; a < 4; ++a)
#pragma unroll
    for (int b = 0; b < 2; ++b)
#pragma unroll
      for (int i = 0; i < 16; ++i) acc[a][b][i] = 0.f;
  __syncthreads();
#pragma unroll 1
  for (int kt = 0; kt < nk; ++kt) {
    const int buf = kt & 1;
    if (kt + 1 < nk) LSTORE(p, buf ^ 1)
    if (kt + 2 < nk) { const int ko = (kt + 2) << 6; GLOAD(p, ko) }
    __builtin_amdgcn_sched_barrier(0);
    COMPUTE(buf)
    __syncthreads();
  }
#undef COMPUTE
#undef GLOAD
#undef LSTORE
}

DI void epi_qkv(const Params& p, int j, f32x16 (&acc)[2][2], int mb, int nb, int lane) {
  const int r = lane & 31, h = lane >> 5, slot = nb >> 6;
  const float* cosT = (const float*)(p.ws + WS_TROPE); const float* sinT = cosT + 8193 * 32;
  const bool smp = mb >= MP;
  if (slot < 20) {
    u16* Q = (u16*)(p.ws + A_Q); u16* KB = (u16*)(p.ws + A_K);
#pragma unroll
    for (int mi = 0; mi < 2; ++mi) {
      float cc[16], ss[16];
#pragma unroll
      for (int reg = 0; reg < 16; ++reg) {
        const int row = mb + mi * 32 + crow(reg, h);
        const int pos = smp ? 8192 : (row & 8191);
        cc[reg] = cosT[pos * 32 + r]; ss[reg] = sinT[pos * 32 + r];
      }
#pragma unroll
      for (int reg = 0; reg < 16; ++reg) {
        const int row = mb + mi * 32 + crow(reg, h);
        const int pos = smp ? 8192 : (row & 8191);
        const float c = cc[reg], s = ss[reg];
        const float x1 = acc[mi][0][reg], x2 = acc[mi][1][reg];
        const float o1 = x1 * c - x2 * s, o2 = x2 * c + x1 * s;
        if (slot < 16) {
          Q[(size_t)row * 1024 + nb + r] = f2bf(o1 * 0.125f); Q[(size_t)row * 1024 + nb + 32 + r] = f2bf(o2 * 0.125f);
        } else {
          const int kvh = slot - 16;
          if (!smp) {
            KB[(size_t)row * 256 + kvh * 64 + r] = f2bf(o1); KB[(size_t)row * 256 + kvh * 64 + 32 + r] = f2bf(o2);
            if (pos >= 8064) { const int b = row >> 13; float* o = p.out + O_KWP + ((size_t)((j * 2 + b) * 128 + (pos - 8064)) * 4 + kvh) * 64; o[r] = o1; o[32 + r] = o2; }
          } else {
            const int b = row - MP; float* o = p.out + O_KWS + ((size_t)((j * 128 + b) * 128 + 127) * 4 + kvh) * 64; o[r] = o1; o[32 + r] = o2;
          }
        }
      }
    }
  } else {
    const int kvh = slot - 20;
    if (!smp) {
      u16* VT = (u16*)(p.ws + A_VT);
      const int b = mb >> 13;
#pragma unroll
      for (int mi = 0; mi < 2; ++mi)
#pragma unroll
        for (int ni = 0; ni < 2; ++ni)
#pragma unroll
          for (int g4 = 0; g4 < 4; ++g4) {
            const int t0 = (mb & 8191) + mi * 32 + 8 * g4 + 4 * h, d = ni * 32 + r;
            uint2 v; v.x = pack2(acc[mi][ni][4 * g4], acc[mi][ni][4 * g4 + 1]); v.y = pack2(acc[mi][ni][4 * g4 + 2], acc[mi][ni][4 * g4 + 3]);
            *(uint2*)(VT + (size_t)(b * 256 + kvh * 64 + d) * 8192 + t0) = v;
            if (t0 >= 8064) {
#pragma unroll
              for (int q = 0; q < 4; ++q) p.out[O_VWP + ((size_t)((j * 2 + b) * 128 + (t0 + q - 8064)) * 4 + kvh) * 64 + d] = acc[mi][ni][4 * g4 + q];
            }
          }
    } else {
#pragma unroll
      for (int mi = 0; mi < 2; ++mi)
#pragma unroll
        for (int ni = 0; ni < 2; ++ni)
#pragma unroll
          for (int reg = 0; reg < 16; ++reg) {
            const int b = mb - MP + mi * 32 + crow(reg, h);
            p.out[O_VWS + ((size_t)((j * 128 + b) * 128 + 127) * 4 + kvh) * 64 + ni * 32 + r] = acc[mi][ni][reg];
          }
    }
  }
}

DI void epi_res(const Params& p, f32x16 (&acc)[2][2], int mb, int nb, int lane) {
  const int r = lane & 31, h = lane >> 5;
  const float* __restrict__ X = (const float*)(p.ws + WS_X); float* __restrict__ Y = (float*)(p.ws + WS_Y);
#pragma unroll
  for (int mi = 0; mi < 2; ++mi) {
    float xv[2][16];
#pragma unroll
    for (int ni = 0; ni < 2; ++ni)
#pragma unroll
      for (int reg = 0; reg < 16; ++reg) xv[ni][reg] = X[(size_t)(mb + mi * 32 + crow(reg, h)) * 1024 + nb + ni * 32 + r];
#pragma unroll
    for (int ni = 0; ni < 2; ++ni)
#pragma unroll
      for (int reg = 0; reg < 16; ++reg) Y[(size_t)(mb + mi * 32 + crow(reg, h)) * 1024 + nb + ni * 32 + r] = ALPHA * xv[ni][reg] + acc[mi][ni][reg];
  }
}

DI void epi_rin(const Params& p, int j, f32x16 (&acc)[2][2], int mb, int nb, int lane) {
  const int r = lane & 31, h = lane >> 5, slot = nb >> 6;
  const bool smp = mb >= MP;
  const int b = mb >> 13;
  if (slot < 32) {
    const bool isq = slot < 16;
    const int hh = (slot & 15) >> 2, cbase = nb & 255, ncol = nb & 1023;
    const float lg = lg2gamma(hh);
    const float* cosR = (const float*)(p.ws + WS_TRET); const float* sinR = cosR + 8193 * 128;
#pragma unroll
    for (int mi = 0; mi < 2; ++mi)
#pragma unroll
      for (int ni = 0; ni < 2; ++ni) {
        const int pidx = (cbase + ni * 32 + r) >> 1;
        float cc[16], ss[16];
#pragma unroll
        for (int reg = 0; reg < 16; ++reg) {
          const int row = mb + mi * 32 + crow(reg, h);
          const int pos = smp ? 8192 : (row & 8191);
          cc[reg] = cosR[pos * 128 + pidx]; ss[reg] = sinR[pos * 128 + pidx];
        }
#pragma unroll
        for (int reg = 0; reg < 16; ++reg) {
          const int row = mb + mi * 32 + crow(reg, h);
          const int pos = smp ? 8192 : (row & 8191);
          const float mine = acc[mi][ni][reg], other = __shfl_xor(mine, 1);
          const float rot = (r & 1) ? (mine * cc[reg] + other * ss[reg]) : (mine * cc[reg] - other * ss[reg]);
          const float e = (float)((smp ? 0 : (pos & 127)) + 1) * lg;
          acc[mi][ni][reg] = isq ? rot * exp2f(e) : rot * 0.0625f * exp2f(-e);
        }
        __builtin_amdgcn_sched_barrier(0);
      }
    if (smp) {
      float* S = (float*)(p.ws + WS_SMP) + (isq ? 0 : 128 * 1024);
#pragma unroll
      for (int mi = 0; mi < 2; ++mi)
#pragma unroll
        for (int ni = 0; ni < 2; ++ni)
#pragma unroll
          for (int reg = 0; reg < 16; ++reg)
            S[(size_t)(mb - MP + mi * 32 + crow(reg, h)) * 1024 + ncol + ni * 32 + r] = acc[mi][ni][reg];
    } else {
      u16* N = (u16*)(p.ws + (isq ? R_Q : R_K));
#pragma unroll
      for (int mi = 0; mi < 2; ++mi)
#pragma unroll
        for (int ni = 0; ni < 2; ++ni)
#pragma unroll
          for (int reg = 0; reg < 16; ++reg)
            N[(size_t)(mb + mi * 32 + crow(reg, h)) * 1024 + ncol + ni * 32 + r] = f2bf(acc[mi][ni][reg]);
      if (!isq) {
        u16* KT = (u16*)(p.ws + R_KT);
#pragma unroll
        for (int mi = 0; mi < 2; ++mi)
#pragma unroll
          for (int ni = 0; ni < 2; ++ni)
#pragma unroll
            for (int g4 = 0; g4 < 4; ++g4) {
              const int t0 = (mb & 8191) + mi * 32 + 8 * g4 + 4 * h;
              uint2 v; v.x = pack2(acc[mi][ni][4 * g4], acc[mi][ni][4 * g4 + 1]); v.y = pack2(acc[mi][ni][4 * g4 + 2], acc[mi][ni][4 * g4 + 3]);
              *(uint2*)(KT + (size_t)(b * 1024 + ncol + ni * 32 + r) * 8192 + t0) = v;
            }
      }
    }
  } else if (slot < 64) {
    const int cv = nb - 2048;
    if (smp) {
      float* SV = (float*)(p.ws + WS_SMP) + 2 * 128 * 1024;
#pragma unroll
      for (int mi = 0; mi < 2; ++mi)
#pragma unroll
        for (int ni = 0; ni < 2; ++ni)
#pragma unroll
          for (int reg = 0; reg < 16; ++reg)
            SV[(size_t)(mb - MP + mi * 32 + crow(reg, h)) * 2048 + cv + ni * 32 + r] = acc[mi][ni][reg];
    } else {
      u16* VT = (u16*)(p.ws + R_VT);
#pragma unroll
      for (int mi = 0; mi < 2; ++mi)
#pragma unroll
        for (int ni = 0; ni < 2; ++ni)
#pragma unroll
          for (int g4 = 0; g4 < 4; ++g4) {
            const int t0 = (mb & 8191) + mi * 32 + 8 * g4 + 4 * h;
            uint2 v; v.x = pack2(acc[mi][ni][4 * g4], acc[mi][ni][4 * g4 + 1]); v.y = pack2(acc[mi][ni][4 * g4 + 2], acc[mi][ni][4 * g4 + 3]);
            *(uint2*)(VT + (size_t)(b * 2048 + cv + ni * 32 + r) * 8192 + t0) = v;
          }
    }
  } else {
    u16* GS = (u16*)(p.ws + R_GS);
    const int cg_ = nb - 4096;
#pragma unroll
    for (int mi = 0; mi < 2; ++mi)
#pragma unroll
      for (int ni = 0; ni < 2; ++ni)
#pragma unroll
        for (int reg = 0; reg < 16; ++reg)
          GS[(size_t)(mb + mi * 32 + crow(reg, h)) * 2048 + cg_ + ni * 32 + r] = f2bf(silu(acc[mi][ni][reg]));
  }
}

DI void epi_fin(const Params& p, int i, f32x16 (&acc)[2][2], int mb, int nb, int lane) {
  const int r = lane & 31, h = lane >> 5;
  const bool smp = mb >= MP;
  if (nb < DFF) {
    u16* UA = (u16*)(p.ws + F_UA);
#pragma unroll
    for (int mi = 0; mi < 2; ++mi)
#pragma unroll
      for (int ni = 0; ni < 2; ++ni)
#pragma unroll
        for (int reg = 0; reg < 16; ++reg) {
          const int row = mb + mi * 32 + crow(reg, h), col = nb + ni * 32 + r;
          const float v = acc[mi][ni][reg];
          UA[(size_t)row * DFF + col] = f2bf(v);
          if (smp) {
            p.out[O_CSS + ((size_t)(i * 128 + (row - MP)) * 2 + 1) * DFF + col] = v;
          } else {
            const int pos = row & 8191;
            if (pos >= 8190) p.out[O_CSP + ((size_t)(i * 2 + (row >> 13)) * 2 + (pos - 8190)) * DFF + col] = v;
          }
        }
  } else {
    u16* UG = (u16*)(p.ws + F_UG);
#pragma unroll
    for (int mi = 0; mi < 2; ++mi)
#pragma unroll
      for (int ni = 0; ni < 2; ++ni)
#pragma unroll
        for (int reg = 0; reg < 16; ++reg)
          UG[(size_t)(mb + mi * 32 + crow(reg, h)) * DFF + (nb - DFF) + ni * 32 + r] = f2bf(acc[mi][ni][reg]);
  }
}

#define XB_TMO      128
#define XB_XCNT(j)  (256  + 64 * (j))
#define XB_XSUB(j)  (1280 + 64 * (j))
#define XB_XGEN(j)  (2304 + 64 * (j))
#define XB_TOP      3328
#define XB_TOPGEN   3392
#define XCD_BAR_WORDS 3456
#define XB_SPIN_CAP (1u << 20)
#define LAS __attribute__((address_space(3)))
DI unsigned xb_ld(unsigned* p) { return __hip_atomic_load(p, __ATOMIC_RELAXED, __HIP_MEMORY_SCOPE_AGENT); }
DI unsigned xb_add(unsigned* p, unsigned v) { return __hip_atomic_fetch_add(p, v, __ATOMIC_RELAXED, __HIP_MEMORY_SCOPE_AGENT); }
DI unsigned xb_xcc_id() { return (unsigned)__builtin_amdgcn_s_getreg((3 << 11) | 20) & 0xFu; }
#define XB_SPIN(cond, bar) do { unsigned _sp = 0; while (cond) { __builtin_amdgcn_s_sleep(1); \
    if ((++_sp & 255u) == 0u) { if (xb_ld(&(bar)[XB_TMO])) break; if (_sp > XB_SPIN_CAP) { atomicAdd(&(bar)[XB_TMO], 1u); break; } } } } while (0)
struct XcdBarrier { unsigned* bar; unsigned x; volatile LAS unsigned* st; };
DI XcdBarrier xcd_barrier_post(unsigned* bar, volatile LAS unsigned* st) {
  XcdBarrier b; b.bar = bar; b.x = xb_xcc_id(); b.st = st;
  if (__builtin_amdgcn_workitem_id_x() == 0) st[2] = xb_add(&bar[XB_XCNT(b.x)], 1u);
  return b;
}
DI void xcd_barrier_complete(unsigned* bar, unsigned x, unsigned& nloc, unsigned& nx) {
  const unsigned G = gridDim.x;
  unsigned sum, cnt, mine, sp = 0u;
  for (;;) {
    sum = 0u; cnt = 0u; mine = 0u;
#pragma unroll
    for (unsigned j = 0; j < 16; ++j) { const unsigned c = xb_ld(&bar[XB_XCNT(j)]); sum += c; cnt += (c > 0u) ? 1u : 0u; mine = (j == x) ? c : mine; }
    if (sum == G) break;
    __builtin_amdgcn_s_sleep(1);
    if ((++sp & 255u) == 0u) { if (xb_ld(&bar[XB_TMO])) break; if (sp > XB_SPIN_CAP) { atomicAdd(&bar[XB_TMO], 1u); break; } }
  }
  nloc = mine > 0u ? mine : 1u; nx = cnt > 0u ? cnt : 1u;
}
DI void xcd_barrier(const XcdBarrier& b) {
  asm volatile("s_waitcnt vmcnt(0)" ::: "memory");
  __syncthreads();
  if (__builtin_amdgcn_workitem_id_x() == 0) {
    unsigned* bar = b.bar;
    __builtin_amdgcn_s_waitcnt(0);
    unsigned nloc = b.st[0], nx = b.st[1];
    if (nloc == 0u) { xcd_barrier_complete(bar, b.x, nloc, nx); b.st[0] = nloc; b.st[1] = nx; }
    const unsigned old = xb_add(&bar[XB_XSUB(b.x)], 1u);
    const unsigned gen = old / nloc;
    if (old + 1u == (gen + 1u) * nloc) {
      __builtin_amdgcn_fence(__ATOMIC_RELEASE, "agent");
      asm volatile("s_waitcnt vmcnt(0)" ::: "memory");
      const unsigned og = xb_add(&bar[XB_TOP], 1u);
      const unsigned tg = og / nx;
      if (og + 1u == (tg + 1u) * nx) xb_add(&bar[XB_TOPGEN], 1u);
      else XB_SPIN(xb_ld(&bar[XB_TOPGEN]) == tg, bar);
      __builtin_amdgcn_fence(__ATOMIC_ACQUIRE, "agent");
      xb_add(&bar[XB_XGEN(b.x)], 1u);
      asm volatile("s_waitcnt vmcnt(0)" ::: "memory");
    } else {
      XB_SPIN(xb_ld(&bar[XB_XGEN(b.x)]) == gen, bar);
      __builtin_amdgcn_fence(__ATOMIC_ACQUIRE, "agent");
      asm volatile("s_waitcnt vmcnt(0)" ::: "memory");
    }
  }
  __syncthreads();
}

DI void signal_cnt(unsigned* c) {
  asm volatile("s_waitcnt vmcnt(0)" ::: "memory");
  __syncthreads();
  if (__builtin_amdgcn_workitem_id_x() == 0) { __builtin_amdgcn_fence(__ATOMIC_RELEASE, "agent"); asm volatile("s_waitcnt vmcnt(0)" ::: "memory"); (void)xb_add(c, 1u); }
}
DI void wait_cnt(unsigned* c, unsigned target, unsigned* bar) {
  if (__builtin_amdgcn_workitem_id_x() == 0) { XB_SPIN(xb_ld(c) < target, bar); __builtin_amdgcn_fence(__ATOMIC_ACQUIRE, "agent"); asm volatile("s_waitcnt vmcnt(0)" ::: "memory"); }
  __syncthreads();
}
constexpr int LN_CNT_WORD0 = XCD_BAR_WORDS;

DI void ln_row(const Params& p, int row, const float4 (&gv)[4], const float4 (&bv)[4], bool last, int nkk, int lane) {
  const float* Y = (const float*)(p.ws + WS_Y);
  float* X = (float*)(p.ws + WS_X); u16* XB = (u16*)(p.ws + WS_XB);
  float4 v[4];
  if (row < MP) {
    const float4* y = (const float4*)(Y + (size_t)row * 1024);
#pragma unroll
    for (int i = 0; i < 4; ++i) v[i] = y[lane + 64 * i];
  } else {
    const float4* x = (const float4*)(X + (size_t)row * 1024);
#pragma unroll
    for (int i = 0; i < 4; ++i) { const float4 t = x[lane + 64 * i]; v[i].x = ALPHA * t.x; v[i].y = ALPHA * t.y; v[i].z = ALPHA * t.z; v[i].w = ALPHA * t.w; }
    const float* __restrict__ PART = (const float*)(p.ws + WS_PART);
    int ks = 0;
    for (; ks + 8 <= nkk; ks += 8) {
      float4 t[8][4];
#pragma unroll
      for (int u = 0; u < 8; ++u)
#pragma unroll
        for (int i = 0; i < 4; ++i)
          t[u][i] = *(const float4*)(PART + ((size_t)(i * nkk + ks + u) * 128 + (row - MP)) * 256 + lane * 4);
#pragma unroll
      for (int u = 0; u < 8; ++u)
#pragma unroll
        for (int i = 0; i < 4; ++i) { v[i].x += t[u][i].x; v[i].y += t[u][i].y; v[i].z += t[u][i].z; v[i].w += t[u][i].w; }
    }
    for (; ks < nkk; ks += 4) {
      float4 t[4][4];
#pragma unroll
      for (int u = 0; u < 4; ++u)
#pragma unroll
        for (int i = 0; i < 4; ++i)
          t[u][i] = *(const float4*)(PART + ((size_t)(i * nkk + ks + u) * 128 + (row - MP)) * 256 + lane * 4);
#pragma unroll
      for (int u = 0; u < 4; ++u)
#pragma unroll
        for (int i = 0; i < 4; ++i) { v[i].x += t[u][i].x; v[i].y += t[u][i].y; v[i].z += t[u][i].z; v[i].w += t[u][i].w; }
    }
  }
  float sm = 0.f;
#pragma unroll
  for (int i = 0; i < 4; ++i) sm += v[i].x + v[i].y + v[i].z + v[i].w;
  const float mu = wave_sum(sm) * (1.f / 1024.f);
  float q = 0.f;
#pragma unroll
  for (int i = 0; i < 4; ++i) { v[i].x -= mu; v[i].y -= mu; v[i].z -= mu; v[i].w -= mu; q += v[i].x * v[i].x + v[i].y * v[i].y + v[i].z * v[i].z + v[i].w * v[i].w; }
  const float rs = rsqrtf(wave_sum(q) * (1.f / 1024.f) + LN_EPS);
  float4* xo = last ? (float4*)(p.out + (row < MP ? O_YP + (size_t)row * 1024 : O_YS + (size_t)(row - MP) * 1024)) : (float4*)(X + (size_t)row * 1024);
#pragma unroll
  for (int i = 0; i < 4; ++i) {
    float4 o;
    o.x = v[i].x * rs * gv[i].x + bv[i].x; o.y = v[i].y * rs * gv[i].y + bv[i].y;
    o.z = v[i].z * rs * gv[i].z + bv[i].z; o.w = v[i].w * rs * gv[i].w + bv[i].w;
    xo[lane + 64 * i] = o;
    if (!last) { uint2 ob; ob.x = pack2(o.x, o.y); ob.y = pack2(o.z, o.w); *(uint2*)(XB + (size_t)row * 1024 + (lane + 64 * i) * 4) = ob; }
  }
}
DI void ln_rows4(const Params& p, int row0, const float4 (&gv)[4], const float4 (&bv)[4], bool last, int lane) {
  const float* Y = (const float*)(p.ws + WS_Y);
  float* X = (float*)(p.ws + WS_X); u16* XB = (u16*)(p.ws + WS_XB);
  float4 v[4][4];
#pragma unroll
  for (int q = 0; q < 4; ++q)
#pragma unroll
    for (int i = 0; i < 4; ++i) v[q][i] = ((const float4*)(Y + (size_t)(row0 + q) * 1024))[lane + 64 * i];
  float sm[4];
#pragma unroll
  for (int q = 0; q < 4; ++q) { sm[q] = 0.f;
#pragma unroll
    for (int i = 0; i < 4; ++i) sm[q] += v[q][i].x + v[q][i].y + v[q][i].z + v[q][i].w; }
#pragma unroll
  for (int o = 32; o >= 1; o >>= 1)
#pragma unroll
    for (int q = 0; q < 4; ++q) sm[q] += __shfl_xor(sm[q], o);
  float qq[4];
#pragma unroll
  for (int q = 0; q < 4; ++q) { const float mu = sm[q] * (1.f / 1024.f); qq[q] = 0.f;
#pragma unroll
    for (int i = 0; i < 4; ++i) { v[q][i].x -= mu; v[q][i].y -= mu; v[q][i].z -= mu; v[q][i].w -= mu; qq[q] += v[q][i].x * v[q][i].x + v[q][i].y * v[q][i].y + v[q][i].z * v[q][i].z + v[q][i].w * v[q][i].w; } }
#pragma unroll
  for (int o = 32; o >= 1; o >>= 1)
#pragma unroll
    for (int q = 0; q < 4; ++q) qq[q] += __shfl_xor(qq[q], o);
#pragma unroll
  for (int q = 0; q < 4; ++q) {
    const int row = row0 + q;
    const float rs = rsqrtf(qq[q] * (1.f / 1024.f) + LN_EPS);
    float4* xo = last ? (float4*)(p.out + O_YP + (size_t)row * 1024) : (float4*)(X + (size_t)row * 1024);
#pragma unroll
    for (int i = 0; i < 4; ++i) {
      float4 o;
      o.x = v[q][i].x * rs * gv[i].x + bv[i].x; o.y = v[q][i].y * rs * gv[i].y + bv[i].y;
      o.z = v[q][i].z * rs * gv[i].z + bv[i].z; o.w = v[q][i].w * rs * gv[i].w + bv[i].w;
      xo[lane + 64 * i] = o;
      if (!last) { uint2 ob; ob.x = pack2(o.x, o.y); ob.y = pack2(o.z, o.w); *(uint2*)(XB + (size_t)row * 1024 + (lane + 64 * i) * 4) = ob; }
    }
  }
}
DI void phase_ln(const Params& p, const float* __restrict__ gam, const float* __restrict__ bet, bool last, int nkk) {
  const int lane = tidx() & 63;
  const int wid = bidx() * 4 + (tidx() >> 6), nw = NVB * 4;
  float4 gv[4], bv[4];
#pragma unroll
  for (int i = 0; i < 4; ++i) { gv[i] = ((const float4*)gam)[lane + 64 * i]; bv[i] = ((const float4*)bet)[lane + 64 * i]; }
  for (int rr = wid; rr < MT; rr += nw) ln_row(p, rr < MS ? MP + rr : rr - MS, gv, bv, last, nkk, lane);
}

enum { G_QKV, G_AO, G_RIN, G_RO, G_FIN, G_FOUT };
template <int G>
DI void gemm_phase(const Params& p, int layer, u16* lds, int vb, bool noepi = false, bool fuse_ln = false) {
  const int j = layer >> 1;
  const u16* A; const u16* Bt; int K, N;
  if (G == G_QKV) { A = (const u16*)(p.ws + WS_XB); Bt = (const u16*)(p.ws + WS_WQKV) + (size_t)j * 1536 * 1024; K = 1024; N = 1536; }
  else if (G == G_AO) { A = (const u16*)(p.ws + WS_ACT2); Bt = (const u16*)(p.ws + WS_WAO) + (size_t)j * 1024 * 1024; K = 1024; N = 1024; }
  else if (G == G_RIN) { A = (const u16*)(p.ws + WS_XB); Bt = (const u16*)(p.ws + WS_WRIN) + (size_t)j * 6144 * 1024; K = 1024; N = 6144; }
  else if (G == G_RO) { A = (const u16*)(p.ws + WS_ACT2); Bt = (const u16*)(p.ws + WS_WRO) + (size_t)j * 1024 * 2048; K = 2048; N = 1024; }
  else if (G == G_FIN) { A = (const u16*)(p.ws + WS_XB); Bt = (const u16*)(p.ws + WS_WFIN) + (size_t)layer * 5632 * 1024; K = 1024; N = 5632; }
  else { A = (const u16*)(p.ws + WS_ACT2); Bt = (const u16*)(p.ws + WS_WFOUT) + (size_t)layer * 1024 * 2816; K = 2816; N = 1024; }
  constexpr bool LNF = (G == G_AO || G == G_RO || G == G_FOUT);
  constexpr bool SPLIT = LNF || (G == G_RIN);
  const int ntn = N >> 8, ntiles = (SPLIT ? 64 : 65) * ntn;
  const int t = tid512(), lane = t & 63, w = t >> 6, wm = w >> 2, wn = w & 3;
  const int per = (int)gridDim.x >> 3;
  const int xcd = vb / per, rank = vb - xcd * per;
  const int lo = (int)(((long long)xcd * ntiles) >> 3), hi = (int)(((long long)(xcd + 1) * ntiles) >> 3);
  for (int L = lo + rank; L < hi; L += per) {
    int tm, tn;
    const int full = 64 * ntn;
    if (L < full) { const int sr = L / (8 * ntn), rem = L - sr * 8 * ntn; tn = rem >> 3; tm = 8 * sr + (rem & 7); }
    else { tn = L - full; tm = 64; }
    f32x16 acc[4][2];
    gemm_core(A + (size_t)tm * 256 * K, K, Bt + (size_t)tn * 256 * K, K, K, lds, acc);
    if (tm == 64 && wm == 1) continue;
    if (noepi) { float sacc = 0.f;
#pragma unroll
      for (int a = 0; a < 4; ++a)
#pragma unroll
        for (int b = 0; b < 2; ++b)
#pragma unroll
          for (int i = 0; i < 16; ++i) sacc += acc[a][b][i];
      if (sacc == 1.2345e30f) p.out[0] = 0.f; continue; }
    const int nb = tn * 256 + wn * 64;
    float* park = (float*)lds + w * 4096 + lane;
#pragma unroll
    for (int mi = 0; mi < 2; ++mi)
#pragma unroll
      for (int ni = 0; ni < 2; ++ni)
#pragma unroll
        for (int i = 0; i < 16; ++i) park[(mi * 32 + ni * 16 + i) * 64] = acc[2 + mi][ni][i];
    f32x16 ac[2][2];
    ac[0][0] = acc[0][0]; ac[0][1] = acc[0][1]; ac[1][0] = acc[1][0]; ac[1][1] = acc[1][1];
#pragma unroll 1
    for (int hf = 0; hf < 2; ++hf) {
      if (hf) {
#pragma unroll
        for (int mi = 0; mi < 2; ++mi)
#pragma unroll
          for (int ni = 0; ni < 2; ++ni)
#pragma unroll
            for (int i = 0; i < 16; ++i) ac[mi][ni][i] = park[(mi * 32 + ni * 16 + i) * 64];
      }
      const int mb = tm * 256 + wm * 128 + hf * 64;
      if (G == G_QKV) epi_qkv(p, j, ac, mb, nb, lane);
      else if (G == G_RIN) epi_rin(p, j, ac, mb, nb, lane);
      else if (G == G_FIN) epi_fin(p, layer, ac, mb, nb, lane);
      else epi_res(p, ac, mb, nb, lane);
    }
    if (LNF && fuse_ln) signal_cnt((unsigned*)(p.ws + WS_BAR) + LN_CNT_WORD0 + (layer * 2 + (G == G_FOUT ? 1 : 0)) * 65 + tm);
  }
  if (SPLIT) {
    const int nkk = K >> 6, r = lane & 31, h = lane >> 5;
    float* PART = (float*)(p.ws + (LNF ? WS_PART : WS_PART2));
    for (int e = vb; e < ntn * nkk; e += (int)gridDim.x) {
      const int tn = e / nkk, ks = e - tn * nkk;
      f32x16 acc[4][2];
      gemm_core(A + (size_t)MP * K + ks * 64, K, Bt + (size_t)tn * 256 * K + ks * 64, K, 64, lds, acc);
      if (wm == 0) {
        float* o = PART + (size_t)e * 128 * 256 + wn * 64 + r;
#pragma unroll
        for (int mi = 0; mi < 4; ++mi)
#pragma unroll
          for (int ni = 0; ni < 2; ++ni)
#pragma unroll
            for (int i = 0; i < 16; ++i) o[(size_t)(mi * 32 + crow(i, h)) * 256 + ni * 32] = acc[mi][ni][i];
      }
      if (LNF && fuse_ln) signal_cnt((unsigned*)(p.ws + WS_BAR) + LN_CNT_WORD0 + (layer * 2 + (G == G_FOUT ? 1 : 0)) * 65 + 64);
    }
    if (LNF && fuse_ln) {
      unsigned* bar = (unsigned*)(p.ws + WS_BAR);
      unsigned* cnt = bar + LN_CNT_WORD0 + (layer * 2 + (G == G_FOUT ? 1 : 0)) * 65;
      const float* gam = (G == G_FOUT ? p.in[I_LFG] : p.in[I_LMG]) + layer * 1024;
      const float* bet = (G == G_FOUT ? p.in[I_LFB] : p.in[I_LMB]) + layer * 1024;
      const bool last = (G == G_FOUT) && layer == 3;
      float4 gv[4], bv[4];
#pragma unroll
      for (int i = 0; i < 4; ++i) { gv[i] = ((const float4*)gam)[lane + 64 * i]; bv[i] = ((const float4*)bet)[lane + 64 * i]; }
      for (int L = lo + rank; L < hi; L += per) {
        const int sr = L / (8 * ntn), rem = L - sr * 8 * ntn, tn = rem >> 3, tm = 8 * sr + (rem & 7);
        wait_cnt(cnt + tm, 4u, bar);
        ln_rows4(p, tm * 256 + tn * 64 + w * 8, gv, bv, last, lane);
        ln_rows4(p, tm * 256 + tn * 64 + w * 8 + 4, gv, bv, last, lane);
      }
      const int G_ = (int)gridDim.x;
      if (vb >= G_ - 16) {
        wait_cnt(cnt + 64, (unsigned)(4 * nkk), bar);
        ln_row(p, MP + (vb - (G_ - 16)) * 8 + w, gv, bv, last, nkk, lane);
      }
    }
  }
}

DI void transpose_job(const float* __restrict__ src, u16* __restrict__ dst, int K, int N, float* tl) {
  const int t = tidx();
  const int tn = N >> 6, ntiles = (K >> 6) * tn;
  for (int tile = bidx(); tile < ntiles; tile += NVB) {
    const int k0 = (tile / tn) << 6, n0 = (tile % tn) << 6;
    __syncthreads();
#pragma unroll
    for (int i = 0; i < 16; ++i) { const int k = (t >> 6) + 4 * i; tl[k * 65 + (t & 63)] = src[(size_t)(k0 + k) * N + n0 + (t & 63)]; }
    __syncthreads();
    const int n = t >> 2, kq = (t & 3) * 16;
    uint4 v0, v1;
    v0.x = pack2(tl[(kq + 0) * 65 + n], tl[(kq + 1) * 65 + n]); v0.y = pack2(tl[(kq + 2) * 65 + n], tl[(kq + 3) * 65 + n]);
    v0.z = pack2(tl[(kq + 4) * 65 + n], tl[(kq + 5) * 65 + n]); v0.w = pack2(tl[(kq + 6) * 65 + n], tl[(kq + 7) * 65 + n]);
    v1.x = pack2(tl[(kq + 8) * 65 + n], tl[(kq + 9) * 65 + n]); v1.y = pack2(tl[(kq + 10) * 65 + n], tl[(kq + 11) * 65 + n]);
    v1.z = pack2(tl[(kq + 12) * 65 + n], tl[(kq + 13) * 65 + n]); v1.w = pack2(tl[(kq + 14) * 65 + n], tl[(kq + 15) * 65 + n]);
    u16* o = dst + (size_t)(n0 + n) * K + k0 + kq;
    *(uint4*)o = v0; *(uint4*)(o + 8) = v1;
  }
}

DI void phase_prep(const Params& p, u16* lds) {
  float* tl = (float*)lds;
  for (int j = 0; j < 2; ++j) {
    transpose_job(p.in[I_WQKV] + (size_t)j * 1024 * 1536, (u16*)(p.ws + WS_WQKV) + (size_t)j * 1536 * 1024, 1024, 1536, tl);
    transpose_job(p.in[I_WAO] + (size_t)j * 1024 * 1024, (u16*)(p.ws + WS_WAO) + (size_t)j * 1024 * 1024, 1024, 1024, tl);
    transpose_job(p.in[I_WRIN] + (size_t)j * 1024 * 6144, (u16*)(p.ws + WS_WRIN) + (size_t)j * 6144 * 1024, 1024, 6144, tl);
    transpose_job(p.in[I_WRO] + (size_t)j * 2048 * 1024, (u16*)(p.ws + WS_WRO) + (size_t)j * 1024 * 2048, 2048, 1024, tl);
  }
  for (int i = 0; i < 4; ++i) {
    transpose_job(p.in[I_WFIN] + (size_t)i * 1024 * 5632, (u16*)(p.ws + WS_WFIN) + (size_t)i * 5632 * 1024, 1024, 5632, tl);
    transpose_job(p.in[I_WFOUT] + (size_t)i * 2816 * 1024, (u16*)(p.ws + WS_WFOUT) + (size_t)i * 1024 * 2816, 2816, 1024, tl);
  }
  const size_t gid = (size_t)bidx() * 256 + tidx(), gstride = (size_t)NVB * 256;
  {
    float4* X = (float4*)(p.ws + WS_X); uint2* XB = (uint2*)(p.ws + WS_XB);
    const size_t nv = (size_t)MT * 256, npv = (size_t)MP * 256;
    for (size_t v0 = gid; v0 < nv; v0 += 4 * gstride) {
      float4 xb[4];
#pragma unroll
      for (int u = 0; u < 4; ++u) { const size_t v = v0 + u * gstride; if (v < nv) xb[u] = (v < npv) ? ((const float4*)p.in[I_XP])[v] : ((const float4*)p.in[I_XS])[v - npv]; }
#pragma unroll
      for (int u = 0; u < 4; ++u) { const size_t v = v0 + u * gstride; if (v < nv) { X[v] = xb[u]; uint2 o; o.x = pack2(xb[u].x, xb[u].y); o.y = pack2(xb[u].z, xb[u].w); XB[v] = o; } }
    }
  }
  {
    float* cosT = (float*)(p.ws + WS_TROPE); float* sinT = cosT + 8193 * 32;
    for (size_t v = gid; v < 8193ull * 32; v += gstride) {
      const int pos = (int)(v >> 5), i = (int)(v & 31);
      const double inv = exp(-9.210340371976182736 * (double)i / 32.0);
      float s, c; sincos_d((double)pos * inv, s, c); cosT[v] = c; sinT[v] = s;
    }
    float* cosR = (float*)(p.ws + WS_TRET); float* sinR = cosR + 8193 * 128;
    for (size_t v = gid; v < 8193ull * 128; v += gstride) {
      const int pos = (int)(v >> 7), i = (int)(v & 127);
      const double inv = exp(-9.210340371976182736 * (double)i / 127.0);
      float s, c; sincos_d((double)pos * inv, s, c); cosR[v] = c; sinR[v] = s;
    }
  }
}

DI void attn_prompt_item(const Params& p, int j, int item, u16* lds) {
  const int g = item & 3, kvh = (item >> 2) & 3, qb = (item >> 4) & 63, b = item >> 10;
  const int head = kvh * 4 + g;
  const int t = tidx(), lane = t & 63, w = t >> 6, r = lane & 31, h = lane >> 5;
  u16* Ks = lds;
  u16* Vts = lds + 256 * 72;
  const u16* Q = (const u16*)(p.ws + A_Q); const u16* KB = (const u16*)(p.ws + A_K); const u16* VT = (const u16*)(p.ws + A_VT);
  u16* OB = (u16*)(p.ws + WS_ACT2);
  const int tok0 = qb * 128 - 128;
  __syncthreads();
#pragma unroll
  for (int i = 0; i < 8; ++i) {
    const int c = t + 256 * i, key = c >> 3, part = c & 7, tok = tok0 + key;
    uint4 v = make_uint4(0, 0, 0, 0);
    if (tok >= 0) v = *(const uint4*)(KB + (size_t)(b * 8192 + tok) * 256 + kvh * 64 + part * 8);
    *(uint4*)(Ks + key * 72 + part * 8) = v;
  }
#pragma unroll
  for (int i = 0; i < 8; ++i) {
    const int c = t + 256 * i, d = c >> 5, part = c & 31, tok = tok0 + part * 8;
    uint4 v = make_uint4(0, 0, 0, 0);
    if (tok >= 0) v = *(const uint4*)(VT + (size_t)(b * 256 + kvh * 64 + d) * 8192 + tok);
    *(uint4*)(Vts + d * 264 + part * 8) = v;
  }
  const size_t qrow = (size_t)b * 8192 + qb * 128 + 32 * w + r;
  bf16x8 bq[4];
#pragma unroll
  for (int kk = 0; kk < 4; ++kk) bq[kk] = *(const bf16x8*)(Q + qrow * 1024 + head * 64 + kk * 16 + h * 8);
  __syncthreads();
  f32x16 S[5];
#pragma unroll
  for (int jb = 0; jb < 5; ++jb) {
#pragma unroll
    for (int i = 0; i < 16; ++i) S[jb][i] = 0.f;
    const u16* kp = Ks + (32 * (w + jb) + r) * 72 + h * 8;
#pragma unroll
    for (int kk = 0; kk < 4; ++kk) S[jb] = MFMA(*(const bf16x8*)(kp + kk * 16), bq[kk], S[jb]);
  }
  const float sink = p.in[I_SINK][j * 16 + head];
  float m = -INFINITY;
#pragma unroll
  for (int jb = 0; jb < 5; ++jb)
#pragma unroll
    for (int reg = 0; reg < 16; ++reg) {
      const int cr = crow(reg, h);
      const int rel = 128 + r - 32 * jb - cr;
      const bool valid = (rel >= 0) && (rel <= 128) && (qb > 0 || (32 * (w + jb) + cr) >= 128);
      const float s = valid ? S[jb][reg] : -INFINITY;
      S[jb][reg] = s; m = fmaxf(m, s);
    }
  m = fmaxf(m, __shfl_xor(m, 32));
  m = fmaxf(m, sink);
  float l = 0.f;
#pragma unroll
  for (int jb = 0; jb < 5; ++jb)
#pragma unroll
    for (int reg = 0; reg < 16; ++reg) { const float e = __expf(S[jb][reg] - m); S[jb][reg] = e; l += e; }
  l += __shfl_xor(l, 32);
  const float inv = 1.f / (l + __expf(sink - m));
  f32x16 O[2];
#pragma unroll
  for (int db = 0; db < 2; ++db)
#pragma unroll
    for (int i = 0; i < 16; ++i) O[db][i] = 0.f;
#pragma unroll
  for (int jb = 0; jb < 5; ++jb)
#pragma unroll
    for (int s = 0; s < 2; ++s) {
      uint4 pb;
      pb.x = pack2(S[jb][8 * s + 0], S[jb][8 * s + 1]); pb.y = pack2(S[jb][8 * s + 2], S[jb][8 * s + 3]);
      pb.z = pack2(S[jb][8 * s + 4], S[jb][8 * s + 5]); pb.w = pack2(S[jb][8 * s + 6], S[jb][8 * s + 7]);
      const bf16x8 bfrag = __builtin_bit_cast(bf16x8, pb);
#pragma unroll
      for (int db = 0; db < 2; ++db) {
        const u16* vp = Vts + (32 * db + r) * 264 + 32 * (w + jb) + 16 * s + 4 * h;
        const uint2 lo = *(const uint2*)vp, hi = *(const uint2*)(vp + 8);
        uint4 av; av.x = lo.x; av.y = lo.y; av.z = hi.x; av.w = hi.y;
        O[db] = MFMA(__builtin_bit_cast(bf16x8, av), bfrag, O[db]);
      }
    }
#pragma unroll
  for (int db = 0; db < 2; ++db)
#pragma unroll
    for (int g4 = 0; g4 < 4; ++g4) {
      uint2 v; v.x = pack2(O[db][4 * g4] * inv, O[db][4 * g4 + 1] * inv); v.y = pack2(O[db][4 * g4 + 2] * inv, O[db][4 * g4 + 3] * inv);
      *(uint2*)(OB + qrow * 1024 + head * 64 + 32 * db + 8 * g4 + 4 * h) = v;
    }
}

DI void attn_sample_item(const Params& p, int j, int item, u16* lds) {
  const int kvh = item & 3, b = item >> 2;
  const int t = tidx(), lane = t & 63, g = t >> 6;
  float* Kc = (float*)lds;
  float* Vc = Kc + 129 * 65;
  float* qs = Vc + 129 * 65;
  float* ps = qs + 256;
  const float* ck = p.in[I_CK] + (size_t)(j * 128 + b) * 128 * 256;
  const float* cv = p.in[I_CV] + (size_t)(j * 128 + b) * 128 * 256;
  float* ok = p.out + O_KWS + (size_t)(j * 128 + b) * 128 * 256;
  float* ov = p.out + O_VWS + (size_t)(j * 128 + b) * 128 * 256;
  __syncthreads();
  {
    const int d = t & 63, w0 = t >> 6;
#pragma unroll 1
    for (int i0 = 0; i0 < 32; i0 += 8) {
      float kb[8], vb[8];
#pragma unroll
      for (int u = 0; u < 8; ++u) { const int wq = w0 + 4 * (i0 + u); kb[u] = ck[wq * 256 + kvh * 64 + d]; vb[u] = cv[wq * 256 + kvh * 64 + d]; }
#pragma unroll
      for (int u = 0; u < 8; ++u) {
        const int wq = w0 + 4 * (i0 + u);
        Kc[wq * 65 + d] = kb[u]; Vc[wq * 65 + d] = vb[u];
        if (wq >= 1) { ok[(wq - 1) * 256 + kvh * 64 + d] = kb[u]; ov[(wq - 1) * 256 + kvh * 64 + d] = vb[u]; }
      }
    }
  }
  if (t < 64) { Kc[128 * 65 + t] = ok[127 * 256 + kvh * 64 + t]; Vc[128 * 65 + t] = ov[127 * 256 + kvh * 64 + t]; }
  qs[t] = bf2f(((const u16*)(p.ws + A_Q))[(size_t)(MP + b) * 1024 + (kvh * 4 + g) * 64 + lane]);
  __syncthreads();
  const float sink = p.in[I_SINK][j * 16 + kvh * 4 + g];
  float s0 = 0.f, s1 = 0.f, s2 = 0.f;
#pragma unroll 8
  for (int d = 0; d < 64; ++d) {
    const float q = qs[g * 64 + d];
    s0 += q * Kc[lane * 65 + d]; s1 += q * Kc[(lane + 64) * 65 + d]; s2 += q * Kc[128 * 65 + d];
  }
  float m = fmaxf(fmaxf(s0, s1), s2);
  m = fmaxf(wave_max(m), sink);
  const float e0 = __expf(s0 - m), e1 = __expf(s1 - m), e2 = __expf(s2 - m);
  float l = wave_sum(e0 + e1) + e2;
  const float inv = 1.f / (l + __expf(sink - m));
  ps[g * 132 + lane] = e0 * inv; ps[g * 132 + 64 + lane] = e1 * inv;
  if (lane == 0) ps[g * 132 + 128] = e2 * inv;
  __syncthreads();
  float o = 0.f;
#pragma unroll 4
  for (int k = 0; k < 129; ++k) o += ps[g * 132 + k] * Vc[k * 65 + lane];
  ((u16*)(p.ws + WS_ACT2))[(size_t)(MP + b) * 1024 + (kvh * 4 + g) * 64 + lane] = f2bf(o);
}

DI void phase_attn(const Params& p, int layer, u16* lds) {
  const int j = layer >> 1;
  for (int item = bidx(); item < 2048 + 512; item += NVB) {
    if (item < 2048) attn_prompt_item(p, j, item, lds);
    else attn_sample_item(p, j, item - 2048, lds);
  }
}

DI void unpack8(const uint4 x, float (&o)[8]) {
  o[0] = __uint_as_float(x.x << 16); o[1] = __uint_as_float(x.x & 0xffff0000u); o[2] = __uint_as_float(x.y << 16); o[3] = __uint_as_float(x.y & 0xffff0000u);
  o[4] = __uint_as_float(x.z << 16); o[5] = __uint_as_float(x.z & 0xffff0000u); o[6] = __uint_as_float(x.w << 16); o[7] = __uint_as_float(x.w & 0xffff0000u);
}
DI void phase_conv(const Params& p, int i) {
  const u16* __restrict__ UA = (const u16*)(p.ws + F_UA); const u16* __restrict__ UG = (const u16*)(p.ws + F_UG);
  u16* __restrict__ H = (u16*)(p.ws + WS_ACT2);
  const float* cw = p.in[I_CW] + (size_t)i * 3 * DFF; const float* cb = p.in[I_CB] + (size_t)i * DFF;
  const float* sc = p.in[I_SC] + (size_t)i * 128 * 2 * DFF;
  const int gid = bidx() * 256 + tidx(), gstride = NVB * 256;
  for (int it = gid; it < 1024 * 352 + 128 * 352; it += gstride) {
    const bool smp = it >= 1024 * 352;
    const int it2 = smp ? it - 1024 * 352 : it;
    const int ch = it2 / 352, f = (it2 - ch * 352) * 8, row0 = smp ? MP + ch : ch * 16;
    float w0[8], w1[8], w2[8], bb[8];
#pragma unroll
    for (int k = 0; k < 8; ++k) { w0[k] = cw[f + k]; w1[k] = cw[DFF + f + k]; w2[k] = cw[2 * DFF + f + k]; bb[k] = cb[f + k]; }
    if (!smp) {
      float a1[8], a2[8];
      const int pos0 = row0 & 8191;
      if (pos0 >= 2) { unpack8(*(const uint4*)(UA + (size_t)(row0 - 1) * DFF + f), a1); unpack8(*(const uint4*)(UA + (size_t)(row0 - 2) * DFF + f), a2); }
      else {
#pragma unroll
        for (int k = 0; k < 8; ++k) { a1[k] = 0.f; a2[k] = 0.f; }
      }
#pragma unroll 1
      for (int rr = 0; rr < 16; rr += 4) {
        const size_t o = (size_t)(row0 + rr) * DFF + f;
        uint4 xa[4], xg[4];
#pragma unroll
        for (int u = 0; u < 4; ++u) { xa[u] = *(const uint4*)(UA + o + (size_t)u * DFF); xg[u] = *(const uint4*)(UG + o + (size_t)u * DFF); }
#pragma unroll
        for (int u = 0; u < 4; ++u) {
          float a0[8], gg[8];
          unpack8(xa[u], a0); unpack8(xg[u], gg);
          unsigned ho[4];
#pragma unroll
          for (int k = 0; k < 4; ++k) {
            const float c0 = bb[2 * k] + a2[2 * k] * w0[2 * k] + a1[2 * k] * w1[2 * k] + a0[2 * k] * w2[2 * k];
            const float c1 = bb[2 * k + 1] + a2[2 * k + 1] * w0[2 * k + 1] + a1[2 * k + 1] * w1[2 * k + 1] + a0[2 * k + 1] * w2[2 * k + 1];
            ho[k] = pack2(silu(c0) * gg[2 * k], silu(c1) * gg[2 * k + 1]);
          }
          *(uint4*)(H + o + (size_t)u * DFF) = make_uint4(ho[0], ho[1], ho[2], ho[3]);
#pragma unroll
          for (int k = 0; k < 8; ++k) { a2[k] = a1[k]; a1[k] = a0[k]; }
        }
      }
    } else {
      const int b = row0 - MP;
      const size_t o = (size_t)row0 * DFF + f;
      float a0[8], gg[8];
      unpack8(*(const uint4*)(UA + o), a0); unpack8(*(const uint4*)(UG + o), gg);
      const float4* s0p = (const float4*)(sc + (size_t)(b * 2 + 0) * DFF + f); const float4* s1p = (const float4*)(sc + (size_t)(b * 2 + 1) * DFF + f);
      float4* o0 = (float4*)(p.out + O_CSS + ((size_t)(i * 128 + b) * 2 + 0) * DFF + f);
      const float4 p0 = s0p[0], p1 = s0p[1], q0 = s1p[0], q1 = s1p[1];
      o0[0] = q0; o0[1] = q1;
      const float x2[8] = {p0.x, p0.y, p0.z, p0.w, p1.x, p1.y, p1.z, p1.w}, x1[8] = {q0.x, q0.y, q0.z, q0.w, q1.x, q1.y, q1.z, q1.w};
      unsigned ho[4];
#pragma unroll
      for (int k = 0; k < 4; ++k) {
        const float c0 = bb[2 * k] + x2[2 * k] * w0[2 * k] + x1[2 * k] * w1[2 * k] + a0[2 * k] * w2[2 * k];
        const float c1 = bb[2 * k + 1] + x2[2 * k + 1] * w0[2 * k + 1] + x1[2 * k + 1] * w1[2 * k + 1] + a0[2 * k + 1] * w2[2 * k + 1];
        ho[k] = pack2(silu(c0) * gg[2 * k], silu(c1) * gg[2 * k + 1]);
      }
      *(uint4*)(H + o) = make_uint4(ho[0], ho[1], ho[2], ho[3]);
    }
  }
}

DI void ret_u_tile(const Params& p, int tile, u16* lds) {
  const int te = tile & 1, hh = (tile >> 1) & 3, c = (tile >> 3) & 63, b = tile >> 9;
  const u16* VT = (const u16*)(p.ws + R_VT) + (size_t)(b * 2048 + hh * 512 + te * 256) * 8192 + c * 128;
  const u16* KT = (const u16*)(p.ws + R_KT) + (size_t)(b * 1024 + hh * 256) * 8192 + c * 128;
  f32x16 acc[4][2];
  gemm_core(VT, 8192, KT, 8192, 128, lds, acc);
  const int t = tid512(), lane = t & 63, w = t >> 6, wm = w >> 2, wn = w & 3, r = lane & 31, h = lane >> 5;
  u16* UT = (u16*)(p.ws + WS_US) + (size_t)((b * 64 + c) * 4 + hh) * 512 * 256;
#pragma unroll
  for (int mi = 0; mi < 4; ++mi)
#pragma unroll
    for (int ni = 0; ni < 2; ++ni)
#pragma unroll
      for (int reg = 0; reg < 16; ++reg)
        UT[(size_t)(te * 256 + wm * 128 + mi * 32 + crow(reg, h)) * 256 + wn * 64 + ni * 32 + r] = f2bf(acc[mi][ni][reg]);
}

DI float block_sum(float v, float* red) {
  v = wave_sum(v);
  __syncthreads();
  if ((tidx() & 63) == 0) red[tidx() >> 6] = v;
  __syncthreads();
  return red[0] + red[1] + red[2] + red[3];
}

DI void ret_sample_item(const Params& p, int j, int item, u16* lds) {
  const int hh = item & 3, b = item >> 2, t = tidx(), tc = t & 127, par = t >> 7;
  float* qs = (float*)lds; float* ks = qs + 256; float* red = ks + 256; float4* red4 = (float4*)(red + 8);
  const float* __restrict__ P2 = (const float*)(p.ws + WS_PART2);
  __syncthreads();
  float qr = 0.f, kr = 0.f;
  float4 vv = make_float4(0.f, 0.f, 0.f, 0.f), gq = make_float4(0.f, 0.f, 0.f, 0.f);
  {
    const float* pq = P2 + ((size_t)(hh * 16) * 128 + b) * 256 + t;
    const float* pk = P2 + ((size_t)((4 + hh) * 16) * 128 + b) * 256 + t;
    const float* pv = P2 + ((size_t)((8 + 2 * hh + (tc >> 6)) * 16) * 128 + b) * 256 + ((4 * tc) & 255);
    const float* pg = P2 + ((size_t)((16 + 2 * hh + (tc >> 6)) * 16) * 128 + b) * 256 + ((4 * tc) & 255);
    float qb[16], kb[16]; float4 vb4[16], gb4[16];
#pragma unroll
    for (int u = 0; u < 16; ++u) { qb[u] = pq[(size_t)u * 128 * 256]; kb[u] = pk[(size_t)u * 128 * 256]; }
#pragma unroll
    for (int u = 0; u < 16; ++u) { vb4[u] = *(const float4*)(pv + (size_t)u * 128 * 256); gb4[u] = *(const float4*)(pg + (size_t)u * 128 * 256); }
#pragma unroll
    for (int u = 0; u < 16; ++u) {
      qr += qb[u]; kr += kb[u];
      vv.x += vb4[u].x; vv.y += vb4[u].y; vv.z += vb4[u].z; vv.w += vb4[u].w;
      gq.x += gb4[u].x; gq.y += gb4[u].y; gq.z += gb4[u].z; gq.w += gb4[u].w;
    }
  }
  qs[t] = qr; ks[t] = kr;
  __syncthreads();
  float qv, kv;
  {
    const float* cosR = (const float*)(p.ws + WS_TRET); const float* sinR = cosR + 8193 * 128;
    const float c = cosR[8192 * 128 + (t >> 1)], sn = sinR[8192 * 128 + (t >> 1)];
    const float oq = qs[t ^ 1], ok_ = ks[t ^ 1];
    const float rq = (t & 1) ? (qr * c + oq * sn) : (qr * c - oq * sn);
    const float rk = (t & 1) ? (kr * c + ok_ * sn) : (kr * c - ok_ * sn);
    const float lg = lg2gamma(hh);
    qv = rq * exp2f(lg); kv = rk * 0.0625f * exp2f(-lg);
  }
  __syncthreads();
  qs[t] = qv; ks[t] = kv;
  const float qk = block_sum(qv * kv, red);
  const float gamma = 1.f - exp2f(-5.f - (float)hh);
  const float4* __restrict__ s0 = (const float4*)(p.in[I_SR] + ((size_t)((j * 128 + b) * 4 + hh) * 256) * 512) + tc;
  float4* __restrict__ so = (float4*)(p.out + O_RSS + ((size_t)((j * 128 + b) * 4 + hh) * 256) * 512) + tc;
  float4 o = make_float4(0.f, 0.f, 0.f, 0.f);
#pragma unroll 1
  for (int d0 = par; d0 < 256; d0 += 16) {
    float4 sv[8];
#pragma unroll
    for (int u = 0; u < 8; ++u) { const f32x4 t4 = __builtin_nontemporal_load((const f32x4*)(s0 + (size_t)(d0 + 2 * u) * 128)); sv[u] = make_float4(t4[0], t4[1], t4[2], t4[3]); }
#pragma unroll
    for (int u = 0; u < 8; ++u) {
      const float q = qs[d0 + 2 * u], k = ks[d0 + 2 * u];
      o.x += q * sv[u].x; o.y += q * sv[u].y; o.z += q * sv[u].z; o.w += q * sv[u].w;
      float4 n; n.x = gamma * (sv[u].x + k * vv.x); n.y = gamma * (sv[u].y + k * vv.y); n.z = gamma * (sv[u].z + k * vv.z); n.w = gamma * (sv[u].w + k * vv.w);
      { f32x4 n4; n4[0] = n.x; n4[1] = n.y; n4[2] = n.z; n4[3] = n.w; __builtin_nontemporal_store(n4, (f32x4*)(so + (size_t)(d0 + 2 * u) * 128)); }
    }
  }
  red4[t] = o;
  __syncthreads();
  float s1 = 0.f;
  if (par == 0) {
    const float4 o2 = red4[t + 128];
    o.x += o2.x + qk * vv.x; o.y += o2.y + qk * vv.y; o.z += o2.z + qk * vv.z; o.w += o2.w + qk * vv.w;
    s1 = o.x + o.y + o.z + o.w;
  }
  const float mu = block_sum(s1, red) * (1.f / 512.f);
  float s2 = 0.f;
  if (par == 0) { o.x -= mu; o.y -= mu; o.z -= mu; o.w -= mu; s2 = o.x * o.x + o.y * o.y + o.z * o.z + o.w * o.w; }
  const float var = block_sum(s2, red) * (1.f / 512.f);
  const float rs = rsqrtf(var + GN_EPS);
  if (par == 0) {
    u16* OB = (u16*)(p.ws + WS_ACT2) + (size_t)(MP + b) * 2048 + hh * 512 + 4 * tc;
    uint2 ov; ov.x = pack2(o.x * rs * silu(gq.x), o.y * rs * silu(gq.y)); ov.y = pack2(o.z * rs * silu(gq.z), o.w * rs * silu(gq.w));
    *(uint2*)OB = ov;
  }
}

DI void phase_ret_u(const Params& p, int layer, u16* lds) {
  const int j = layer >> 1;
  const int half = __builtin_amdgcn_readfirstlane(tid512() >> 8);
  const int G = (int)gridDim.x, gs = G >> 1, br = bid_real();
  if (br < gs) {
    for (int it = br; it < 256; it += gs) ret_sample_item(p, j, 2 * it + half, lds + half * LDS_HALF_E);
  } else {
    for (int it = br - gs; it < 1024; it += G - gs) ret_u_tile(p, it, lds);
  }
}

DI void phase_ret_scan(const Params& p, int layer) {
  const int j = layer >> 1;
  u16* UT = (u16*)(p.ws + WS_US);
  const size_t cstride = 4ull * 512 * 256;
  for (int v = bidx() * 256 + tidx(); v < 131072; v += NVB * 256) {
    const int d8 = v & 31, e = (v >> 5) & 511, hh = (v >> 14) & 3, b = v >> 16;
    u16* base = UT + ((size_t)(b * 64 * 4 + hh) * 512 + e) * 256 + d8 * 8;
    const float cd = exp2f(128.f * lg2gamma(hh));
    float s[8];
#pragma unroll
    for (int k = 0; k < 8; ++k) s[k] = 0.f;
#pragma unroll 1
    for (int c0 = 0; c0 < 64; c0 += 16) {
      uint4 ub[16];
#pragma unroll
      for (int q = 0; q < 16; ++q) ub[q] = *(const uint4*)(base + (size_t)(c0 + q) * cstride);
#pragma unroll
      for (int q = 0; q < 16; ++q) {
        uint4 o; o.x = pack2(s[0], s[1]); o.y = pack2(s[2], s[3]); o.z = pack2(s[4], s[5]); o.w = pack2(s[6], s[7]);
        *(uint4*)(base + (size_t)(c0 + q) * cstride) = o;
        const unsigned us[4] = {ub[q].x, ub[q].y, ub[q].z, ub[q].w};
#pragma unroll
        for (int k = 0; k < 4; ++k) {
          s[2 * k] = cd * (s[2 * k] + __uint_as_float(us[k] << 16));
          s[2 * k + 1] = cd * (s[2 * k + 1] + __uint_as_float(us[k] & 0xffff0000u));
        }
      }
    }
    float* o = p.out + O_RSP + ((size_t)((j * 2 + b) * 4 + hh) * 256 + d8 * 8) * 512 + e;
#pragma unroll
    for (int k = 0; k < 8; ++k) o[(size_t)k * 512] = s[k];
  }
}

DI void ret_out_item(const Params& p, int item, u16* lds) {
  const int rh = item & 1, hh = (item >> 1) & 3, c = (item >> 3) & 63, b = item >> 9;
  const int t = tidx(), lane = t & 63, w = t >> 6, r = lane & 31, h = lane >> 5;
  const size_t row0 = (size_t)b * 8192 + c * 128, trow0 = row0 + rh * 64;
  const u16* QR = (const u16*)(p.ws + R_Q); const u16* KR = (const u16*)(p.ws + R_K);
  const u16* VT = (const u16*)(p.ws + R_VT) + (size_t)(b * 2048 + hh * 512) * 8192 + c * 128;
  const u16* PT = (const u16*)(p.ws + WS_US) + (size_t)((b * 64 + c) * 4 + hh) * 512 * 256;
  u16* inner = lds;
  float* red1 = (float*)lds;
  float* red2 = red1 + 64 * 132;
  float* smu = red2 + 64 * 132;
  float* srs = smu + 64;
  __syncthreads();
  {
    f32x16 T[2];
#pragma unroll
    for (int ib = 0; ib < 2; ++ib)
#pragma unroll
      for (int i = 0; i < 16; ++i) T[ib][i] = 0.f;
    if (rh == 1 || w < 2) {
      const u16* kp = KR + (row0 + 32 * w + r) * 1024 + hh * 256 + h * 8;
      const u16* qp0 = QR + (trow0 + r) * 1024 + hh * 256 + h * 8;
      const u16* qp1 = qp0 + 32 * 1024;
#pragma unroll 4
      for (int ks = 0; ks < 16; ++ks) {
        const bf16x8 a = *(const bf16x8*)(kp + ks * 16);
        T[0] = MFMA(a, *(const bf16x8*)(qp0 + ks * 16), T[0]);
        T[1] = MFMA(a, *(const bf16x8*)(qp1 + ks * 16), T[1]);
      }
    }
#pragma unroll
    for (int ib = 0; ib < 2; ++ib)
#pragma unroll
      for (int g4 = 0; g4 < 4; ++g4) {
        const int il = 32 * ib + r, ig = rh * 64 + il, j0 = 32 * w + 8 * g4 + 4 * h;
        const float v0 = (j0 + 0 <= ig) ? T[ib][4 * g4 + 0] : 0.f, v1 = (j0 + 1 <= ig) ? T[ib][4 * g4 + 1] : 0.f;
        const float v2 = (j0 + 2 <= ig) ? T[ib][4 * g4 + 2] : 0.f, v3 = (j0 + 3 <= ig) ? T[ib][4 * g4 + 3] : 0.f;
        uint2 v; v.x = pack2(v0, v1); v.y = pack2(v2, v3);
        *(uint2*)(inner + il * 136 + j0) = v;
      }
  }
  __syncthreads();
  f32x16 acc[2][4];
#pragma unroll
  for (int rb = 0; rb < 2; ++rb)
#pragma unroll
    for (int eb = 0; eb < 4; ++eb)
#pragma unroll
      for (int i = 0; i < 16; ++i) acc[rb][eb][i] = 0.f;
#define RO_MFMA8() \
      acc[0][0] = MFMA(a0, b0, acc[0][0]); acc[1][0] = MFMA(a1, b0, acc[1][0]); acc[0][1] = MFMA(a0, b1, acc[0][1]); acc[1][1] = MFMA(a1, b1, acc[1][1]); \
      acc[0][2] = MFMA(a0, b2, acc[0][2]); acc[1][2] = MFMA(a1, b2, acc[1][2]); acc[0][3] = MFMA(a0, b3, acc[0][3]); acc[1][3] = MFMA(a1, b3, acc[1][3]);
  {
    const u16* ap = inner + r * 136 + h * 8;
    const u16* bp = VT + (size_t)(128 * w + r) * 8192 + h * 8;
    const int nks = rh ? 8 : 4;
    bf16x8 b0 = *(const bf16x8*)(bp), b1 = *(const bf16x8*)(bp + (size_t)32 * 8192), b2 = *(const bf16x8*)(bp + (size_t)64 * 8192), b3 = *(const bf16x8*)(bp + (size_t)96 * 8192);
#pragma unroll 1
    for (int ks = 0; ks < nks; ++ks) {
      const int kn = (ks + 1 < nks) ? ks + 1 : ks;
      const bf16x8 n0 = *(const bf16x8*)(bp + kn * 16), n1 = *(const bf16x8*)(bp + (size_t)32 * 8192 + kn * 16), n2 = *(const bf16x8*)(bp + (size_t)64 * 8192 + kn * 16), n3 = *(const bf16x8*)(bp + (size_t)96 * 8192 + kn * 16);
      const bf16x8 a0 = *(const bf16x8*)(ap + ks * 16), a1 = *(const bf16x8*)(ap + 32 * 136 + ks * 16);
      __builtin_amdgcn_sched_barrier(0);
      RO_MFMA8()
      b0 = n0; b1 = n1; b2 = n2; b3 = n3;
    }
  }
  {
    const u16* ap = QR + (trow0 + r) * 1024 + hh * 256 + h * 8;
    const u16* bp = PT + (size_t)(128 * w + r) * 256 + h * 8;
    bf16x8 a0 = *(const bf16x8*)(ap), a1 = *(const bf16x8*)(ap + 32 * 1024);
    bf16x8 b0 = *(const bf16x8*)(bp), b1 = *(const bf16x8*)(bp + 32 * 256), b2 = *(const bf16x8*)(bp + 64 * 256), b3 = *(const bf16x8*)(bp + 96 * 256);
    bf16x8 m0 = *(const bf16x8*)(ap + 16), m1 = *(const bf16x8*)(ap + 32 * 1024 + 16);
    bf16x8 n0 = *(const bf16x8*)(bp + 16), n1 = *(const bf16x8*)(bp + 32 * 256 + 16), n2 = *(const bf16x8*)(bp + 64 * 256 + 16), n3 = *(const bf16x8*)(bp + 96 * 256 + 16);
#pragma unroll 1
    for (int ks = 0; ks < 16; ++ks) {
      const int kn = (ks + 2 < 16) ? ks + 2 : 15;
      const bf16x8 x0 = *(const bf16x8*)(ap + kn * 16), x1 = *(const bf16x8*)(ap + 32 * 1024 + kn * 16);
      const bf16x8 y0 = *(const bf16x8*)(bp + kn * 16), y1 = *(const bf16x8*)(bp + 32 * 256 + kn * 16), y2 = *(const bf16x8*)(bp + 64 * 256 + kn * 16), y3 = *(const bf16x8*)(bp + 96 * 256 + kn * 16);
      __builtin_amdgcn_sched_barrier(0);
      RO_MFMA8()
      a0 = m0; a1 = m1; b0 = n0; b1 = n1; b2 = n2; b3 = n3;
      m0 = x0; m1 = x1; n0 = y0; n1 = y1; n2 = y2; n3 = y3;
    }
  }
#undef RO_MFMA8
  __syncthreads();
#pragma unroll
  for (int rb = 0; rb < 2; ++rb)
#pragma unroll
    for (int reg = 0; reg < 16; ++reg) {
      float s1 = 0.f, s2 = 0.f;
#pragma unroll
      for (int eb = 0; eb < 4; ++eb) { const float v = acc[rb][eb][reg]; s1 += v; s2 += v * v; }
      const int row = 32 * rb + crow(reg, h);
      red1[row * 132 + w * 32 + r] = s1; red2[row * 132 + w * 32 + r] = s2;
    }
  __syncthreads();
  {
    const int row = t >> 2, q = t & 3;
    float s1 = 0.f, s2 = 0.f;
#pragma unroll
    for (int k = 0; k < 32; ++k) { s1 += red1[row * 132 + q * 32 + k]; s2 += red2[row * 132 + q * 32 + k]; }
    s1 += __shfl_xor(s1, 1); s2 += __shfl_xor(s2, 1);
    s1 += __shfl_xor(s1, 2); s2 += __shfl_xor(s2, 2);
    const float mu = s1 * (1.f / 512.f);
    const float var = fmaxf(s2 * (1.f / 512.f) - mu * mu, 0.f);
    if (q == 0) { smu[row] = mu; srs[row] = rsqrtf(var + GN_EPS); }
  }
  __syncthreads();
  const u16* __restrict__ GS = (const u16*)(p.ws + R_GS); u16* __restrict__ OB = (u16*)(p.ws + WS_ACT2);
#pragma unroll
  for (int rb = 0; rb < 2; ++rb)
#pragma unroll
    for (int rq = 0; rq < 4; ++rq) {
      u16 gg[4][4];
#pragma unroll
      for (int q = 0; q < 4; ++q)
#pragma unroll
        for (int eb = 0; eb < 4; ++eb) gg[q][eb] = GS[(trow0 + 32 * rb + crow(4 * rq + q, h)) * 2048 + hh * 512 + 128 * w + r + 32 * eb];
#pragma unroll
      for (int q = 0; q < 4; ++q) {
        const int reg = 4 * rq + q, row = 32 * rb + crow(reg, h);
        const float mu = smu[row], rs = srs[row];
        const size_t o = (trow0 + row) * 2048 + hh * 512 + 128 * w + r;
#pragma unroll
        for (int eb = 0; eb < 4; ++eb) OB[o + 32 * eb] = f2bf((acc[rb][eb][reg] - mu) * rs * bf2f(gg[q][eb]));
      }
    }
}

enum { PH_PREP = 0, PH_QKV, PH_ATTN, PH_AO, PH_RIN, PH_RETU, PH_SCAN, PH_RETO, PH_RO, PH_LNM, PH_FIN, PH_CONV, PH_FOUT, PH_LNF };

DI void run_phase(const Params& p, int ph, int layer, u16* lds, int vb, bool noepi = false, bool fuse_ln = false) {
  u16* hl = lds + __builtin_amdgcn_readfirstlane(tid512() >> 8) * LDS_HALF_E;
  switch (ph) {
    case PH_PREP: phase_prep(p, hl); break;
    case PH_QKV: gemm_phase<G_QKV>(p, layer, lds, vb); break;
    case PH_ATTN: phase_attn(p, layer, hl); break;
    case PH_AO: gemm_phase<G_AO>(p, layer, lds, vb, false, fuse_ln); break;
    case PH_RIN: gemm_phase<G_RIN>(p, layer, lds, vb); break;
    case PH_RETU: phase_ret_u(p, layer, lds); break;
    case PH_SCAN: phase_ret_scan(p, layer); break;
    case PH_RETO: for (int item = bidx(); item < 1024; item += NVB) ret_out_item(p, item, hl); break;
    case PH_RO: gemm_phase<G_RO>(p, layer, lds, vb, false, fuse_ln); break;
    case PH_LNM: phase_ln(p, p.in[I_LMG] + layer * 1024, p.in[I_LMB] + layer * 1024, false, (layer & 1) ? 32 : 16); break;
    case PH_FIN: gemm_phase<G_FIN>(p, layer, lds, vb, noepi); break;
    case PH_CONV: phase_conv(p, layer); break;
    case PH_FOUT: gemm_phase<G_FOUT>(p, layer, lds, vb, false, fuse_ln); break;
    case PH_LNF: phase_ln(p, p.in[I_LFG] + layer * 1024, p.in[I_LFB] + layer * 1024, layer == 3, 44); break;
  }
}

#if !MEGA
__global__ void __launch_bounds__(512, 2) k_phase(Params p, int ph, int layer) {
  __shared__ __attribute__((aligned(16))) u16 lds[LDS_BYTES / 2];
  run_phase(p, ph, layer, lds, (int)blockIdx.x);
}

#else
#ifndef PROBE_MASK
#define PROBE_MASK 0
#endif
#ifndef PROBE_NOEPI
#define PROBE_NOEPI 0
#endif
__global__ void __launch_bounds__(512, 2) k_mega(Params p) {
  __shared__ __attribute__((aligned(16))) u16 lds[LDS_BYTES / 2];
  __shared__ uint4 xb_words;
  cg::grid_group grid = cg::this_grid();
  if (__builtin_amdgcn_workitem_id_x() == 0) xb_words = make_uint4(0u, 0u, 0u, (unsigned)__builtin_amdgcn_workgroup_id_x());
  __syncthreads();
  XcdBarrier xb = xcd_barrier_post((unsigned*)(p.ws + WS_BAR), (volatile LAS unsigned*)&xb_words);
  {
    Params q = p;
    asm volatile("" : "+s"(q.out)); asm volatile("" : "+s"(q.ws));
    const int rep0 = ((PROBE_MASK >> PH_PREP) & 1) ? 2 : 1;
    for (int rr = 0; rr < rep0; ++rr) run_phase(q, PH_PREP, 0, lds, 0);
    if (p.ws == nullptr) grid.sync();
    xcd_barrier(xb);
    if (__builtin_amdgcn_workitem_id_x() == 0) {
      unsigned* bar = (unsigned*)(p.ws + WS_BAR);
      const unsigned G = gridDim.x;
      unsigned cnt = 0u, mine = 0u, dense = 0u; bool uni = true;
#pragma unroll
      for (unsigned j = 0; j < 16; ++j) {
        const unsigned c = xb_ld(&bar[XB_XCNT(j)]);
        cnt += (c > 0u) ? 1u : 0u; mine = (j == xb.x) ? c : mine; dense += (j < xb.x && c > 0u) ? 1u : 0u;
        uni = uni && (c == 0u || c * 8u == G);
      }
      const unsigned rank = xb_words.z;
      xb_words.x = mine > 0u ? mine : 1u; xb_words.y = cnt > 0u ? cnt : 1u;
      xb_words.w = (uni && cnt == 8u && rank < (G >> 3)) ? dense * (G >> 3) + rank : (unsigned)__builtin_amdgcn_workgroup_id_x();
    }
    __syncthreads();
  }
#pragma unroll 1
  for (int step = 1; step < 29; ++step) {
    int ph, layer, idx;
    {
      const int s = step - 1;
      if (s < 6) { layer = 0; idx = s; } else if (s < 14) { layer = 1; idx = s - 6; } else if (s < 20) { layer = 2; idx = s - 14; } else { layer = 3; idx = s - 20; }
      if (layer & 1) ph = (idx < 5) ? (PH_RIN + idx) : (PH_FIN + idx - 5);
      else ph = (idx < 3) ? (PH_QKV + idx) : (PH_FIN + idx - 3);
    }
    Params q = p;
#pragma unroll
    for (int i = 0; i < 19; ++i) asm volatile("" : "+s"(q.in[i]));
    asm volatile("" : "+s"(q.out)); asm volatile("" : "+s"(q.ws));
    const int rep = ((PROBE_MASK >> ph) & 1) ? 2 : 1;
    const int vb = (int)xb_words.w;
    for (int rr = 0; rr < rep; ++rr) run_phase(q, ph, layer, lds, vb, PROBE_NOEPI && rr > 0, true);
    if (step < 28) xcd_barrier(xb);
  }
}
#endif

extern "C" void kernel_launch(void* const* d_in, const int* in_sizes, int n_in, void* d_out, int out_size, void* d_ws, size_t ws_size, hipStream_t stream) {
  static int grid_blocks = 0;
  if (!grid_blocks) {
    int dev = 0, cus = 0, per_cu = 0;
    (void)hipGetDevice(&dev);
    (void)hipDeviceGetAttribute(&cus, hipDeviceAttributeMultiprocessorCount, dev);
#if MEGA
    (void)hipOccupancyMaxActiveBlocksPerMultiprocessor(&per_cu, k_mega, 512, 0);
#else
    (void)hipOccupancyMaxActiveBlocksPerMultiprocessor(&per_cu, k_phase, 512, 0);
#endif
    if (per_cu < 1) per_cu = 1;
    if (per_cu > 1) per_cu = 1;
    grid_blocks = cus * per_cu;
    if (n_in != 19 || ws_size < WS_END) fprintf(stderr, "kernel_launch: unexpected n_in %d or ws %zu < %zu\n", n_in, ws_size, (size_t)WS_END);
  }
  Params p{};
  for (int i = 0; i < 19; ++i) p.in[i] = (const float*)d_in[i];
  p.out = (float*)d_out; p.ws = (unsigned char*)d_ws;
#if MEGA
  (void)hipMemsetAsync((unsigned char*)d_ws + WS_BAR, 0, 16384, stream);
  void* args[] = {&p};
  hipError_t e = hipLaunchCooperativeKernel((void*)k_mega, dim3(grid_blocks), dim3(512), args, 0, stream);
  if (e != hipSuccess) fprintf(stderr, "cooperative launch failed: %s (grid %d)\n", hipGetErrorString(e), grid_blocks);
#else
  auto L = [&](int ph, int layer) { hipLaunchKernelGGL(k_phase, dim3(grid_blocks), dim3(512), 0, stream, p, ph, layer); };
  L(PH_PREP, 0);
  for (int layer = 0; layer < 4; ++layer) {
    if ((layer & 1) == 0) { L(PH_QKV, layer); L(PH_ATTN, layer); L(PH_AO, layer); }
    else { L(PH_RIN, layer); L(PH_RETU, layer); L(PH_SCAN, layer); L(PH_RETO, layer); L(PH_RO, layer); }
    L(PH_LNM, layer); L(PH_FIN, layer); L(PH_CONV, layer); L(PH_FOUT, layer); L(PH_LNF, layer);
  }
#endif
}
```

```cpp
#include <hip/hip_runtime.h>
#include <hip/hip_cooperative_groups.h>
#include <cstdio>
namespace cg = cooperative_groups;

#ifndef MEGA
#define MEGA 1
#endif

typedef unsigned short u16;
using f32x4 = __attribute__((ext_vector_type(4))) float;
using bf16x8 = __attribute__((ext_vector_type(8))) short;
using f32x16 = __attribute__((ext_vector_type(16))) float;
#define DI __device__ __forceinline__
#define MFMA(a, b, c) __builtin_amdgcn_mfma_f32_32x32x16_bf16((a), (b), (c), 0, 0, 0)

constexpr int D = 1024, SEQ = 8192, MP = 16384, MS = 128, MT = MP + MS;
constexpr int DFF = 2816;
constexpr float ALPHA = 1.6817928305074290f;
constexpr float LN_EPS = 1e-5f, GN_EPS = 1e-5f;

constexpr size_t O_YP = 0;
constexpr size_t O_YS = O_YP + (size_t)MP * D;
constexpr size_t O_KWP = O_YS + (size_t)MS * D;
constexpr size_t O_VWP = O_KWP + 2ull * 2 * 128 * 256;
constexpr size_t O_RSP = O_VWP + 2ull * 2 * 128 * 256;
constexpr size_t O_CSP = O_RSP + 2ull * 2 * 4 * 256 * 512;
constexpr size_t O_KWS = O_CSP + 4ull * 2 * 2 * DFF;
constexpr size_t O_VWS = O_KWS + 2ull * 128 * 128 * 256;
constexpr size_t O_RSS = O_VWS + 2ull * 128 * 128 * 256;
constexpr size_t O_CSS = O_RSS + 2ull * 128 * 4 * 256 * 512;

constexpr size_t al(size_t x) { return (x + 255) & ~size_t(255); }
constexpr size_t WS_WQKV = 0;
constexpr size_t WS_WAO = WS_WQKV + 2ull * 1536 * 1024 * 2;
constexpr size_t WS_WRIN = WS_WAO + 2ull * 1024 * 1024 * 2;
constexpr size_t WS_WRO = WS_WRIN + 2ull * 6144 * 1024 * 2;
constexpr size_t WS_WFIN = WS_WRO + 2ull * 1024 * 2048 * 2;
constexpr size_t WS_WFOUT = WS_WFIN + 4ull * 5632 * 1024 * 2;
constexpr size_t WS_TROPE = WS_WFOUT + 4ull * 1024 * 2816 * 2;
constexpr size_t WS_TRET = WS_TROPE + al(2ull * 8193 * 32 * 4);
constexpr size_t WS_X = WS_TRET + al(2ull * 8193 * 128 * 4);
constexpr size_t WS_XB = WS_X + (size_t)MT * 1024 * 4;
constexpr size_t WS_Y = WS_XB + (size_t)MT * 1024 * 2;
constexpr size_t WS_ACT = WS_Y + (size_t)MT * 1024 * 4;
constexpr size_t WS_ACT2 = WS_ACT + 268435456ull;
constexpr size_t WS_US = WS_ACT2 + (size_t)MT * 2816 * 2;
constexpr size_t WS_SMP = WS_US + 134217728ull;
constexpr size_t WS_BAR = WS_SMP + 128ull * 4096 * 4;
constexpr size_t WS_PART = WS_BAR + 16384;
constexpr size_t WS_PART2 = WS_PART + 4ull * 44 * 128 * 256 * 4;
constexpr size_t WS_END = WS_PART2 + 24ull * 16 * 128 * 256 * 4;
constexpr size_t A_Q = WS_ACT;
constexpr size_t A_K = A_Q + (size_t)MT * 1024 * 2;
constexpr size_t A_VT = A_K + (size_t)MP * 256 * 2;
constexpr size_t R_Q = WS_ACT;
constexpr size_t R_K = R_Q + (size_t)MT * 1024 * 2;
constexpr size_t R_KT = R_K + (size_t)MT * 1024 * 2;
constexpr size_t R_VT = R_KT + 2ull * 1024 * 8192 * 2;
constexpr size_t R_GS = R_VT + 2ull * 2048 * 8192 * 2;
static_assert(R_GS + (size_t)MT * 2048 * 2 <= WS_ACT2, "act region");
constexpr size_t F_UA = WS_ACT;
constexpr size_t F_UG = F_UA + (size_t)MT * 2816 * 2;

struct Params {
  const float* in[19];
  float* out;
  unsigned char* ws;
};
enum { I_XP = 0, I_XS, I_CK, I_CV, I_SR, I_SC, I_WQKV, I_SINK, I_WAO, I_WRIN, I_WRO, I_WFIN, I_CW, I_CB, I_WFOUT, I_LMG, I_LMB, I_LFG, I_LFB };

DI int tid512() { int t = __builtin_amdgcn_workitem_id_x(); asm volatile("" : "+v"(t)); return t; }
DI int bid_real() { int b = __builtin_amdgcn_workgroup_id_x(); asm volatile("" : "+s"(b)); return b; }
DI int tidx() { return tid512() & 255; }
DI int bidx() { return 2 * bid_real() + __builtin_amdgcn_readfirstlane(tid512() >> 8); }
#define NVB (2 * (int)gridDim.x)
DI u16 f2bf(float x) { return __builtin_bit_cast(u16, (__bf16)x); }
DI float bf2f(u16 v) { return __uint_as_float(((unsigned)v) << 16); }
DI unsigned pack2(float a, float b) { return (unsigned)f2bf(a) | ((unsigned)f2bf(b) << 16); }
DI int crow(int reg, int h) { return (reg & 3) + 8 * (reg >> 2) + 4 * h; }
DI float silu(float x) { return x / (1.f + __expf(-x)); }
DI float lg2gamma(int hh) { return hh == 0 ? -0.04580368961312479f : hh == 1 ? -0.02272007650008353f : hh == 2 ? -0.011315313227834146f : -0.005646563141142063f; }

DI float wave_max(float v) {
#pragma unroll
  for (int o = 32; o >= 1; o >>= 1) v = fmaxf(v, __shfl_xor(v, o));
  return v;
}
DI float wave_sum(float v) {
#pragma unroll
  for (int o = 32; o >= 1; o >>= 1) v += __shfl_xor(v, o);
  return v;
}

DI void sincos_d(double x, float& s, float& c) {
  const double n = rint(x * 0.63661977236758134308);
  double r = fma(-n, 1.57079632673412561417e+00, x);
  r = fma(-n, 6.07710050650619224932e-11, r);
  const double r2 = r * r;
  double sp = 1.0 / 6227020800.0;
  sp = fma(sp, r2, -1.0 / 39916800.0); sp = fma(sp, r2, 1.0 / 362880.0); sp = fma(sp, r2, -1.0 / 5040.0);
  sp = fma(sp, r2, 1.0 / 120.0); sp = fma(sp, r2, -1.0 / 6.0); sp = fma(sp, r2, 1.0);
  const double sn = sp * r;
  double cp = -1.0 / 87178291200.0;
  cp = fma(cp, r2, 1.0 / 479001600.0); cp = fma(cp, r2, -1.0 / 3628800.0); cp = fma(cp, r2, 1.0 / 40320.0);
  cp = fma(cp, r2, -1.0 / 720.0); cp = fma(cp, r2, 1.0 / 24.0); cp = fma(cp, r2, -0.5); cp = fma(cp, r2, 1.0);
  const int q = ((int)n) & 3;
  const double ss = (q & 1) ? cp : sn, cc = (q & 1) ? sn : cp;
  s = (float)((q == 2 || q == 3) ? -ss : ss);
  c = (float)((q == 1 || q == 2) ? -cc : cc);
}

constexpr int LSTR = 72;
constexpr int TILE_E = 256 * LSTR;
constexpr int LDS_BYTES = 4 * TILE_E * 2;
constexpr int LDS_HALF_E = LDS_BYTES / 4;

DI void gemm_core(const u16* __restrict__ A, size_t lda, const u16* __restrict__ Bt, size_t ldb, int K, u16* lds, f32x16 (&acc)[4][2]) {
  const int t = tid512(), lane = t & 63, w = t >> 6, wm = w >> 2, wn = w & 3, r = lane & 31, h = lane >> 5;
  u16* As = lds; u16* Bs = lds + 2 * TILE_E;
  const int lrow = t >> 3, lk = (t & 7) * 8;
  const u16* Ag = A + (size_t)lrow * lda + lk;
  const u16* Bg = Bt + (size_t)lrow * ldb + lk;
#define GLOAD(P, ko) \
  P##a0 = *(const uint4*)(Ag + (ko)); P##a1 = *(const uint4*)(Ag + (size_t)64 * lda + (ko)); P##a2 = *(const uint4*)(Ag + (size_t)128 * lda + (ko)); P##a3 = *(const uint4*)(Ag + (size_t)192 * lda + (ko)); \
  P##b0 = *(const uint4*)(Bg + (ko)); P##b1 = *(const uint4*)(Bg + (size_t)64 * ldb + (ko)); P##b2 = *(const uint4*)(Bg + (size_t)128 * ldb + (ko)); P##b3 = *(const uint4*)(Bg + (size_t)192 * ldb + (ko));
#define LSTORE(P, buf) { u16* ad_ = As + (buf) * TILE_E + lrow * LSTR + lk; u16* bd_ = Bs + (buf) * TILE_E + lrow * LSTR + lk; \
  *(uint4*)(ad_) = P##a0; *(uint4*)(ad_ + 64 * LSTR) = P##a1; *(uint4*)(ad_ + 128 * LSTR) = P##a2; *(uint4*)(ad_ + 192 * LSTR) = P##a3; \
  *(uint4*)(bd_) = P##b0; *(uint4*)(bd_ + 64 * LSTR) = P##b1; *(uint4*)(bd_ + 128 * LSTR) = P##b2; *(uint4*)(bd_ + 192 * LSTR) = P##b3; }
#define COMPUTE(buf) { \
    const u16* as = As + (buf) * TILE_E + (wm * 128 + r) * LSTR + h * 8; \
    const u16* bs = Bs + (buf) * TILE_E + (wn * 64 + r) * LSTR + h * 8; \
    _Pragma("unroll") for (int kk = 0; kk < 4; ++kk) { \
      const bf16x8 b0 = *(const bf16x8*)(bs + kk * 16), b1 = *(const bf16x8*)(bs + 32 * LSTR + kk * 16); \
      _Pragma("unroll") for (int mi = 0; mi < 4; ++mi) { \
        const bf16x8 a = *(const bf16x8*)(as + mi * 32 * LSTR + kk * 16); \
        acc[mi][0] = MFMA(a, b0, acc[mi][0]); acc[mi][1] = MFMA(a, b1, acc[mi][1]); } } }
  uint4 pa0, pa1, pa2, pa3, pb0, pb1, pb2, pb3;
  const int nk = K >> 6;
  {
    uint4 qa0, qa1, qa2, qa3, qb0, qb1, qb2, qb3;
    GLOAD(q, 0)
    if (nk > 1) { GLOAD(p, 64) }
    __syncthreads();
    LSTORE(q, 0)
  }
#pragma unroll
  for (int a = 0; a < 4; ++a)
#pragma unroll
    for (int b = 0; b < 2; ++b)
#pragma unroll
      for (int i = 0; i < 16; ++i) acc[a][b][i] = 0.f;
  __syncthreads();
#pragma unroll 1
  for (int kt = 0; kt < nk; ++kt) {
    const int buf = kt & 1;
    if (kt + 1 < nk) LSTORE(p, buf ^ 1)
    if (kt + 2 < nk) { const int ko = (kt + 2) << 6; GLOAD(p, ko) }
    __builtin_amdgcn_sched_barrier(0);
    COMPUTE(buf)
    __syncthreads();
  }
#undef COMPUTE
#undef GLOAD
#undef LSTORE
}

DI void epi_qkv(const Params& p, int j, f32x16 (&acc)[2][2], int mb, int nb, int lane) {
  const int r = lane & 31, h = lane >> 5, slot = nb >> 6;
  const float* cosT = (const float*)(p.ws + WS_TROPE); const float* sinT = cosT + 8193 * 32;
  const bool smp = mb >= MP;
  if (slot < 20) {
    u16* Q = (u16*)(p.ws + A_Q); u16* KB = (u16*)(p.ws + A_K);
#pragma unroll
    for (int mi = 0; mi < 2; ++mi) {
      float cc[16], ss[16];
#pragma unroll
      for (int reg = 0; reg < 16; ++reg) {
        const int row = mb + mi * 32 + crow(reg, h);
        const int pos = smp ? 8192 : (row & 8191);
        cc[reg] = cosT[pos * 32 + r]; ss[reg] = sinT[pos * 32 + r];
      }
#pragma unroll
      for (int reg = 0; reg < 16; ++reg) {
        const int row = mb + mi * 32 + crow(reg, h);
        const int pos = smp ? 8192 : (row & 8191);
        const float c = cc[reg], s = ss[reg];
        const float x1 = acc[mi][0][reg], x2 = acc[mi][1][reg];
        const float o1 = x1 * c - x2 * s, o2 = x2 * c + x1 * s;
        if (slot < 16) {
          Q[(size_t)row * 1024 + nb + r] = f2bf(o1 * 0.125f); Q[(size_t)row * 1024 + nb + 32 + r] = f2bf(o2 * 0.125f);
        } else {
          const int kvh = slot - 16;
          if (!smp) {
            KB[(size_t)row * 256 + kvh * 64 + r] = f2bf(o1); KB[(size_t)row * 256 + kvh * 64 + 32 + r] = f2bf(o2);
            if (pos >= 8064) { const int b = row >> 13; float* o = p.out + O_KWP + ((size_t)((j * 2 + b) * 128 + (pos - 8064)) * 4 + kvh) * 64; o[r] = o1; o[32 + r] = o2; }
          } else {
            const int b = row - MP; float* o = p.out + O_KWS + ((size_t)((j * 128 + b) * 128 + 127) * 4 + kvh) * 64; o[r] = o1; o[32 + r] = o2;
          }
        }
      }
    }
  } else {
    const int kvh = slot - 20;
    if (!smp) {
      u16* VT = (u16*)(p.ws + A_VT);
      const int b = mb >> 13;
#pragma unroll
      for (int mi = 0; mi < 2; ++mi)
#pragma unroll
        for (int ni = 0; ni < 2; ++ni)
#pragma unroll
          for (int g4 = 0; g4 < 4; ++g4) {
            const int t0 = (mb & 8191) + mi * 32 + 8 * g4 + 4 * h, d = ni * 32 + r;
            uint2 v; v.x = pack2(acc[mi][ni][4 * g4], acc[mi][ni][4 * g4 + 1]); v.y = pack2(acc[mi][ni][4 * g4 + 2], acc[mi][ni][4 * g4 + 3]);
            *(uint2*)(VT + (size_t)(b * 256 + kvh * 64 + d) * 8192 + t0) = v;
            if (t0 >= 8064) {
#pragma unroll
              for (int q = 0; q < 4; ++q) p.out[O_VWP + ((size_t)((j * 2 + b) * 128 + (t0 + q - 8064)) * 4 + kvh) * 64 + d] = acc[mi][ni][4 * g4 + q];
            }
          }
    } else {
#pragma unroll
      for (int mi = 0; mi < 2; ++mi)
#pragma unroll
        for (int ni = 0; ni < 2; ++ni)
#pragma unroll
          for (int reg = 0; reg < 16; ++reg) {
            const int b = mb - MP + mi * 32 + crow(reg, h);
            p.out[O_VWS + ((size_t)((j * 128 + b) * 128 + 127) * 4 + kvh) * 64 + ni * 32 + r] = acc[mi][ni][reg];
          }
    }
  }
}

DI void epi_res(const Params& p, f32x16 (&acc)[2][2], int mb, int nb, int lane) {
  const int r = lane & 31, h = lane >> 5;
  const float* __restrict__ X = (const float*)(p.ws + WS_X); float* __restrict__ Y = (float*)(p.ws + WS_Y);
#pragma unroll
  for (int mi = 0; mi < 2; ++mi) {
    float xv[2][16];
#pragma unroll
    for (int ni = 0; ni < 2; ++ni)
#pragma unroll
      for (int reg = 0; reg < 16; ++reg) xv[ni][reg] = X[(size_t)(mb + mi * 32 + crow(reg, h)) * 1024 + nb + ni * 32 + r];
#pragma unroll
    for (int ni = 0; ni < 2; ++ni)
#pragma unroll
      for (int reg = 0; reg < 16; ++reg) Y[(size_t)(mb + mi * 32 + crow(reg, h)) * 1024 + nb + ni * 32 + r] = ALPHA * xv[ni][reg] + acc[mi][ni][reg];
  }
}

DI void epi_rin(const Params& p, int j, f32x16 (&acc)[2][2], int mb, int nb, int lane) {
  const int r = lane & 31, h = lane >> 5, slot = nb >> 6;
  const bool smp = mb >= MP;
  const int b = mb >> 13;
  if (slot < 32) {
    const bool isq = slot < 16;
    const int hh = (slot & 15) >> 2, cbase = nb & 255, ncol = nb & 1023;
    const float lg = lg2gamma(hh);
    const float* cosR = (const float*)(p.ws + WS_TRET); const float* sinR = cosR + 8193 * 128;
#pragma unroll
    for (int mi = 0; mi < 2; ++mi)
#pragma unroll
      for (int ni = 0; ni < 2; ++ni) {
        const int pidx = (cbase + ni * 32 + r) >> 1;
        float cc[16], ss[16];
#pragma unroll
        for (int reg = 0; reg < 16; ++reg) {
          const int row = mb + mi * 32 + crow(reg, h);
          const int pos = smp ? 8192 : (row & 8191);
          cc[reg] = cosR[pos * 128 + pidx]; ss[reg] = sinR[pos * 128 + pidx];
        }
#pragma unroll
        for (int reg = 0; reg < 16; ++reg) {
          const int row = mb + mi * 32 + crow(reg, h);
          const int pos = smp ? 8192 : (row & 8191);
          const float mine = acc[mi][ni][reg], other = __shfl_xor(mine, 1);
          const float rot = (r & 1) ? (mine * cc[reg] + other * ss[reg]) : (mine * cc[reg] - other * ss[reg]);
          const float e = (float)((smp ? 0 : (pos & 127)) + 1) * lg;
          acc[mi][ni][reg] = isq ? rot * exp2f(e) : rot * 0.0625f * exp2f(-e);
        }
        __builtin_amdgcn_sched_barrier(0);
      }
    if (smp) {
      float* S = (float*)(p.ws + WS_SMP) + (isq ? 0 : 128 * 1024);
#pragma unroll
      for (int mi = 0; mi < 2; ++mi)
#pragma unroll
        for (int ni = 0; ni < 2; ++ni)
#pragma unroll
          for (int reg = 0; reg < 16; ++reg)
            S[(size_t)(mb - MP + mi * 32 + crow(reg, h)) * 1024 + ncol + ni * 32 + r] = acc[mi][ni][reg];
    } else {
      u16* N = (u16*)(p.ws + (isq ? R_Q : R_K));
#pragma unroll
      for (int mi = 0; mi < 2; ++mi)
#pragma unroll
        for (int ni = 0; ni < 2; ++ni)
#pragma unroll
          for (int reg = 0; reg < 16; ++reg)
            N[(size_t)(mb + mi * 32 + crow(reg, h)) * 1024 + ncol + ni * 32 + r] = f2bf(acc[mi][ni][reg]);
      if (!isq) {
        u16* KT = (u16*)(p.ws + R_KT);
#pragma unroll
        for (int mi = 0; mi < 2; ++mi)
#pragma unroll
          for (int ni = 0; ni < 2; ++ni)
#pragma unroll
            for (int g4 = 0; g4 < 4; ++g4) {
              const int t0 = (mb & 8191) + mi * 32 + 8 * g4 + 4 * h;
              uint2 v; v.x = pack2(acc[mi][ni][4 * g4], acc[mi][ni][4 * g4 + 1]); v.y = pack2(acc[mi][ni][4 * g4 + 2], acc[mi][ni][4 * g4 + 3]);
              *(uint2*)(KT + (size_t)(b * 1024 + ncol + ni * 32 + r) * 8192 + t0) = v;
            }
      }
    }
  } else if (slot < 64) {
    const int cv = nb - 2048;
    if (smp) {
      float* SV = (float*)(p.ws + WS_SMP) + 2 * 128 * 1024;
#pragma unroll
      for (int mi = 0; mi < 2; ++mi)
#pragma unroll
        for (int ni = 0; ni < 2; ++ni)
#pragma unroll
          for (int reg = 0; reg < 16; ++reg)
            SV[(size_t)(mb - MP + mi * 32 + crow(reg, h)) * 2048 + cv + ni * 32 + r] = acc[mi][ni][reg];
    } else {
      u16* VT = (u16*)(p.ws + R_VT);
#pragma unroll
      for (int mi = 0; mi < 2; ++mi)
#pragma unroll
        for (int ni = 0; ni < 2; ++ni)
#pragma unroll
          for (int g4 = 0; g4 < 4; ++g4) {
            const int t0 = (mb & 8191) + mi * 32 + 8 * g4 + 4 * h;
            uint2 v; v.x = pack2(acc[mi][ni][4 * g4], acc[mi][ni][4 * g4 + 1]); v.y = pack2(acc[mi][ni][4 * g4 + 2], acc[mi][ni][4 * g4 + 3]);
            *(uint2*)(VT + (size_t)(b * 2048 + cv + ni * 32 + r) * 8192 + t0) = v;
          }
    }
  } else {
    u16* GS = (u16*)(p.ws + R_GS);
    const int cg_ = nb - 4096;
#pragma unroll
    for (int mi = 0; mi < 2; ++mi)
#pragma unroll
      for (int ni = 0; ni < 2; ++ni)
#pragma unroll
        for (int reg = 0; reg < 16; ++reg)
          GS[(size_t)(mb + mi * 32 + crow(reg, h)) * 2048 + cg_ + ni * 32 + r] = f2bf(silu(acc[mi][ni][reg]));
  }
}

DI void epi_fin(const Params& p, int i, f32x16 (&acc)[2][2], int mb, int nb, int lane) {
  const int r = lane & 31, h = lane >> 5;
  const bool smp = mb >= MP;
  if (nb < DFF) {
    u16* UA = (u16*)(p.ws + F_UA);
#pragma unroll
    for (int mi = 0; mi < 2; ++mi)
#pragma unroll
      for (int ni = 0; ni < 2; ++ni)
#pragma unroll
        for (int reg = 0; reg < 16; ++reg) {
          const int row = mb + mi * 32 + crow(reg, h), col = nb + ni * 32 + r;
          const float v = acc[mi][ni][reg];
          UA[(size_t)row * DFF + col] = f2bf(v);
          if (smp) {
            p.out[O_CSS + ((size_t)(i * 128 + (row - MP)) * 2 + 1) * DFF + col] = v;
          } else {
            const int pos = row & 8191;
            if (pos >= 8190) p.out[O_CSP + ((size_t)(i * 2 + (row >> 13)) * 2 + (pos - 8190)) * DFF + col] = v;
          }
        }
  } else {
    u16* UG = (u16*)(p.ws + F_UG);
#pragma unroll
    for (int mi = 0; mi < 2; ++mi)
#pragma unroll
      for (int ni = 0; ni < 2; ++ni)
#pragma unroll
        for (int reg = 0; reg < 16; ++reg)
          UG[(size_t)(mb + mi * 32 + crow(reg, h)) * DFF + (nb - DFF) + ni * 32 + r] = f2bf(acc[mi][ni][reg]);
  }
}

#define XB_TMO      128
#define XB_XCNT(j)  (256  + 64 * (j))
#define XB_XSUB(j)  (1280 + 64 * (j))
#define XB_XGEN(j)  (2304 + 64 * (j))
#define XB_TOP      3328
#define XB_TOPGEN   3392
#define XCD_BAR_WORDS 3456
#define XB_SPIN_CAP (1u << 20)
#define LAS __attribute__((address_space(3)))
DI unsigned xb_ld(unsigned* p) { return __hip_atomic_load(p, __ATOMIC_RELAXED, __HIP_MEMORY_SCOPE_AGENT); }
DI unsigned xb_add(unsigned* p, unsigned v) { return __hip_atomic_fetch_add(p, v, __ATOMIC_RELAXED, __HIP_MEMORY_SCOPE_AGENT); }
DI unsigned xb_xcc_id() { return (unsigned)__builtin_amdgcn_s_getreg((3 << 11) | 20) & 0xFu; }
#define XB_SPIN(cond, bar) do { unsigned _sp = 0; while (cond) { __builtin_amdgcn_s_sleep(1); \
    if ((++_sp & 255u) == 0u) { if (xb_ld(&(bar)[XB_TMO])) break; if (_sp > XB_SPIN_CAP) { atomicAdd(&(bar)[XB_TMO], 1u); break; } } } } while (0)
struct XcdBarrier { unsigned* bar; unsigned x; volatile LAS unsigned* st; };
DI XcdBarrier xcd_barrier_post(unsigned* bar, volatile LAS unsigned* st) {
  XcdBarrier b; b.bar = bar; b.x = xb_xcc_id(); b.st = st;
  if (__builtin_amdgcn_workitem_id_x() == 0) st[2] = xb_add(&bar[XB_XCNT(b.x)], 1u);
  return b;
}
DI void xcd_barrier_complete(unsigned* bar, unsigned x, unsigned& nloc, unsigned& nx) {
  const unsigned G = gridDim.x;
  unsigned sum, cnt, mine, sp = 0u;
  for (;;) {
    sum = 0u; cnt = 0u; mine = 0u;
#pragma unroll
    for (unsigned j = 0; j < 16; ++j) { const unsigned c = xb_ld(&bar[XB_XCNT(j)]); sum += c; cnt += (c > 0u) ? 1u : 0u; mine = (j == x) ? c : mine; }
    if (sum == G) break;
    __builtin_amdgcn_s_sleep(1);
    if ((++sp & 255u) == 0u) { if (xb_ld(&bar[XB_TMO])) break; if (sp > XB_SPIN_CAP) { atomicAdd(&bar[XB_TMO], 1u); break; } }
  }
  nloc = mine > 0u ? mine : 1u; nx = cnt > 0u ? cnt : 1u;
}
DI void xcd_barrier(const XcdBarrier& b) {
  asm volatile("s_waitcnt vmcnt(0)" ::: "memory");
  __syncthreads();
  if (__builtin_amdgcn_workitem_id_x() == 0) {
    unsigned* bar = b.bar;
    __builtin_amdgcn_s_waitcnt(0);
    unsigned nloc = b.st[0], nx = b.st[1];
    if (nloc == 0u) { xcd_barrier_complete(bar, b.x, nloc, nx); b.st[0] = nloc; b.st[1] = nx; }
    const unsigned old = xb_add(&bar[XB_XSUB(b.x)], 1u);
    const unsigned gen = old / nloc;
    if (old + 1u == (gen + 1u) * nloc) {
      __builtin_amdgcn_fence(__ATOMIC_RELEASE, "agent");
      asm volatile("s_waitcnt vmcnt(0)" ::: "memory");
      const unsigned og = xb_add(&bar[XB_TOP], 1u);
      const unsigned tg = og / nx;
      if (og + 1u == (tg + 1u) * nx) xb_add(&bar[XB_TOPGEN], 1u);
      else XB_SPIN(xb_ld(&bar[XB_TOPGEN]) == tg, bar);
      __builtin_amdgcn_fence(__ATOMIC_ACQUIRE, "agent");
      xb_add(&bar[XB_XGEN(b.x)], 1u);
      asm volatile("s_waitcnt vmcnt(0)" ::: "memory");
    } else {
      XB_SPIN(xb_ld(&bar[XB_XGEN(b.x)]) == gen, bar);
      __builtin_amdgcn_fence(__ATOMIC_ACQUIRE, "agent");
      asm volatile("s_waitcnt vmcnt(0)" ::: "memory");
    }
  }
  __syncthreads();
}

DI void signal_cnt(unsigned* c) {
  asm volatile("s_waitcnt vmcnt(0)" ::: "memory");
  __syncthreads();
  if (__builtin_amdgcn_workitem_id_x() == 0) { __builtin_amdgcn_fence(__ATOMIC_RELEASE, "agent"); asm volatile("s_waitcnt vmcnt(0)" ::: "memory"); (void)xb_add(c, 1u); }
}
DI void wait_cnt(unsigned* c, unsigned target, unsigned* bar) {
  if (__builtin_amdgcn_workitem_id_x() == 0) { XB_SPIN(xb_ld(c) < target, bar); __builtin_amdgcn_fence(__ATOMIC_ACQUIRE, "agent"); asm volatile("s_waitcnt vmcnt(0)" ::: "memory"); }
  __syncthreads();
}
constexpr int LN_CNT_WORD0 = XCD_BAR_WORDS;

DI void ln_row(const Params& p, int row, const float4 (&gv)[4], const float4 (&bv)[4], bool last, int nkk, int lane) {
  const float* Y = (const float*)(p.ws + WS_Y);
  float* X = (float*)(p.ws + WS_X); u16* XB = (u16*)(p.ws + WS_XB);
  float4 v[4];
  if (row < MP) {
    const float4* y = (const float4*)(Y + (size_t)row * 1024);
#pragma unroll
    for (int i = 0; i < 4; ++i) v[i] = y[lane + 64 * i];
  } else {
    const float4* x = (const float4*)(X + (size_t)row * 1024);
#pragma unroll
    for (int i = 0; i < 4; ++i) { const float4 t = x[lane + 64 * i]; v[i].x = ALPHA * t.x; v[i].y = ALPHA * t.y; v[i].z = ALPHA * t.z; v[i].w = ALPHA * t.w; }
    const float* __restrict__ PART = (const float*)(p.ws + WS_PART);
    for (int ks = 0; ks < nkk; ks += 4) {
      float4 t[4][4];
#pragma unroll
      for (int u = 0; u < 4; ++u)
#pragma unroll
        for (int i = 0; i < 4; ++i)
          t[u][i] = *(const float4*)(PART + ((size_t)(i * nkk + ks + u) * 128 + (row - MP)) * 256 + lane * 4);
#pragma unroll
      for (int u = 0; u < 4; ++u)
#pragma unroll
        for (int i = 0; i < 4; ++i) { v[i].x += t[u][i].x; v[i].y += t[u][i].y; v[i].z += t[u][i].z; v[i].w += t[u][i].w; }
    }
  }
  float sm = 0.f;
#pragma unroll
  for (int i = 0; i < 4; ++i) sm += v[i].x + v[i].y + v[i].z + v[i].w;
  const float mu = wave_sum(sm) * (1.f / 1024.f);
  float q = 0.f;
#pragma unroll
  for (int i = 0; i < 4; ++i) { v[i].x -= mu; v[i].y -= mu; v[i].z -= mu; v[i].w -= mu; q += v[i].x * v[i].x + v[i].y * v[i].y + v[i].z * v[i].z + v[i].w * v[i].w; }
  const float rs = rsqrtf(wave_sum(q) * (1.f / 1024.f) + LN_EPS);
  float4* xo = last ? (float4*)(p.out + (row < MP ? O_YP + (size_t)row * 1024 : O_YS + (size_t)(row - MP) * 1024)) : (float4*)(X + (size_t)row * 1024);
#pragma unroll
  for (int i = 0; i < 4; ++i) {
    float4 o;
    o.x = v[i].x * rs * gv[i].x + bv[i].x; o.y = v[i].y * rs * gv[i].y + bv[i].y;
    o.z = v[i].z * rs * gv[i].z + bv[i].z; o.w = v[i].w * rs * gv[i].w + bv[i].w;
    xo[lane + 64 * i] = o;
    if (!last) { uint2 ob; ob.x = pack2(o.x, o.y); ob.y = pack2(o.z, o.w); *(uint2*)(XB + (size_t)row * 1024 + (lane + 64 * i) * 4) = ob; }
  }
}
DI void ln_rows4(const Params& p, int row0, const float4 (&gv)[4], const float4 (&bv)[4], bool last, int lane) {
  const float* Y = (const float*)(p.ws + WS_Y);
  float* X = (float*)(p.ws + WS_X); u16* XB = (u16*)(p.ws + WS_XB);
  float4 v[4][4];
#pragma unroll
  for (int q = 0; q < 4; ++q)
#pragma unroll
    for (int i = 0; i < 4; ++i) v[q][i] = ((const float4*)(Y + (size_t)(row0 + q) * 1024))[lane + 64 * i];
  float sm[4];
#pragma unroll
  for (int q = 0; q < 4; ++q) { sm[q] = 0.f;
#pragma unroll
    for (int i = 0; i < 4; ++i) sm[q] += v[q][i].x + v[q][i].y + v[q][i].z + v[q][i].w; }
#pragma unroll
  for (int o = 32; o >= 1; o >>= 1)
#pragma unroll
    for (int q = 0; q < 4; ++q) sm[q] += __shfl_xor(sm[q], o);
  float qq[4];
#pragma unroll
  for (int q = 0; q < 4; ++q) { const float mu = sm[q] * (1.f / 1024.f); qq[q] = 0.f;
#pragma unroll
    for (int i = 0; i < 4; ++i) { v[q][i].x -= mu; v[q][i].y -= mu; v[q][i].z -= mu; v[q][i].w -= mu; qq[q] += v[q][i].x * v[q][i].x + v[q][i].y * v[q][i].y + v[q][i].z * v[q][i].z + v[q][i].w * v[q][i].w; } }
#pragma unroll
  for (int o = 32; o >= 1; o >>= 1)
#pragma unroll
    for (int q = 0; q < 4; ++q) qq[q] += __shfl_xor(qq[q], o);
#pragma unroll
  for (int q = 0; q < 4; ++q) {
    const int row = row0 + q;
    const float rs = rsqrtf(qq[q] * (1.f / 1024.f) + LN_EPS);
    float4* xo = last ? (float4*)(p.out + O_YP + (size_t)row * 1024) : (float4*)(X + (size_t)row * 1024);
#pragma unroll
    for (int i = 0; i < 4; ++i) {
      float4 o;
      o.x = v[q][i].x * rs * gv[i].x + bv[i].x; o.y = v[q][i].y * rs * gv[i].y + bv[i].y;
      o.z = v[q][i].z * rs * gv[i].z + bv[i].z; o.w = v[q][i].w * rs * gv[i].w + bv[i].w;
      xo[lane + 64 * i] = o;
      if (!last) { uint2 ob; ob.x = pack2(o.x, o.y); ob.y = pack2(o.z, o.w); *(uint2*)(XB + (size_t)row * 1024 + (lane + 64 * i) * 4) = ob; }
    }
  }
}
DI void phase_ln(const Params& p, const float* __restrict__ gam, const float* __restrict__ bet, bool last, int nkk) {
  const int lane = tidx() & 63;
  const int wid = bidx() * 4 + (tidx() >> 6), nw = NVB * 4;
  float4 gv[4], bv[4];
#pragma unroll
  for (int i = 0; i < 4; ++i) { gv[i] = ((const float4*)gam)[lane + 64 * i]; bv[i] = ((const float4*)bet)[lane + 64 * i]; }
  for (int rr = wid; rr < MT; rr += nw) ln_row(p, rr < MS ? MP + rr : rr - MS, gv, bv, last, nkk, lane);
}

enum { G_QKV, G_AO, G_RIN, G_RO, G_FIN, G_FOUT };
template <int G>
DI void gemm_phase(const Params& p, int layer, u16* lds, int vb, bool noepi = false, bool fuse_ln = false) {
  const int j = layer >> 1;
  const u16* A; const u16* Bt; int K, N;
  if (G == G_QKV) { A = (const u16*)(p.ws + WS_XB); Bt = (const u16*)(p.ws + WS_WQKV) + (size_t)j * 1536 * 1024; K = 1024; N = 1536; }
  else if (G == G_AO) { A = (const u16*)(p.ws + WS_ACT2); Bt = (const u16*)(p.ws + WS_WAO) + (size_t)j * 1024 * 1024; K = 1024; N = 1024; }
  else if (G == G_RIN) { A = (const u16*)(p.ws + WS_XB); Bt = (const u16*)(p.ws + WS_WRIN) + (size_t)j * 6144 * 1024; K = 1024; N = 6144; }
  else if (G == G_RO) { A = (const u16*)(p.ws + WS_ACT2); Bt = (const u16*)(p.ws + WS_WRO) + (size_t)j * 1024 * 2048; K = 2048; N = 1024; }
  else if (G == G_FIN) { A = (const u16*)(p.ws + WS_XB); Bt = (const u16*)(p.ws + WS_WFIN) + (size_t)layer * 5632 * 1024; K = 1024; N = 5632; }
  else { A = (const u16*)(p.ws + WS_ACT2); Bt = (const u16*)(p.ws + WS_WFOUT) + (size_t)layer * 1024 * 2816; K = 2816; N = 1024; }
  constexpr bool LNF = (G == G_AO || G == G_RO || G == G_FOUT);
  constexpr bool SPLIT = LNF || (G == G_RIN);
  const int ntn = N >> 8, ntiles = (SPLIT ? 64 : 65) * ntn;
  const int t = tid512(), lane = t & 63, w = t >> 6, wm = w >> 2, wn = w & 3;
  const int per = (int)gridDim.x >> 3;
  const int xcd = vb / per, rank = vb - xcd * per;
  const int lo = (int)(((long long)xcd * ntiles) >> 3), hi = (int)(((long long)(xcd + 1) * ntiles) >> 3);
  for (int L = lo + rank; L < hi; L += per) {
    int tm, tn;
    const int full = 64 * ntn;
    if (L < full) { const int sr = L / (8 * ntn), rem = L - sr * 8 * ntn; tn = rem >> 3; tm = 8 * sr + (rem & 7); }
    else { tn = L - full; tm = 64; }
    f32x16 acc[4][2];
    gemm_core(A + (size_t)tm * 256 * K, K, Bt + (size_t)tn * 256 * K, K, K, lds, acc);
    if (tm == 64 && wm == 1) continue;
    if (noepi) { float sacc = 0.f;
#pragma unroll
      for (int a = 0; a < 4; ++a)
#pragma unroll
        for (int b = 0; b < 2; ++b)
#pragma unroll
          for (int i = 0; i < 16; ++i) sacc += acc[a][b][i];
      if (sacc == 1.2345e30f) p.out[0] = 0.f; continue; }
    const int nb = tn * 256 + wn * 64;
    float* park = (float*)lds + w * 4096 + lane;
#pragma unroll
    for (int mi = 0; mi < 2; ++mi)
#pragma unroll
      for (int ni = 0; ni < 2; ++ni)
#pragma unroll
        for (int i = 0; i < 16; ++i) park[(mi * 32 + ni * 16 + i) * 64] = acc[2 + mi][ni][i];
    f32x16 ac[2][2];
    ac[0][0] = acc[0][0]; ac[0][1] = acc[0][1]; ac[1][0] = acc[1][0]; ac[1][1] = acc[1][1];
#pragma unroll 1
    for (int hf = 0; hf < 2; ++hf) {
      if (hf) {
#pragma unroll
        for (int mi = 0; mi < 2; ++mi)
#pragma unroll
          for (int ni = 0; ni < 2; ++ni)
#pragma unroll
            for (int i = 0; i < 16; ++i) ac[mi][ni][i] = park[(mi * 32 + ni * 16 + i) * 64];
      }
      const int mb = tm * 256 + wm * 128 + hf * 64;
      if (G == G_QKV) epi_qkv(p, j, ac, mb, nb, lane);
      else if (G == G_RIN) epi_rin(p, j, ac, mb, nb, lane);
      else if (G == G_FIN) epi_fin(p, layer, ac, mb, nb, lane);
      else epi_res(p, ac, mb, nb, lane);
    }
    if (LNF && fuse_ln) signal_cnt((unsigned*)(p.ws + WS_BAR) + LN_CNT_WORD0 + (layer * 2 + (G == G_FOUT ? 1 : 0)) * 65 + tm);
  }
  if (SPLIT) {
    const int nkk = K >> 6, r = lane & 31, h = lane >> 5;
    float* PART = (float*)(p.ws + (LNF ? WS_PART : WS_PART2));
    for (int e = vb; e < ntn * nkk; e += (int)gridDim.x) {
      const int tn = e / nkk, ks = e - tn * nkk;
      f32x16 acc[4][2];
      gemm_core(A + (size_t)MP * K + ks * 64, K, Bt + (size_t)tn * 256 * K + ks * 64, K, 64, lds, acc);
      if (wm == 0) {
        float* o = PART + (size_t)e * 128 * 256 + wn * 64 + r;
#pragma unroll
        for (int mi = 0; mi < 4; ++mi)
#pragma unroll
          for (int ni = 0; ni < 2; ++ni)
#pragma unroll
            for (int i = 0; i < 16; ++i) o[(size_t)(mi * 32 + crow(i, h)) * 256 + ni * 32] = acc[mi][ni][i];
      }
      if (LNF && fuse_ln) signal_cnt((unsigned*)(p.ws + WS_BAR) + LN_CNT_WORD0 + (layer * 2 + (G == G_FOUT ? 1 : 0)) * 65 + 64);
    }
    if (LNF && fuse_ln) {
      unsigned* bar = (unsigned*)(p.ws + WS_BAR);
      unsigned* cnt = bar + LN_CNT_WORD0 + (layer * 2 + (G == G_FOUT ? 1 : 0)) * 65;
      const float* gam = (G == G_FOUT ? p.in[I_LFG] : p.in[I_LMG]) + layer * 1024;
      const float* bet = (G == G_FOUT ? p.in[I_LFB] : p.in[I_LMB]) + layer * 1024;
      const bool last = (G == G_FOUT) && layer == 3;
      float4 gv[4], bv[4];
#pragma unroll
      for (int i = 0; i < 4; ++i) { gv[i] = ((const float4*)gam)[lane + 64 * i]; bv[i] = ((const float4*)bet)[lane + 64 * i]; }
      for (int L = lo + rank; L < hi; L += per) {
        const int sr = L / (8 * ntn), rem = L - sr * 8 * ntn, tn = rem >> 3, tm = 8 * sr + (rem & 7);
        wait_cnt(cnt + tm, 4u, bar);
        ln_rows4(p, tm * 256 + tn * 64 + w * 8, gv, bv, last, lane);
        ln_rows4(p, tm * 256 + tn * 64 + w * 8 + 4, gv, bv, last, lane);
      }
      const int G_ = (int)gridDim.x;
      if (vb >= G_ - 16) {
        wait_cnt(cnt + 64, (unsigned)(4 * nkk), bar);
        ln_row(p, MP + (vb - (G_ - 16)) * 8 + w, gv, bv, last, nkk, lane);
      }
    }
  }
}

DI void transpose_job(const float* __restrict__ src, u16* __restrict__ dst, int K, int N, float* tl) {
  const int t = tidx();
  const int tn = N >> 6, ntiles = (K >> 6) * tn;
  for (int tile = bidx(); tile < ntiles; tile += NVB) {
    const int k0 = (tile / tn) << 6, n0 = (tile % tn) << 6;
    __syncthreads();
#pragma unroll
    for (int i = 0; i < 16; ++i) { const int k = (t >> 6) + 4 * i; tl[k * 65 + (t & 63)] = src[(size_t)(k0 + k) * N + n0 + (t & 63)]; }
    __syncthreads();
    const int n = t >> 2, kq = (t & 3) * 16;
    uint4 v0, v1;
    v0.x = pack2(tl[(kq + 0) * 65 + n], tl[(kq + 1) * 65 + n]); v0.y = pack2(tl[(kq + 2) * 65 + n], tl[(kq + 3) * 65 + n]);
    v0.z = pack2(tl[(kq + 4) * 65 + n], tl[(kq + 5) * 65 + n]); v0.w = pack2(tl[(kq + 6) * 65 + n], tl[(kq + 7) * 65 + n]);
    v1.x = pack2(tl[(kq + 8) * 65 + n], tl[(kq + 9) * 65 + n]); v1.y = pack2(tl[(kq + 10) * 65 + n], tl[(kq + 11) * 65 + n]);
    v1.z = pack2(tl[(kq + 12) * 65 + n], tl[(kq + 13) * 65 + n]); v1.w = pack2(tl[(kq + 14) * 65 + n], tl[(kq + 15) * 65 + n]);
    u16* o = dst + (size_t)(n0 + n) * K + k0 + kq;
    *(uint4*)o = v0; *(uint4*)(o + 8) = v1;
  }
}

DI void phase_prep(const Params& p, u16* lds) {
  float* tl = (float*)lds;
  for (int j = 0; j < 2; ++j) {
    transpose_job(p.in[I_WQKV] + (size_t)j * 1024 * 1536, (u16*)(p.ws + WS_WQKV) + (size_t)j * 1536 * 1024, 1024, 1536, tl);
    transpose_job(p.in[I_WAO] + (size_t)j * 1024 * 1024, (u16*)(p.ws + WS_WAO) + (size_t)j * 1024 * 1024, 1024, 1024, tl);
    transpose_job(p.in[I_WRIN] + (size_t)j * 1024 * 6144, (u16*)(p.ws + WS_WRIN) + (size_t)j * 6144 * 1024, 1024, 6144, tl);
    transpose_job(p.in[I_WRO] + (size_t)j * 2048 * 1024, (u16*)(p.ws + WS_WRO) + (size_t)j * 1024 * 2048, 2048, 1024, tl);
  }
  for (int i = 0; i < 4; ++i) {
    transpose_job(p.in[I_WFIN] + (size_t)i * 1024 * 5632, (u16*)(p.ws + WS_WFIN) + (size_t)i * 5632 * 1024, 1024, 5632, tl);
    transpose_job(p.in[I_WFOUT] + (size_t)i * 2816 * 1024, (u16*)(p.ws + WS_WFOUT) + (size_t)i * 1024 * 2816, 2816, 1024, tl);
  }
  const size_t gid = (size_t)bidx() * 256 + tidx(), gstride = (size_t)NVB * 256;
  {
    float4* X = (float4*)(p.ws + WS_X); uint2* XB = (uint2*)(p.ws + WS_XB);
    const size_t nv = (size_t)MT * 256, npv = (size_t)MP * 256;
    for (size_t v0 = gid; v0 < nv; v0 += 4 * gstride) {
      float4 xb[4];
#pragma unroll
      for (int u = 0; u < 4; ++u) { const size_t v = v0 + u * gstride; if (v < nv) xb[u] = (v < npv) ? ((const float4*)p.in[I_XP])[v] : ((const float4*)p.in[I_XS])[v - npv]; }
#pragma unroll
      for (int u = 0; u < 4; ++u) { const size_t v = v0 + u * gstride; if (v < nv) { X[v] = xb[u]; uint2 o; o.x = pack2(xb[u].x, xb[u].y); o.y = pack2(xb[u].z, xb[u].w); XB[v] = o; } }
    }
  }
  {
    float* cosT = (float*)(p.ws + WS_TROPE); float* sinT = cosT + 8193 * 32;
    for (size_t v = gid; v < 8193ull * 32; v += gstride) {
      const int pos = (int)(v >> 5), i = (int)(v & 31);
      const double inv = exp(-9.210340371976182736 * (double)i / 32.0);
      float s, c; sincos_d((double)pos * inv, s, c); cosT[v] = c; sinT[v] = s;
    }
    float* cosR = (float*)(p.ws + WS_TRET); float* sinR = cosR + 8193 * 128;
    for (size_t v = gid; v < 8193ull * 128; v += gstride) {
      const int pos = (int)(v >> 7), i = (int)(v & 127);
      const double inv = exp(-9.210340371976182736 * (double)i / 127.0);
      float s, c; sincos_d((double)pos * inv, s, c); cosR[v] = c; sinR[v] = s;
    }
  }
}

DI void attn_prompt_item(const Params& p, int j, int item, u16* lds) {
  const int g = item & 3, kvh = (item >> 2) & 3, qb = (item >> 4) & 63, b = item >> 10;
  const int head = kvh * 4 + g;
  const int t = tidx(), lane = t & 63, w = t >> 6, r = lane & 31, h = lane >> 5;
  u16* Ks = lds;
  u16* Vts = lds + 256 * 72;
  const u16* Q = (const u16*)(p.ws + A_Q); const u16* KB = (const u16*)(p.ws + A_K); const u16* VT = (const u16*)(p.ws + A_VT);
  u16* OB = (u16*)(p.ws + WS_ACT2);
  const int tok0 = qb * 128 - 128;
  __syncthreads();
#pragma unroll
  for (int i = 0; i < 8; ++i) {
    const int c = t + 256 * i, key = c >> 3, part = c & 7, tok = tok0 + key;
    uint4 v = make_uint4(0, 0, 0, 0);
    if (tok >= 0) v = *(const uint4*)(KB + (size_t)(b * 8192 + tok) * 256 + kvh * 64 + part * 8);
    *(uint4*)(Ks + key * 72 + part * 8) = v;
  }
#pragma unroll
  for (int i = 0; i < 8; ++i) {
    const int c = t + 256 * i, d = c >> 5, part = c & 31, tok = tok0 + part * 8;
    uint4 v = make_uint4(0, 0, 0, 0);
    if (tok >= 0) v = *(const uint4*)(VT + (size_t)(b * 256 + kvh * 64 + d) * 8192 + tok);
    *(uint4*)(Vts + d * 264 + part * 8) = v;
  }
  const size_t qrow = (size_t)b * 8192 + qb * 128 + 32 * w + r;
  bf16x8 bq[4];
#pragma unroll
  for (int kk = 0; kk < 4; ++kk) bq[kk] = *(const bf16x8*)(Q + qrow * 1024 + head * 64 + kk * 16 + h * 8);
  __syncthreads();
  f32x16 S[5];
#pragma unroll
  for (int jb = 0; jb < 5; ++jb) {
#pragma unroll
    for (int i = 0; i < 16; ++i) S[jb][i] = 0.f;
    const u16* kp = Ks + (32 * (w + jb) + r) * 72 + h * 8;
#pragma unroll
    for (int kk = 0; kk < 4; ++kk) S[jb] = MFMA(*(const bf16x8*)(kp + kk * 16), bq[kk], S[jb]);
  }
  const float sink = p.in[I_SINK][j * 16 + head];
  float m = -INFINITY;
#pragma unroll
  for (int jb = 0; jb < 5; ++jb)
#pragma unroll
    for (int reg = 0; reg < 16; ++reg) {
      const int cr = crow(reg, h);
      const int rel = 128 + r - 32 * jb - cr;
      const bool valid = (rel >= 0) && (rel <= 128) && (qb > 0 || (32 * (w + jb) + cr) >= 128);
      const float s = valid ? S[jb][reg] : -INFINITY;
      S[jb][reg] = s; m = fmaxf(m, s);
    }
  m = fmaxf(m, __shfl_xor(m, 32));
  m = fmaxf(m, sink);
  float l = 0.f;
#pragma unroll
  for (int jb = 0; jb < 5; ++jb)
#pragma unroll
    for (int reg = 0; reg < 16; ++reg) { const float e = __expf(S[jb][reg] - m); S[jb][reg] = e; l += e; }
  l += __shfl_xor(l, 32);
  const float inv = 1.f / (l + __expf(sink - m));
  f32x16 O[2];
#pragma unroll
  for (int db = 0; db < 2; ++db)
#pragma unroll
    for (int i = 0; i < 16; ++i) O[db][i] = 0.f;
#pragma unroll
  for (int jb = 0; jb < 5; ++jb)
#pragma unroll
    for (int s = 0; s < 2; ++s) {
      uint4 pb;
      pb.x = pack2(S[jb][8 * s + 0], S[jb][8 * s + 1]); pb.y = pack2(S[jb][8 * s + 2], S[jb][8 * s + 3]);
      pb.z = pack2(S[jb][8 * s + 4], S[jb][8 * s + 5]); pb.w = pack2(S[jb][8 * s + 6], S[jb][8 * s + 7]);
      const bf16x8 bfrag = __builtin_bit_cast(bf16x8, pb);
#pragma unroll
      for (int db = 0; db < 2; ++db) {
        const u16* vp = Vts + (32 * db + r) * 264 + 32 * (w + jb) + 16 * s + 4 * h;
        const uint2 lo = *(const uint2*)vp, hi = *(const uint2*)(vp + 8);
        uint4 av; av.x = lo.x; av.y = lo.y; av.z = hi.x; av.w = hi.y;
        O[db] = MFMA(__builtin_bit_cast(bf16x8, av), bfrag, O[db]);
      }
    }
#pragma unroll
  for (int db = 0; db < 2; ++db)
#pragma unroll
    for (int g4 = 0; g4 < 4; ++g4) {
      uint2 v; v.x = pack2(O[db][4 * g4] * inv, O[db][4 * g4 + 1] * inv); v.y = pack2(O[db][4 * g4 + 2] * inv, O[db][4 * g4 + 3] * inv);
      *(uint2*)(OB + qrow * 1024 + head * 64 + 32 * db + 8 * g4 + 4 * h) = v;
    }
}

DI void attn_sample_item(const Params& p, int j, int item, u16* lds) {
  const int kvh = item & 3, b = item >> 2;
  const int t = tidx(), lane = t & 63, g = t >> 6;
  float* Kc = (float*)lds;
  float* Vc = Kc + 129 * 65;
  float* qs = Vc + 129 * 65;
  float* ps = qs + 256;
  const float* ck = p.in[I_CK] + (size_t)(j * 128 + b) * 128 * 256;
  const float* cv = p.in[I_CV] + (size_t)(j * 128 + b) * 128 * 256;
  float* ok = p.out + O_KWS + (size_t)(j * 128 + b) * 128 * 256;
  float* ov = p.out + O_VWS + (size_t)(j * 128 + b) * 128 * 256;
  __syncthreads();
  {
    const int d = t & 63, w0 = t >> 6;
#pragma unroll 1
    for (int i0 = 0; i0 < 32; i0 += 8) {
      float kb[8], vb[8];
#pragma unroll
      for (int u = 0; u < 8; ++u) { const int wq = w0 + 4 * (i0 + u); kb[u] = ck[wq * 256 + kvh * 64 + d]; vb[u] = cv[wq * 256 + kvh * 64 + d]; }
#pragma unroll
      for (int u = 0; u < 8; ++u) {
        const int wq = w0 + 4 * (i0 + u);
        Kc[wq * 65 + d] = kb[u]; Vc[wq * 65 + d] = vb[u];
        if (wq >= 1) { ok[(wq - 1) * 256 + kvh * 64 + d] = kb[u]; ov[(wq - 1) * 256 + kvh * 64 + d] = vb[u]; }
      }
    }
  }
  if (t < 64) { Kc[128 * 65 + t] = ok[127 * 256 + kvh * 64 + t]; Vc[128 * 65 + t] = ov[127 * 256 + kvh * 64 + t]; }
  qs[t] = bf2f(((const u16*)(p.ws + A_Q))[(size_t)(MP + b) * 1024 + (kvh * 4 + g) * 64 + lane]);
  __syncthreads();
  const float sink = p.in[I_SINK][j * 16 + kvh * 4 + g];
  float s0 = 0.f, s1 = 0.f, s2 = 0.f;
#pragma unroll 8
  for (int d = 0; d < 64; ++d) {
    const float q = qs[g * 64 + d];
    s0 += q * Kc[lane * 65 + d]; s1 += q * Kc[(lane + 64) * 65 + d]; s2 += q * Kc[128 * 65 + d];
  }
  float m = fmaxf(fmaxf(s0, s1), s2);
  m = fmaxf(wave_max(m), sink);
  const float e0 = __expf(s0 - m), e1 = __expf(s1 - m), e2 = __expf(s2 - m);
  float l = wave_sum(e0 + e1) + e2;
  const float inv = 1.f / (l + __expf(sink - m));
  ps[g * 132 + lane] = e0 * inv; ps[g * 132 + 64 + lane] = e1 * inv;
  if (lane == 0) ps[g * 132 + 128] = e2 * inv;
  __syncthreads();
  float o = 0.f;
#pragma unroll 4
  for (int k = 0; k < 129; ++k) o += ps[g * 132 + k] * Vc[k * 65 + lane];
  ((u16*)(p.ws + WS_ACT2))[(size_t)(MP + b) * 1024 + (kvh * 4 + g) * 64 + lane] = f2bf(o);
}

DI void phase_attn(const Params& p, int layer, u16* lds) {
  const int j = layer >> 1;
  for (int item = bidx(); item < 2048 + 512; item += NVB) {
    if (item < 2048) attn_prompt_item(p, j, item, lds);
    else attn_sample_item(p, j, item - 2048, lds);
  }
}

DI void unpack8(const uint4 x, float (&o)[8]) {
  o[0] = __uint_as_float(x.x << 16); o[1] = __uint_as_float(x.x & 0xffff0000u); o[2] = __uint_as_float(x.y << 16); o[3] = __uint_as_float(x.y & 0xffff0000u);
  o[4] = __uint_as_float(x.z << 16); o[5] = __uint_as_float(x.z & 0xffff0000u); o[6] = __uint_as_float(x.w << 16); o[7] = __uint_as_float(x.w & 0xffff0000u);
}
DI void phase_conv(const Params& p, int i) {
  const u16* __restrict__ UA = (const u16*)(p.ws + F_UA); const u16* __restrict__ UG = (const u16*)(p.ws + F_UG);
  u16* __restrict__ H = (u16*)(p.ws + WS_ACT2);
  const float* cw = p.in[I_CW] + (size_t)i * 3 * DFF; const float* cb = p.in[I_CB] + (size_t)i * DFF;
  const float* sc = p.in[I_SC] + (size_t)i * 128 * 2 * DFF;
  const int gid = bidx() * 256 + tidx(), gstride = NVB * 256;
  for (int it = gid; it < 1024 * 352 + 128 * 352; it += gstride) {
    const bool smp = it >= 1024 * 352;
    const int it2 = smp ? it - 1024 * 352 : it;
    const int ch = it2 / 352, f = (it2 - ch * 352) * 8, row0 = smp ? MP + ch : ch * 16;
    float w0[8], w1[8], w2[8], bb[8];
#pragma unroll
    for (int k = 0; k < 8; ++k) { w0[k] = cw[f + k]; w1[k] = cw[DFF + f + k]; w2[k] = cw[2 * DFF + f + k]; bb[k] = cb[f + k]; }
    if (!smp) {
      float a1[8], a2[8];
      const int pos0 = row0 & 8191;
      if (pos0 >= 2) { unpack8(*(const uint4*)(UA + (size_t)(row0 - 1) * DFF + f), a1); unpack8(*(const uint4*)(UA + (size_t)(row0 - 2) * DFF + f), a2); }
      else {
#pragma unroll
        for (int k = 0; k < 8; ++k) { a1[k] = 0.f; a2[k] = 0.f; }
      }
#pragma unroll 1
      for (int rr = 0; rr < 16; rr += 4) {
        const size_t o = (size_t)(row0 + rr) * DFF + f;
        uint4 xa[4], xg[4];
#pragma unroll
        for (int u = 0; u < 4; ++u) { xa[u] = *(const uint4*)(UA + o + (size_t)u * DFF); xg[u] = *(const uint4*)(UG + o + (size_t)u * DFF); }
#pragma unroll
        for (int u = 0; u < 4; ++u) {
          float a0[8], gg[8];
          unpack8(xa[u], a0); unpack8(xg[u], gg);
          unsigned ho[4];
#pragma unroll
          for (int k = 0; k < 4; ++k) {
            const float c0 = bb[2 * k] + a2[2 * k] * w0[2 * k] + a1[2 * k] * w1[2 * k] + a0[2 * k] * w2[2 * k];
            const float c1 = bb[2 * k + 1] + a2[2 * k + 1] * w0[2 * k + 1] + a1[2 * k + 1] * w1[2 * k + 1] + a0[2 * k + 1] * w2[2 * k + 1];
            ho[k] = pack2(silu(c0) * gg[2 * k], silu(c1) * gg[2 * k + 1]);
          }
          *(uint4*)(H + o + (size_t)u * DFF) = make_uint4(ho[0], ho[1], ho[2], ho[3]);
#pragma unroll
          for (int k = 0; k < 8; ++k) { a2[k] = a1[k]; a1[k] = a0[k]; }
        }
      }
    } else {
      const int b = row0 - MP;
      const size_t o = (size_t)row0 * DFF + f;
      float a0[8], gg[8];
      unpack8(*(const uint4*)(UA + o), a0); unpack8(*(const uint4*)(UG + o), gg);
      const float4* s0p = (const float4*)(sc + (size_t)(b * 2 + 0) * DFF + f); const float4* s1p = (const float4*)(sc + (size_t)(b * 2 + 1) * DFF + f);
      float4* o0 = (float4*)(p.out + O_CSS + ((size_t)(i * 128 + b) * 2 + 0) * DFF + f);
      const float4 p0 = s0p[0], p1 = s0p[1], q0 = s1p[0], q1 = s1p[1];
      o0[0] = q0; o0[1] = q1;
      const float x2[8] = {p0.x, p0.y, p0.z, p0.w, p1.x, p1.y, p1.z, p1.w}, x1[8] = {q0.x, q0.y, q0.z, q0.w, q1.x, q1.y, q1.z, q1.w};
      unsigned ho[4];
#pragma unroll
      for (int k = 0; k < 4; ++k) {
        const float c0 = bb[2 * k] + x2[2 * k] * w0[2 * k] + x1[2 * k] * w1[2 * k] + a0[2 * k] * w2[2 * k];
        const float c1 = bb[2 * k + 1] + x2[2 * k + 1] * w0[2 * k + 1] + x1[2 * k + 1] * w1[2 * k + 1] + a0[2 * k + 1] * w2[2 * k + 1];
        ho[k] = pack2(silu(c0) * gg[2 * k], silu(c1) * gg[2 * k + 1]);
      }
      *(uint4*)(H + o) = make_uint4(ho[0], ho[1], ho[2], ho[3]);
    }
  }
}

DI void ret_u_tile(const Params& p, int tile, u16* lds) {
  const int te = tile & 1, hh = (tile >> 1) & 3, c = (tile >> 3) & 63, b = tile >> 9;
  const u16* VT = (const u16*)(p.ws + R_VT) + (size_t)(b * 2048 + hh * 512 + te * 256) * 8192 + c * 128;
  const u16* KT = (const u16*)(p.ws + R_KT) + (size_t)(b * 1024 + hh * 256) * 8192 + c * 128;
  f32x16 acc[4][2];
  gemm_core(VT, 8192, KT, 8192, 128, lds, acc);
  const int t = tid512(), lane = t & 63, w = t >> 6, wm = w >> 2, wn = w & 3, r = lane & 31, h = lane >> 5;
  u16* UT = (u16*)(p.ws + WS_US) + (size_t)((b * 64 + c) * 4 + hh) * 512 * 256;
#pragma unroll
  for (int mi = 0; mi < 4; ++mi)
#pragma unroll
    for (int ni = 0; ni < 2; ++ni)
#pragma unroll
      for (int reg = 0; reg < 16; ++reg)
        UT[(size_t)(te * 256 + wm * 128 + mi * 32 + crow(reg, h)) * 256 + wn * 64 + ni * 32 + r] = f2bf(acc[mi][ni][reg]);
}

DI float block_sum(float v, float* red) {
  v = wave_sum(v);
  __syncthreads();
  if ((tidx() & 63) == 0) red[tidx() >> 6] = v;
  __syncthreads();
  return red[0] + red[1] + red[2] + red[3];
}

DI void ret_sample_item(const Params& p, int j, int item, u16* lds) {
  const int hh = item & 3, b = item >> 2, t = tidx(), tc = t & 127, par = t >> 7;
  float* qs = (float*)lds; float* ks = qs + 256; float* red = ks + 256; float4* red4 = (float4*)(red + 8);
  const float* __restrict__ P2 = (const float*)(p.ws + WS_PART2);
  __syncthreads();
  float qr = 0.f, kr = 0.f;
  float4 vv = make_float4(0.f, 0.f, 0.f, 0.f), gq = make_float4(0.f, 0.f, 0.f, 0.f);
  {
    const float* pq = P2 + ((size_t)(hh * 16) * 128 + b) * 256 + t;
    const float* pk = P2 + ((size_t)((4 + hh) * 16) * 128 + b) * 256 + t;
    const float* pv = P2 + ((size_t)((8 + 2 * hh + (tc >> 6)) * 16) * 128 + b) * 256 + ((4 * tc) & 255);
    const float* pg = P2 + ((size_t)((16 + 2 * hh + (tc >> 6)) * 16) * 128 + b) * 256 + ((4 * tc) & 255);
    float qb[16], kb[16]; float4 vb4[16], gb4[16];
#pragma unroll
    for (int u = 0; u < 16; ++u) { qb[u] = pq[(size_t)u * 128 * 256]; kb[u] = pk[(size_t)u * 128 * 256]; }
#pragma unroll
    for (int u = 0; u < 16; ++u) { vb4[u] = *(const float4*)(pv + (size_t)u * 128 * 256); gb4[u] = *(const float4*)(pg + (size_t)u * 128 * 256); }
#pragma unroll
    for (int u = 0; u < 16; ++u) {
      qr += qb[u]; kr += kb[u];
      vv.x += vb4[u].x; vv.y += vb4[u].y; vv.z += vb4[u].z; vv.w += vb4[u].w;
      gq.x += gb4[u].x; gq.y += gb4[u].y; gq.z += gb4[u].z; gq.w += gb4[u].w;
    }
  }
  qs[t] = qr; ks[t] = kr;
  __syncthreads();
  float qv, kv;
  {
    const float* cosR = (const float*)(p.ws + WS_TRET); const float* sinR = cosR + 8193 * 128;
    const float c = cosR[8192 * 128 + (t >> 1)], sn = sinR[8192 * 128 + (t >> 1)];
    const float oq = qs[t ^ 1], ok_ = ks[t ^ 1];
    const float rq = (t & 1) ? (qr * c + oq * sn) : (qr * c - oq * sn);
    const float rk = (t & 1) ? (kr * c + ok_ * sn) : (kr * c - ok_ * sn);
    const float lg = lg2gamma(hh);
    qv = rq * exp2f(lg); kv = rk * 0.0625f * exp2f(-lg);
  }
  __syncthreads();
  qs[t] = qv; ks[t] = kv;
  const float qk = block_sum(qv * kv, red);
  const float gamma = 1.f - exp2f(-5.f - (float)hh);
  const float4* __restrict__ s0 = (const float4*)(p.in[I_SR] + ((size_t)((j * 128 + b) * 4 + hh) * 256) * 512) + tc;
  float4* __restrict__ so = (float4*)(p.out + O_RSS + ((size_t)((j * 128 + b) * 4 + hh) * 256) * 512) + tc;
  float4 o = make_float4(0.f, 0.f, 0.f, 0.f);
#pragma unroll 1
  for (int d0 = par; d0 < 256; d0 += 16) {
    float4 sv[8];
#pragma unroll
    for (int u = 0; u < 8; ++u) { const f32x4 t4 = __builtin_nontemporal_load((const f32x4*)(s0 + (size_t)(d0 + 2 * u) * 128)); sv[u] = make_float4(t4[0], t4[1], t4[2], t4[3]); }
#pragma unroll
    for (int u = 0; u < 8; ++u) {
      const float q = qs[d0 + 2 * u], k = ks[d0 + 2 * u];
      o.x += q * sv[u].x; o.y += q * sv[u].y; o.z += q * sv[u].z; o.w += q * sv[u].w;
      float4 n; n.x = gamma * (sv[u].x + k * vv.x); n.y = gamma * (sv[u].y + k * vv.y); n.z = gamma * (sv[u].z + k * vv.z); n.w = gamma * (sv[u].w + k * vv.w);
      { f32x4 n4; n4[0] = n.x; n4[1] = n.y; n4[2] = n.z; n4[3] = n.w; __builtin_nontemporal_store(n4, (f32x4*)(so + (size_t)(d0 + 2 * u) * 128)); }
    }
  }
  red4[t] = o;
  __syncthreads();
  float s1 = 0.f;
  if (par == 0) {
    const float4 o2 = red4[t + 128];
    o.x += o2.x + qk * vv.x; o.y += o2.y + qk * vv.y; o.z += o2.z + qk * vv.z; o.w += o2.w + qk * vv.w;
    s1 = o.x + o.y + o.z + o.w;
  }
  const float mu = block_sum(s1, red) * (1.f / 512.f);
  float s2 = 0.f;
  if (par == 0) { o.x -= mu; o.y -= mu; o.z -= mu; o.w -= mu; s2 = o.x * o.x + o.y * o.y + o.z * o.z + o.w * o.w; }
  const float var = block_sum(s2, red) * (1.f / 512.f);
  const float rs = rsqrtf(var + GN_EPS);
  if (par == 0) {
    u16* OB = (u16*)(p.ws + WS_ACT2) + (size_t)(MP + b) * 2048 + hh * 512 + 4 * tc;
    uint2 ov; ov.x = pack2(o.x * rs * silu(gq.x), o.y * rs * silu(gq.y)); ov.y = pack2(o.z * rs * silu(gq.z), o.w * rs * silu(gq.w));
    *(uint2*)OB = ov;
  }
}

DI void phase_ret_u(const Params& p, int layer, u16* lds) {
  const int j = layer >> 1;
  const int half = __builtin_amdgcn_readfirstlane(tid512() >> 8);
  const int G = (int)gridDim.x, gs = G >> 1, br = bid_real();
  if (br < gs) {
    for (int it = br; it < 256; it += gs) ret_sample_item(p, j, 2 * it + half, lds + half * LDS_HALF_E);
  } else {
    for (int it = br - gs; it < 1024; it += G - gs) ret_u_tile(p, it, lds);
  }
}

DI void phase_ret_scan(const Params& p, int layer) {
  const int j = layer >> 1;
  u16* UT = (u16*)(p.ws + WS_US);
  const size_t cstride = 4ull * 512 * 256;
  for (int v = bidx() * 256 + tidx(); v < 131072; v += NVB * 256) {
    const int d8 = v & 31, e = (v >> 5) & 511, hh = (v >> 14) & 3, b = v >> 16;
    u16* base = UT + ((size_t)(b * 64 * 4 + hh) * 512 + e) * 256 + d8 * 8;
    const float cd = exp2f(128.f * lg2gamma(hh));
    float s[8];
#pragma unroll
    for (int k = 0; k < 8; ++k) s[k] = 0.f;
#pragma unroll 1
    for (int c0 = 0; c0 < 64; c0 += 16) {
      uint4 ub[16];
#pragma unroll
      for (int q = 0; q < 16; ++q) ub[q] = *(const uint4*)(base + (size_t)(c0 + q) * cstride);
#pragma unroll
      for (int q = 0; q < 16; ++q) {
        uint4 o; o.x = pack2(s[0], s[1]); o.y = pack2(s[2], s[3]); o.z = pack2(s[4], s[5]); o.w = pack2(s[6], s[7]);
        *(uint4*)(base + (size_t)(c0 + q) * cstride) = o;
        const unsigned us[4] = {ub[q].x, ub[q].y, ub[q].z, ub[q].w};
#pragma unroll
        for (int k = 0; k < 4; ++k) {
          s[2 * k] = cd * (s[2 * k] + __uint_as_float(us[k] << 16));
          s[2 * k + 1] = cd * (s[2 * k + 1] + __uint_as_float(us[k] & 0xffff0000u));
        }
      }
    }
    float* o = p.out + O_RSP + ((size_t)((j * 2 + b) * 4 + hh) * 256 + d8 * 8) * 512 + e;
#pragma unroll
    for (int k = 0; k < 8; ++k) o[(size_t)k * 512] = s[k];
  }
}

DI void ret_out_item(const Params& p, int item, u16* lds) {
  const int rh = item & 1, hh = (item >> 1) & 3, c = (item >> 3) & 63, b = item >> 9;
  const int t = tidx(), lane = t & 63, w = t >> 6, r = lane & 31, h = lane >> 5;
  const size_t row0 = (size_t)b * 8192 + c * 128, trow0 = row0 + rh * 64;
  const u16* QR = (const u16*)(p.ws + R_Q); const u16* KR = (const u16*)(p.ws + R_K);
  const u16* VT = (const u16*)(p.ws + R_VT) + (size_t)(b * 2048 + hh * 512) * 8192 + c * 128;
  const u16* PT = (const u16*)(p.ws + WS_US) + (size_t)((b * 64 + c) * 4 + hh) * 512 * 256;
  u16* inner = lds;
  float* red1 = (float*)lds;
  float* red2 = red1 + 64 * 132;
  float* smu = red2 + 64 * 132;
  float* srs = smu + 64;
  __syncthreads();
  {
    f32x16 T[2];
#pragma unroll
    for (int ib = 0; ib < 2; ++ib)
#pragma unroll
      for (int i = 0; i < 16; ++i) T[ib][i] = 0.f;
    if (rh == 1 || w < 2) {
      const u16* kp = KR + (row0 + 32 * w + r) * 1024 + hh * 256 + h * 8;
      const u16* qp0 = QR + (trow0 + r) * 1024 + hh * 256 + h * 8;
      const u16* qp1 = qp0 + 32 * 1024;
#pragma unroll 4
      for (int ks = 0; ks < 16; ++ks) {
        const bf16x8 a = *(const bf16x8*)(kp + ks * 16);
        T[0] = MFMA(a, *(const bf16x8*)(qp0 + ks * 16), T[0]);
        T[1] = MFMA(a, *(const bf16x8*)(qp1 + ks * 16), T[1]);
      }
    }
#pragma unroll
    for (int ib = 0; ib < 2; ++ib)
#pragma unroll
      for (int g4 = 0; g4 < 4; ++g4) {
        const int il = 32 * ib + r, ig = rh * 64 + il, j0 = 32 * w + 8 * g4 + 4 * h;
        const float v0 = (j0 + 0 <= ig) ? T[ib][4 * g4 + 0] : 0.f, v1 = (j0 + 1 <= ig) ? T[ib][4 * g4 + 1] : 0.f;
        const float v2 = (j0 + 2 <= ig) ? T[ib][4 * g4 + 2] : 0.f, v3 = (j0 + 3 <= ig) ? T[ib][4 * g4 + 3] : 0.f;
        uint2 v; v.x = pack2(v0, v1); v.y = pack2(v2, v3);
        *(uint2*)(inner + il * 136 + j0) = v;
      }
  }
  __syncthreads();
  f32x16 acc[2][4];
#pragma unroll
  for (int rb = 0; rb < 2; ++rb)
#pragma unroll
    for (int eb = 0; eb < 4; ++eb)
#pragma unroll
      for (int i = 0; i < 16; ++i) acc[rb][eb][i] = 0.f;
#define RO_MFMA8(A0, A1, B0, B1, B2, B3) \
      acc[0][0] = MFMA(A0, B0, acc[0][0]); acc[1][0] = MFMA(A1, B0, acc[1][0]); acc[0][1] = MFMA(A0, B1, acc[0][1]); acc[1][1] = MFMA(A1, B1, acc[1][1]); \
      acc[0][2] = MFMA(A0, B2, acc[0][2]); acc[1][2] = MFMA(A1, B2, acc[1][2]); acc[0][3] = MFMA(A0, B3, acc[0][3]); acc[1][3] = MFMA(A1, B3, acc[1][3]);
  {
    const u16* ap = inner + r * 136 + h * 8;
    const u16* bp = VT + (size_t)(128 * w + r) * 8192 + h * 8;
    const int ngr = rh ? 2 : 1;
#pragma unroll 1
    for (int g = 0; g < ngr; ++g) {
      bf16x8 bb[4][4];
#pragma unroll
      for (int q = 0; q < 4; ++q)
#pragma unroll
        for (int eb = 0; eb < 4; ++eb) bb[q][eb] = *(const bf16x8*)(bp + (size_t)(32 * eb) * 8192 + (4 * g + q) * 16);
      __builtin_amdgcn_sched_barrier(0);
#pragma unroll
      for (int q = 0; q < 4; ++q) {
        const bf16x8 a0 = *(const bf16x8*)(ap + (4 * g + q) * 16), a1 = *(const bf16x8*)(ap + 32 * 136 + (4 * g + q) * 16);
        RO_MFMA8(a0, a1, bb[q][0], bb[q][1], bb[q][2], bb[q][3])
      }
    }
  }
  {
    const u16* ap = QR + (trow0 + r) * 1024 + hh * 256 + h * 8;
    const u16* bp = PT + (size_t)(128 * w + r) * 256 + h * 8;
#pragma unroll 1
    for (int g = 0; g < 8; ++g) {
      bf16x8 bb[2][4], aa[2][2];
#pragma unroll
      for (int q = 0; q < 2; ++q) {
        aa[q][0] = *(const bf16x8*)(ap + (2 * g + q) * 16); aa[q][1] = *(const bf16x8*)(ap + 32 * 1024 + (2 * g + q) * 16);
#pragma unroll
        for (int eb = 0; eb < 4; ++eb) bb[q][eb] = *(const bf16x8*)(bp + (size_t)(32 * eb) * 256 + (2 * g + q) * 16);
      }
      __builtin_amdgcn_sched_barrier(0);
#pragma unroll
      for (int q = 0; q < 2; ++q) { RO_MFMA8(aa[q][0], aa[q][1], bb[q][0], bb[q][1], bb[q][2], bb[q][3]) }
    }
  }
#undef RO_MFMA8
  __syncthreads();
#pragma unroll
  for (int rb = 0; rb < 2; ++rb)
#pragma unroll
    for (int reg = 0; reg < 16; ++reg) {
      float s1 = 0.f, s2 = 0.f;
#pragma unroll
      for (int eb = 0; eb < 4; ++eb) { const float v = acc[rb][eb][reg]; s1 += v; s2 += v * v; }
      const int row = 32 * rb + crow(reg, h);
      red1[row * 132 + w * 32 + r] = s1; red2[row * 132 + w * 32 + r] = s2;
    }
  __syncthreads();
  {
    const int row = t >> 2, q = t & 3;
    float s1 = 0.f, s2 = 0.f;
#pragma unroll
    for (int k = 0; k < 32; ++k) { s1 += red1[row * 132 + q * 32 + k]; s2 += red2[row * 132 + q * 32 + k]; }
    s1 += __shfl_xor(s1, 1); s2 += __shfl_xor(s2, 1);
    s1 += __shfl_xor(s1, 2); s2 += __shfl_xor(s2, 2);
    const float mu = s1 * (1.f / 512.f);
    const float var = fmaxf(s2 * (1.f / 512.f) - mu * mu, 0.f);
    if (q == 0) { smu[row] = mu; srs[row] = rsqrtf(var + GN_EPS); }
  }
  __syncthreads();
  const u16* __restrict__ GS = (const u16*)(p.ws + R_GS); u16* __restrict__ OB = (u16*)(p.ws + WS_ACT2);
#pragma unroll
  for (int rb = 0; rb < 2; ++rb)
#pragma unroll
    for (int rq = 0; rq < 4; ++rq) {
      u16 gg[4][4];
#pragma unroll
      for (int q = 0; q < 4; ++q)
#pragma unroll
        for (int eb = 0; eb < 4; ++eb) gg[q][eb] = GS[(trow0 + 32 * rb + crow(4 * rq + q, h)) * 2048 + hh * 512 + 128 * w + r + 32 * eb];
#pragma unroll
      for (int q = 0; q < 4; ++q) {
        const int reg = 4 * rq + q, row = 32 * rb + crow(reg, h);
        const float mu = smu[row], rs = srs[row];
        const size_t o = (trow0 + row) * 2048 + hh * 512 + 128 * w + r;
#pragma unroll
        for (int eb = 0; eb < 4; ++eb) OB[o + 32 * eb] = f2bf((acc[rb][eb][reg] - mu) * rs * bf2f(gg[q][eb]));
      }
    }
}

enum { PH_PREP = 0, PH_QKV, PH_ATTN, PH_AO, PH_RIN, PH_RETU, PH_SCAN, PH_RETO, PH_RO, PH_LNM, PH_FIN, PH_CONV, PH_FOUT, PH_LNF };

DI void run_phase(const Params& p, int ph, int layer, u16* lds, int vb, bool noepi = false, bool fuse_ln = false) {
  u16* hl = lds + __builtin_amdgcn_readfirstlane(tid512() >> 8) * LDS_HALF_E;
  switch (ph) {
    case PH_PREP: phase_prep(p, hl); break;
    case PH_QKV: gemm_phase<G_QKV>(p, layer, lds, vb); break;
    case PH_ATTN: phase_attn(p, layer, hl); break;
    case PH_AO: gemm_phase<G_AO>(p, layer, lds, vb, false, fuse_ln); break;
    case PH_RIN: gemm_phase<G_RIN>(p, layer, lds, vb); break;
    case PH_RETU: phase_ret_u(p, layer, lds); break;
    case PH_SCAN: phase_ret_scan(p, layer); break;
    case PH_RETO: for (int item = bidx(); item < 1024; item += NVB) ret_out_item(p, item, hl); break;
    case PH_RO: gemm_phase<G_RO>(p, layer, lds, vb, false, fuse_ln); break;
    case PH_LNM: phase_ln(p, p.in[I_LMG] + layer * 1024, p.in[I_LMB] + layer * 1024, false, (layer & 1) ? 32 : 16); break;
    case PH_FIN: gemm_phase<G_FIN>(p, layer, lds, vb, noepi); break;
    case PH_CONV: phase_conv(p, layer); break;
    case PH_FOUT: gemm_phase<G_FOUT>(p, layer, lds, vb, false, fuse_ln); break;
    case PH_LNF: phase_ln(p, p.in[I_LFG] + layer * 1024, p.in[I_LFB] + layer * 1024, layer == 3, 44); break;
  }
}

#if !MEGA
__global__ void __launch_bounds__(512, 2) k_phase(Params p, int ph, int layer) {
  __shared__ __attribute__((aligned(16))) u16 lds[LDS_BYTES / 2];
  run_phase(p, ph, layer, lds, (int)blockIdx.x);
}

#else
#ifndef PROBE_MASK
#define PROBE_MASK 0
#endif
#ifndef PROBE_NOEPI
#define PROBE_NOEPI 0
#endif
__global__ void __launch_bounds__(512, 2) k_mega(Params p) {
  __shared__ __attribute__((aligned(16))) u16 lds[LDS_BYTES / 2];
  __shared__ uint4 xb_words;
  cg::grid_group grid = cg::this_grid();
  if (__builtin_amdgcn_workitem_id_x() == 0) xb_words = make_uint4(0u, 0u, 0u, (unsigned)__builtin_amdgcn_workgroup_id_x());
  __syncthreads();
  XcdBarrier xb = xcd_barrier_post((unsigned*)(p.ws + WS_BAR), (volatile LAS unsigned*)&xb_words);
  {
    Params q = p;
    asm volatile("" : "+s"(q.out)); asm volatile("" : "+s"(q.ws));
    const int rep0 = ((PROBE_MASK >> PH_PREP) & 1) ? 2 : 1;
    for (int rr = 0; rr < rep0; ++rr) run_phase(q, PH_PREP, 0, lds, 0);
    if (p.ws == nullptr) grid.sync();
    xcd_barrier(xb);
    if (__builtin_amdgcn_workitem_id_x() == 0) {
      unsigned* bar = (unsigned*)(p.ws + WS_BAR);
      const unsigned G = gridDim.x;
      unsigned cnt = 0u, mine = 0u, dense = 0u; bool uni = true;
#pragma unroll
      for (unsigned j = 0; j < 16; ++j) {
        const unsigned c = xb_ld(&bar[XB_XCNT(j)]);
        cnt += (c > 0u) ? 1u : 0u; mine = (j == xb.x) ? c : mine; dense += (j < xb.x && c > 0u) ? 1u : 0u;
        uni = uni && (c == 0u || c * 8u == G);
      }
      const unsigned rank = xb_words.z;
      xb_words.x = mine > 0u ? mine : 1u; xb_words.y = cnt > 0u ? cnt : 1u;
      xb_words.w = (uni && cnt == 8u && rank < (G >> 3)) ? dense * (G >> 3) + rank : (unsigned)__builtin_amdgcn_workgroup_id_x();
    }
    __syncthreads();
  }
#pragma unroll 1
  for (int step = 1; step < 29; ++step) {
    int ph, layer, idx;
    {
      const int s = step - 1;
      if (s < 6) { layer = 0; idx = s; } else if (s < 14) { layer = 1; idx = s - 6; } else if (s < 20) { layer = 2; idx = s - 14; } else { layer = 3; idx = s - 20; }
      if (layer & 1) ph = (idx < 5) ? (PH_RIN + idx) : (PH_FIN + idx - 5);
      else ph = (idx < 3) ? (PH_QKV + idx) : (PH_FIN + idx - 3);
    }
    Params q = p;
#pragma unroll
    for (int i = 0; i < 19; ++i) asm volatile("" : "+s"(q.in[i]));
    asm volatile("" : "+s"(q.out)); asm volatile("" : "+s"(q.ws));
    const int rep = ((PROBE_MASK >> ph) & 1) ? 2 : 1;
    const int vb = (int)xb_words.w;
    for (int rr = 0; rr < rep; ++rr) run_phase(q, ph, layer, lds, vb, PROBE_NOEPI && rr > 0, true);
    if (step < 28) xcd_barrier(xb);
  }
}
#endif

extern "C" void kernel_launch(void* const* d_in, const int* in_sizes, int n_in, void* d_out, int out_size, void* d_ws, size_t ws_size, hipStream_t stream) {
  static int grid_blocks = 0;
  if (!grid_blocks) {
    int dev = 0, cus = 0, per_cu = 0;
    (void)hipGetDevice(&dev);
    (void)hipDeviceGetAttribute(&cus, hipDeviceAttributeMultiprocessorCount, dev);
#if MEGA
    (void)hipOccupancyMaxActiveBlocksPerMultiprocessor(&per_cu, k_mega, 512, 0);
#else
    (void)hipOccupancyMaxActiveBlocksPerMultiprocessor(&per_cu, k_phase, 512, 0);
#endif
    if (per_cu < 1) per_cu = 1;
    if (per_cu > 1) per_cu = 1;
    grid_blocks = cus * per_cu;
    if (n_in != 19 || ws_size < WS_END) fprintf(stderr, "kernel_launch: unexpected n_in %d or ws %zu < %zu\n", n_in, ws_size, (size_t)WS_END);
  }
  Params p{};
  for (int i = 0; i < 19; ++i) p.in[i] = (const float*)d_in[i];
  p.out = (float*)d_out; p.ws = (unsigned char*)d_ws;
#if MEGA
  (void)hipMemsetAsync((unsigned char*)d_ws + WS_BAR, 0, 16384, stream);
  void* args[] = {&p};
  hipError_t e = hipLaunchCooperativeKernel((void*)k_mega, dim3(grid_blocks), dim3(512), args, 0, stream);
  if (e != hipSuccess) fprintf(stderr, "cooperative launch failed: %s (grid %d)\n", hipGetErrorString(e), grid_blocks);
#else
  auto L = [&](int ph, int layer) { hipLaunchKernelGGL(k_phase, dim3(grid_blocks), dim3(512), 0, stream, p, ph, layer); };
  L(PH_PREP, 0);
  for (int layer = 0; layer < 4; ++layer) {
    if ((layer & 1) == 0) { L(PH_QKV, layer); L(PH_ATTN, layer); L(PH_AO, layer); }
    else { L(PH_RIN, layer); L(PH_RETU, layer); L(PH_SCAN, layer); L(PH_RETO, layer); L(PH_RO, layer); }
    L(PH_LNM, layer); L(PH_FIN, layer); L(PH_CONV, layer); L(PH_FOUT, layer); L(PH_LNF, layer);
  }
#endif
}
```

```cpp
#include <hip/hip_runtime.h>
#include <hip/hip_cooperative_groups.h>
#include <cstdio>
namespace cg = cooperative_groups;

#ifndef MEGA
#define MEGA 1
#endif

typedef unsigned short u16;
using f32x4 = __attribute__((ext_vector_type(4))) float;
using bf16x8 = __attribute__((ext_vector_type(8))) short;
using f32x16 = __attribute__((ext_vector_type(16))) float;
#define DI __device__ __forceinline__
#define MFMA(a, b, c) __builtin_amdgcn_mfma_f32_32x32x16_bf16((a), (b), (c), 0, 0, 0)

constexpr int D = 1024, SEQ = 8192, MP = 16384, MS = 128, MT = MP + MS;
constexpr int DFF = 2816;
constexpr float ALPHA = 1.6817928305074290f;
constexpr float LN_EPS = 1e-5f, GN_EPS = 1e-5f;

constexpr size_t O_YP = 0;
constexpr size_t O_YS = O_YP + (size_t)MP * D;
constexpr size_t O_KWP = O_YS + (size_t)MS * D;
constexpr size_t O_VWP = O_KWP + 2ull * 2 * 128 * 256;
constexpr size_t O_RSP = O_VWP + 2ull * 2 * 128 * 256;
constexpr size_t O_CSP = O_RSP + 2ull * 2 * 4 * 256 * 512;
constexpr size_t O_KWS = O_CSP + 4ull * 2 * 2 * DFF;
constexpr size_t O_VWS = O_KWS + 2ull * 128 * 128 * 256;
constexpr size_t O_RSS = O_VWS + 2ull * 128 * 128 * 256;
constexpr size_t O_CSS = O_RSS + 2ull * 128 * 4 * 256 * 512;

constexpr size_t al(size_t x) { return (x + 255) & ~size_t(255); }
constexpr size_t WS_WQKV = 0;
constexpr size_t WS_WAO = WS_WQKV + 2ull * 1536 * 1024 * 2;
constexpr size_t WS_WRIN = WS_WAO + 2ull * 1024 * 1024 * 2;
constexpr size_t WS_WRO = WS_WRIN + 2ull * 6144 * 1024 * 2;
constexpr size_t WS_WFIN = WS_WRO + 2ull * 1024 * 2048 * 2;
constexpr size_t WS_WFOUT = WS_WFIN + 4ull * 5632 * 1024 * 2;
constexpr size_t WS_TROPE = WS_WFOUT + 4ull * 1024 * 2816 * 2;
constexpr size_t WS_TRET = WS_TROPE + al(2ull * 8193 * 32 * 4);
constexpr size_t WS_X = WS_TRET + al(2ull * 8193 * 128 * 4);
constexpr size_t WS_XB = WS_X + (size_t)MT * 1024 * 4;
constexpr size_t WS_Y = WS_XB + (size_t)MT * 1024 * 2;
constexpr size_t WS_ACT = WS_Y + (size_t)MT * 1024 * 4;
constexpr size_t WS_ACT2 = WS_ACT + 268435456ull;
constexpr size_t WS_US = WS_ACT2 + (size_t)MT * 2816 * 2;
constexpr size_t WS_SMP = WS_US + 134217728ull;
constexpr size_t WS_BAR = WS_SMP + 128ull * 4096 * 4;
constexpr size_t WS_PART = WS_BAR + 16384;
constexpr size_t WS_PART2 = WS_PART + 4ull * 44 * 128 * 256 * 4;
constexpr size_t WS_END = WS_PART2 + 24ull * 16 * 128 * 256 * 4;
constexpr size_t A_Q = WS_ACT;
constexpr size_t A_K = A_Q + (size_t)MT * 1024 * 2;
constexpr size_t A_VT = A_K + (size_t)MP * 256 * 2;
constexpr size_t R_Q = WS_ACT;
constexpr size_t R_K = R_Q + (size_t)MT * 1024 * 2;
constexpr size_t R_KT = R_K + (size_t)MT * 1024 * 2;
constexpr size_t R_VT = R_KT + 2ull * 1024 * 8192 * 2;
constexpr size_t R_GS = R_VT + 2ull * 2048 * 8192 * 2;
static_assert(R_GS + (size_t)MT * 2048 * 2 <= WS_ACT2, "act region");
constexpr size_t F_UA = WS_ACT;
constexpr size_t F_UG = F_UA + (size_t)MT * 2816 * 2;

struct Params {
  const float* in[19];
  float* out;
  unsigned char* ws;
};
enum { I_XP = 0, I_XS, I_CK, I_CV, I_SR, I_SC, I_WQKV, I_SINK, I_WAO, I_WRIN, I_WRO, I_WFIN, I_CW, I_CB, I_WFOUT, I_LMG, I_LMB, I_LFG, I_LFB };

DI int tid512() { int t = __builtin_amdgcn_workitem_id_x(); asm volatile("" : "+v"(t)); return t; }
DI int bid_real() { int b = __builtin_amdgcn_workgroup_id_x(); asm volatile("" : "+s"(b)); return b; }
DI int tidx() { return tid512() & 255; }
DI int bidx() { return 2 * bid_real() + __builtin_amdgcn_readfirstlane(tid512() >> 8); }
#define NVB (2 * (int)gridDim.x)
DI u16 f2bf(float x) { return __builtin_bit_cast(u16, (__bf16)x); }
DI float bf2f(u16 v) { return __uint_as_float(((unsigned)v) << 16); }
DI unsigned pack2(float a, float b) { return (unsigned)f2bf(a) | ((unsigned)f2bf(b) << 16); }
DI int crow(int reg, int h) { return (reg & 3) + 8 * (reg >> 2) + 4 * h; }
DI float silu(float x) { return x / (1.f + __expf(-x)); }
DI float lg2gamma(int hh) { return hh == 0 ? -0.04580368961312479f : hh == 1 ? -0.02272007650008353f : hh == 2 ? -0.011315313227834146f : -0.005646563141142063f; }

DI float wave_max(float v) {
#pragma unroll
  for (int o = 32; o >= 1; o >>= 1) v = fmaxf(v, __shfl_xor(v, o));
  return v;
}
DI float wave_sum(float v) {
#pragma unroll
  for (int o = 32; o >= 1; o >>= 1) v += __shfl_xor(v, o);
  return v;
}

DI void sincos_d(double x, float& s, float& c) {
  const double n = rint(x * 0.63661977236758134308);
  double r = fma(-n, 1.57079632673412561417e+00, x);
  r = fma(-n, 6.07710050650619224932e-11, r);
  const double r2 = r * r;
  double sp = 1.0 / 6227020800.0;
  sp = fma(sp, r2, -1.0 / 39916800.0); sp = fma(sp, r2, 1.0 / 362880.0); sp = fma(sp, r2, -1.0 / 5040.0);
  sp = fma(sp, r2, 1.0 / 120.0); sp = fma(sp, r2, -1.0 / 6.0); sp = fma(sp, r2, 1.0);
  const double sn = sp * r;
  double cp = -1.0 / 87178291200.0;
  cp = fma(cp, r2, 1.0 / 479001600.0); cp = fma(cp, r2, -1.0 / 3628800.0); cp = fma(cp, r2, 1.0 / 40320.0);
  cp = fma(cp, r2, -1.0 / 720.0); cp = fma(cp, r2, 1.0 / 24.0); cp = fma(cp, r2, -0.5); cp = fma(cp, r2, 1.0);
  const int q = ((int)n) & 3;
  const double ss = (q & 1) ? cp : sn, cc = (q & 1) ? sn : cp;
  s = (float)((q == 2 || q == 3) ? -ss : ss);
  c = (float)((q == 1 || q == 2) ? -cc : cc);
}

constexpr int LSTR = 72;
constexpr int TILE_E = 256 * LSTR;
constexpr int LDS_BYTES = 4 * TILE_E * 2;
constexpr int LDS_HALF_E = LDS_BYTES / 4;

DI void gemm_core(const u16* __restrict__ A, size_t lda, const u16* __restrict__ Bt, size_t ldb, int K, u16* lds, f32x16 (&acc)[4][2]) {
  const int t = tid512(), lane = t & 63, w = t >> 6, wm = w >> 2, wn = w & 3, r = lane & 31, h = lane >> 5;
  u16* As = lds; u16* Bs = lds + 2 * TILE_E;
  const int lrow = t >> 3, lk = (t & 7) * 8;
  const u16* Ag = A + (size_t)lrow * lda + lk;
  const u16* Bg = Bt + (size_t)lrow * ldb + lk;
#define GLOAD(P, ko) \
  P##a0 = *(const uint4*)(Ag + (ko)); P##a1 = *(const uint4*)(Ag + (size_t)64 * lda + (ko)); P##a2 = *(const uint4*)(Ag + (size_t)128 * lda + (ko)); P##a3 = *(const uint4*)(Ag + (size_t)192 * lda + (ko)); \
  P##b0 = *(const uint4*)(Bg + (ko)); P##b1 = *(const uint4*)(Bg + (size_t)64 * ldb + (ko)); P##b2 = *(const uint4*)(Bg + (size_t)128 * ldb + (ko)); P##b3 = *(const uint4*)(Bg + (size_t)192 * ldb + (ko));
#define LSTORE(P, buf) { u16* ad_ = As + (buf) * TILE_E + lrow * LSTR + lk; u16* bd_ = Bs + (buf) * TILE_E + lrow * LSTR + lk; \
  *(uint4*)(ad_) = P##a0; *(uint4*)(ad_ + 64 * LSTR) = P##a1; *(uint4*)(ad_ + 128 * LSTR) = P##a2; *(uint4*)(ad_ + 192 * LSTR) = P##a3; \
  *(uint4*)(bd_) = P##b0; *(uint4*)(bd_ + 64 * LSTR) = P##b1; *(uint4*)(bd_ + 128 * LSTR) = P##b2; *(uint4*)(bd_ + 192 * LSTR) = P##b3; }
#define COMPUTE(buf) { \
    const u16* as = As + (buf) * TILE_E + (wm * 128 + r) * LSTR + h * 8; \
    const u16* bs = Bs + (buf) * TILE_E + (wn * 64 + r) * LSTR + h * 8; \
    _Pragma("unroll") for (int kk = 0; kk < 4; ++kk) { \
      const bf16x8 b0 = *(const bf16x8*)(bs + kk * 16), b1 = *(const bf16x8*)(bs + 32 * LSTR + kk * 16); \
      _Pragma("unroll") for (int mi = 0; mi < 4; ++mi) { \
        const bf16x8 a = *(const bf16x8*)(as + mi * 32 * LSTR + kk * 16); \
        acc[mi][0] = MFMA(a, b0, acc[mi][0]); acc[mi][1] = MFMA(a, b1, acc[mi][1]); } } }
  uint4 pa0, pa1, pa2, pa3, pb0, pb1, pb2, pb3;
  const int nk = K >> 6;
  {
    uint4 qa0, qa1, qa2, qa3, qb0, qb1, qb2, qb3;
    GLOAD(q, 0)
    if (nk > 1) { GLOAD(p, 64) }
    __syncthreads();
    LSTORE(q, 0)
  }
#pragma unroll
  for (int a = 0; a < 4; ++a)
#pragma unroll
    for (int b = 0; b < 2; ++b)
#pragma unroll
      for (int i = 0; i < 16; ++i) acc[a][b][i] = 0.f;
  __syncthreads();
#pragma unroll 1
  for (int kt = 0; kt < nk; ++kt) {
    const int buf = kt & 1;
    if (kt + 1 < nk) LSTORE(p, buf ^ 1)
    if (kt + 2 < nk) { const int ko = (kt + 2) << 6; GLOAD(p, ko) }
    __builtin_amdgcn_sched_barrier(0);
    COMPUTE(buf)
    __syncthreads();
  }
#undef COMPUTE
#undef GLOAD
#undef LSTORE
}

DI void epi_qkv(const Params& p, int j, f32x16 (&acc)[2][2], int mb, int nb, int lane) {
  const int r = lane & 31, h = lane >> 5, slot = nb >> 6;
  const float* cosT = (const float*)(p.ws + WS_TROPE); const float* sinT = cosT + 8193 * 32;
  const bool smp = mb >= MP;
  if (slot < 20) {
    u16* Q = (u16*)(p.ws + A_Q); u16* KB = (u16*)(p.ws + A_K);
#pragma unroll
    for (int mi = 0; mi < 2; ++mi) {
      float cc[16], ss[16];
#pragma unroll
      for (int reg = 0; reg < 16; ++reg) {
        const int row = mb + mi * 32 + crow(reg, h);
        const int pos = smp ? 8192 : (row & 8191);
        cc[reg] = cosT[pos * 32 + r]; ss[reg] = sinT[pos * 32 + r];
      }
#pragma unroll
      for (int reg = 0; reg < 16; ++reg) {
        const int row = mb + mi * 32 + crow(reg, h);
        const int pos = smp ? 8192 : (row & 8191);
        const float c = cc[reg], s = ss[reg];
        const float x1 = acc[mi][0][reg], x2 = acc[mi][1][reg];
        const float o1 = x1 * c - x2 * s, o2 = x2 * c + x1 * s;
        if (slot < 16) {
          Q[(size_t)row * 1024 + nb + r] = f2bf(o1 * 0.125f); Q[(size_t)row * 1024 + nb + 32 + r] = f2bf(o2 * 0.125f);
        } else {
          const int kvh = slot - 16;
          if (!smp) {
            KB[(size_t)row * 256 + kvh * 64 + r] = f2bf(o1); KB[(size_t)row * 256 + kvh * 64 + 32 + r] = f2bf(o2);
            if (pos >= 8064) { const int b = row >> 13; float* o = p.out + O_KWP + ((size_t)((j * 2 + b) * 128 + (pos - 8064)) * 4 + kvh) * 64; o[r] = o1; o[32 + r] = o2; }
          } else {
            const int b = row - MP; float* o = p.out + O_KWS + ((size_t)((j * 128 + b) * 128 + 127) * 4 + kvh) * 64; o[r] = o1; o[32 + r] = o2;
          }
        }
      }
    }
  } else {
    const int kvh = slot - 20;
    if (!smp) {
      u16* VT = (u16*)(p.ws + A_VT);
      const int b = mb >> 13;
#pragma unroll
      for (int mi = 0; mi < 2; ++mi)
#pragma unroll
        for (int ni = 0; ni < 2; ++ni)
#pragma unroll
          for (int g4 = 0; g4 < 4; ++g4) {
            const int t0 = (mb & 8191) + mi * 32 + 8 * g4 + 4 * h, d = ni * 32 + r;
            uint2 v; v.x = pack2(acc[mi][ni][4 * g4], acc[mi][ni][4 * g4 + 1]); v.y = pack2(acc[mi][ni][4 * g4 + 2], acc[mi][ni][4 * g4 + 3]);
            *(uint2*)(VT + (size_t)(b * 256 + kvh * 64 + d) * 8192 + t0) = v;
            if (t0 >= 8064) {
#pragma unroll
              for (int q = 0; q < 4; ++q) p.out[O_VWP + ((size_t)((j * 2 + b) * 128 + (t0 + q - 8064)) * 4 + kvh) * 64 + d] = acc[mi][ni][4 * g4 + q];
            }
          }
    } else {
#pragma unroll
      for (int mi = 0; mi < 2; ++mi)
#pragma unroll
        for (int ni = 0; ni < 2; ++ni)
#pragma unroll
          for (int reg = 0; reg < 16; ++reg) {
            const int b = mb - MP + mi * 32 + crow(reg, h);
            p.out[O_VWS + ((size_t)((j * 128 + b) * 128 + 127) * 4 + kvh) * 64 + ni * 32 + r] = acc[mi][ni][reg];
          }
    }
  }
}

DI void epi_res(const Params& p, f32x16 (&acc)[2][2], int mb, int nb, int lane) {
  const int r = lane & 31, h = lane >> 5;
  const float* __restrict__ X = (const float*)(p.ws + WS_X); float* __restrict__ Y = (float*)(p.ws + WS_Y);
#pragma unroll
  for (int mi = 0; mi < 2; ++mi) {
    float xv[2][16];
#pragma unroll
    for (int ni = 0; ni < 2; ++ni)
#pragma unroll
      for (int reg = 0; reg < 16; ++reg) xv[ni][reg] = X[(size_t)(mb + mi * 32 + crow(reg, h)) * 1024 + nb + ni * 32 + r];
#pragma unroll
    for (int ni = 0; ni < 2; ++ni)
#pragma unroll
      for (int reg = 0; reg < 16; ++reg) Y[(size_t)(mb + mi * 32 + crow(reg, h)) * 1024 + nb + ni * 32 + r] = ALPHA * xv[ni][reg] + acc[mi][ni][reg];
  }
}

DI void epi_rin(const Params& p, int j, f32x16 (&acc)[2][2], int mb, int nb, int lane) {
  const int r = lane & 31, h = lane >> 5, slot = nb >> 6;
  const bool smp = mb >= MP;
  const int b = mb >> 13;
  if (slot < 32) {
    const bool isq = slot < 16;
    const int hh = (slot & 15) >> 2, cbase = nb & 255, ncol = nb & 1023;
    const float lg = lg2gamma(hh);
    const float* cosR = (const float*)(p.ws + WS_TRET); const float* sinR = cosR + 8193 * 128;
#pragma unroll
    for (int mi = 0; mi < 2; ++mi)
#pragma unroll
      for (int ni = 0; ni < 2; ++ni) {
        const int pidx = (cbase + ni * 32 + r) >> 1;
        float cc[16], ss[16];
#pragma unroll
        for (int reg = 0; reg < 16; ++reg) {
          const int row = mb + mi * 32 + crow(reg, h);
          const int pos = smp ? 8192 : (row & 8191);
          cc[reg] = cosR[pos * 128 + pidx]; ss[reg] = sinR[pos * 128 + pidx];
        }
#pragma unroll
        for (int reg = 0; reg < 16; ++reg) {
          const int row = mb + mi * 32 + crow(reg, h);
          const int pos = smp ? 8192 : (row & 8191);
          const float mine = acc[mi][ni][reg], other = __shfl_xor(mine, 1);
          const float rot = (r & 1) ? (mine * cc[reg] + other * ss[reg]) : (mine * cc[reg] - other * ss[reg]);
          const float e = (float)((smp ? 0 : (pos & 127)) + 1) * lg;
          acc[mi][ni][reg] = isq ? rot * exp2f(e) : rot * 0.0625f * exp2f(-e);
        }
        __builtin_amdgcn_sched_barrier(0);
      }
    if (smp) {
      float* S = (float*)(p.ws + WS_SMP) + (isq ? 0 : 128 * 1024);
#pragma unroll
      for (int mi = 0; mi < 2; ++mi)
#pragma unroll
        for (int ni = 0; ni < 2; ++ni)
#pragma unroll
          for (int reg = 0; reg < 16; ++reg)
            S[(size_t)(mb - MP + mi * 32 + crow(reg, h)) * 1024 + ncol + ni * 32 + r] = acc[mi][ni][reg];
    } else {
      u16* N = (u16*)(p.ws + (isq ? R_Q : R_K));
#pragma unroll
      for (int mi = 0; mi < 2; ++mi)
#pragma unroll
        for (int ni = 0; ni < 2; ++ni)
#pragma unroll
          for (int reg = 0; reg < 16; ++reg)
            N[(size_t)(mb + mi * 32 + crow(reg, h)) * 1024 + ncol + ni * 32 + r] = f2bf(acc[mi][ni][reg]);
      if (!isq) {
        u16* KT = (u16*)(p.ws + R_KT);
#pragma unroll
        for (int mi = 0; mi < 2; ++mi)
#pragma unroll
          for (int ni = 0; ni < 2; ++ni)
#pragma unroll
            for (int g4 = 0; g4 < 4; ++g4) {
              const int t0 = (mb & 8191) + mi * 32 + 8 * g4 + 4 * h;
              uint2 v; v.x = pack2(acc[mi][ni][4 * g4], acc[mi][ni][4 * g4 + 1]); v.y = pack2(acc[mi][ni][4 * g4 + 2], acc[mi][ni][4 * g4 + 3]);
              *(uint2*)(KT + (size_t)(b * 1024 + ncol + ni * 32 + r) * 8192 + t0) = v;
            }
      }
    }
  } else if (slot < 64) {
    const int cv = nb - 2048;
    if (smp) {
      float* SV = (float*)(p.ws + WS_SMP) + 2 * 128 * 1024;
#pragma unroll
      for (int mi = 0; mi < 2; ++mi)
#pragma unroll
        for (int ni = 0; ni < 2; ++ni)
#pragma unroll
          for (int reg = 0; reg < 16; ++reg)
            SV[(size_t)(mb - MP + mi * 32 + crow(reg, h)) * 2048 + cv + ni * 32 + r] = acc[mi][ni][reg];
    } else {
      u16* VT = (u16*)(p.ws + R_VT);
#pragma unroll
      for (int mi = 0; mi < 2; ++mi)
#pragma unroll
        for (int ni = 0; ni < 2; ++ni)
#pragma unroll
          for (int g4 = 0; g4 < 4; ++g4) {
            const int t0 = (mb & 8191) + mi * 32 + 8 * g4 + 4 * h;
            uint2 v; v.x = pack2(acc[mi][ni][4 * g4], acc[mi][ni][4 * g4 + 1]); v.y = pack2(acc[mi][ni][4 * g4 + 2], acc[mi][ni][4 * g4 + 3]);
            *(uint2*)(VT + (size_t)(b * 2048 + cv + ni * 32 + r) * 8192 + t0) = v;
          }
    }
  } else {
    u16* GS = (u16*)(p.ws + R_GS);
    const int cg_ = nb - 4096;
#pragma unroll
    for (int mi = 0; mi < 2; ++mi)
#pragma unroll
      for (int ni = 0; ni < 2; ++ni)
#pragma unroll
        for (int reg = 0; reg < 16; ++reg)
          GS[(size_t)(mb + mi * 32 + crow(reg, h)) * 2048 + cg_ + ni * 32 + r] = f2bf(silu(acc[mi][ni][reg]));
  }
}

DI void epi_fin(const Params& p, int i, f32x16 (&acc)[2][2], int mb, int nb, int lane) {
  const int r = lane & 31, h = lane >> 5;
  const bool smp = mb >= MP;
  if (nb < DFF) {
    u16* UA = (u16*)(p.ws + F_UA);
#pragma unroll
    for (int mi = 0; mi < 2; ++mi)
#pragma unroll
      for (int ni = 0; ni < 2; ++ni)
#pragma unroll
        for (int reg = 0; reg < 16; ++reg) {
          const int row = mb + mi * 32 + crow(reg, h), col = nb + ni * 32 + r;
          const float v = acc[mi][ni][reg];
          UA[(size_t)row * DFF + col] = f2bf(v);
          if (smp) {
            p.out[O_CSS + ((size_t)(i * 128 + (row - MP)) * 2 + 1) * DFF + col] = v;
          } else {
            const int pos = row & 8191;
            if (pos >= 8190) p.out[O_CSP + ((size_t)(i * 2 + (row >> 13)) * 2 + (pos - 8190)) * DFF + col] = v;
          }
        }
  } else {
    u16* UG = (u16*)(p.ws + F_UG);
#pragma unroll
    for (int mi = 0; mi < 2; ++mi)
#pragma unroll
      for (int ni = 0; ni < 2; ++ni)
#pragma unroll
        for (int reg = 0; reg < 16; ++reg)
          UG[(size_t)(mb + mi * 32 + crow(reg, h)) * DFF + (nb - DFF) + ni * 32 + r] = f2bf(acc[mi][ni][reg]);
  }
}

#define XB_TMO      128
#define XB_XCNT(j)  (256  + 64 * (j))
#define XB_XSUB(j)  (1280 + 64 * (j))
#define XB_XGEN(j)  (2304 + 64 * (j))
#define XB_TOP      3328
#define XB_TOPGEN   3392
#define XCD_BAR_WORDS 3456
#define XB_SPIN_CAP (1u << 20)
#define LAS __attribute__((address_space(3)))
DI unsigned xb_ld(unsigned* p) { return __hip_atomic_load(p, __ATOMIC_RELAXED, __HIP_MEMORY_SCOPE_AGENT); }
DI unsigned xb_add(unsigned* p, unsigned v) { return __hip_atomic_fetch_add(p, v, __ATOMIC_RELAXED, __HIP_MEMORY_SCOPE_AGENT); }
DI unsigned xb_xcc_id() { return (unsigned)__builtin_amdgcn_s_getreg((3 << 11) | 20) & 0xFu; }
#define XB_SPIN(cond, bar) do { unsigned _sp = 0; while (cond) { __builtin_amdgcn_s_sleep(1); \
    if ((++_sp & 255u) == 0u) { if (xb_ld(&(bar)[XB_TMO])) break; if (_sp > XB_SPIN_CAP) { atomicAdd(&(bar)[XB_TMO], 1u); break; } } } } while (0)
struct XcdBarrier { unsigned* bar; unsigned x; volatile LAS unsigned* st; };
DI XcdBarrier xcd_barrier_post(unsigned* bar, volatile LAS unsigned* st) {
  XcdBarrier b; b.bar = bar; b.x = xb_xcc_id(); b.st = st;
  if (__builtin_amdgcn_workitem_id_x() == 0) st[2] = xb_add(&bar[XB_XCNT(b.x)], 1u);
  return b;
}
DI void xcd_barrier_complete(unsigned* bar, unsigned x, unsigned& nloc, unsigned& nx) {
  const unsigned G = gridDim.x;
  unsigned sum, cnt, mine, sp = 0u;
  for (;;) {
    sum = 0u; cnt = 0u; mine = 0u;
#pragma unroll
    for (unsigned j = 0; j < 16; ++j) { const unsigned c = xb_ld(&bar[XB_XCNT(j)]); sum += c; cnt += (c > 0u) ? 1u : 0u; mine = (j == x) ? c : mine; }
    if (sum == G) break;
    __builtin_amdgcn_s_sleep(1);
    if ((++sp & 255u) == 0u) { if (xb_ld(&bar[XB_TMO])) break; if (sp > XB_SPIN_CAP) { atomicAdd(&bar[XB_TMO], 1u); break; } }
  }
  nloc = mine > 0u ? mine : 1u; nx = cnt > 0u ? cnt : 1u;
}
DI void xcd_barrier(const XcdBarrier& b) {
  asm volatile("s_waitcnt vmcnt(0)" ::: "memory");
  __syncthreads();
  if (__builtin_amdgcn_workitem_id_x() == 0) {
    unsigned* bar = b.bar;
    __builtin_amdgcn_s_waitcnt(0);
    unsigned nloc = b.st[0], nx = b.st[1];
    if (nloc == 0u) { xcd_barrier_complete(bar, b.x, nloc, nx); b.st[0] = nloc; b.st[1] = nx; }
    const unsigned old = xb_add(&bar[XB_XSUB(b.x)], 1u);
    const unsigned gen = old / nloc;
    if (old + 1u == (gen + 1u) * nloc) {
      __builtin_amdgcn_fence(__ATOMIC_RELEASE, "agent");
      asm volatile("s_waitcnt vmcnt(0)" ::: "memory");
      const unsigned og = xb_add(&bar[XB_TOP], 1u);
      const unsigned tg = og / nx;
      if (og + 1u == (tg + 1u) * nx) xb_add(&bar[XB_TOPGEN], 1u);
      else XB_SPIN(xb_ld(&bar[XB_TOPGEN]) == tg, bar);
      __builtin_amdgcn_fence(__ATOMIC_ACQUIRE, "agent");
      xb_add(&bar[XB_XGEN(b.x)], 1u);
      asm volatile("s_waitcnt vmcnt(0)" ::: "memory");
    } else {
      XB_SPIN(xb_ld(&bar[XB_XGEN(b.x)]) == gen, bar);
      __builtin_amdgcn_fence(__ATOMIC_ACQUIRE, "agent");
      asm volatile("s_waitcnt vmcnt(0)" ::: "memory");
    }
  }
  __syncthreads();
}

DI void signal_cnt(unsigned* c) {
  asm volatile("s_waitcnt vmcnt(0)" ::: "memory");
  __syncthreads();
  if (__builtin_amdgcn_workitem_id_x() == 0) { __builtin_amdgcn_fence(__ATOMIC_RELEASE, "agent"); asm volatile("s_waitcnt vmcnt(0)" ::: "memory"); (void)xb_add(c, 1u); }
}
DI void wait_cnt(unsigned* c, unsigned target, unsigned* bar) {
  if (__builtin_amdgcn_workitem_id_x() == 0) { XB_SPIN(xb_ld(c) < target, bar); __builtin_amdgcn_fence(__ATOMIC_ACQUIRE, "agent"); asm volatile("s_waitcnt vmcnt(0)" ::: "memory"); }
  __syncthreads();
}
constexpr int LN_CNT_WORD0 = XCD_BAR_WORDS;

DI void ln_row(const Params& p, int row, const float4 (&gv)[4], const float4 (&bv)[4], bool last, int nkk, int lane) {
  const float* Y = (const float*)(p.ws + WS_Y);
  float* X = (float*)(p.ws + WS_X); u16* XB = (u16*)(p.ws + WS_XB);
  float4 v[4];
  if (row < MP) {
    const float4* y = (const float4*)(Y + (size_t)row * 1024);
#pragma unroll
    for (int i = 0; i < 4; ++i) v[i] = y[lane + 64 * i];
  } else {
    const float4* x = (const float4*)(X + (size_t)row * 1024);
#pragma unroll
    for (int i = 0; i < 4; ++i) { const float4 t = x[lane + 64 * i]; v[i].x = ALPHA * t.x; v[i].y = ALPHA * t.y; v[i].z = ALPHA * t.z; v[i].w = ALPHA * t.w; }
    const float* __restrict__ PART = (const float*)(p.ws + WS_PART);
    for (int ks = 0; ks < nkk; ks += 4) {
      float4 t[4][4];
#pragma unroll
      for (int u = 0; u < 4; ++u)
#pragma unroll
        for (int i = 0; i < 4; ++i)
          t[u][i] = *(const float4*)(PART + ((size_t)(i * nkk + ks + u) * 128 + (row - MP)) * 256 + lane * 4);
#pragma unroll
      for (int u = 0; u < 4; ++u)
#pragma unroll
        for (int i = 0; i < 4; ++i) { v[i].x += t[u][i].x; v[i].y += t[u][i].y; v[i].z += t[u][i].z; v[i].w += t[u][i].w; }
    }
  }
  float sm = 0.f;
#pragma unroll
  for (int i = 0; i < 4; ++i) sm += v[i].x + v[i].y + v[i].z + v[i].w;
  const float mu = wave_sum(sm) * (1.f / 1024.f);
  float q = 0.f;
#pragma unroll
  for (int i = 0; i < 4; ++i) { v[i].x -= mu; v[i].y -= mu; v[i].z -= mu; v[i].w -= mu; q += v[i].x * v[i].x + v[i].y * v[i].y + v[i].z * v[i].z + v[i].w * v[i].w; }
  const float rs = rsqrtf(wave_sum(q) * (1.f / 1024.f) + LN_EPS);
  float4* xo = last ? (float4*)(p.out + (row < MP ? O_YP + (size_t)row * 1024 : O_YS + (size_t)(row - MP) * 1024)) : (float4*)(X + (size_t)row * 1024);
#pragma unroll
  for (int i = 0; i < 4; ++i) {
    float4 o;
    o.x = v[i].x * rs * gv[i].x + bv[i].x; o.y = v[i].y * rs * gv[i].y + bv[i].y;
    o.z = v[i].z * rs * gv[i].z + bv[i].z; o.w = v[i].w * rs * gv[i].w + bv[i].w;
    xo[lane + 64 * i] = o;
    if (!last) { uint2 ob; ob.x = pack2(o.x, o.y); ob.y = pack2(o.z, o.w); *(uint2*)(XB + (size_t)row * 1024 + (lane + 64 * i) * 4) = ob; }
  }
}
DI void ln_rows4(const Params& p, int row0, const float4 (&gv)[4], const float4 (&bv)[4], bool last, int lane) {
  const float* Y = (const float*)(p.ws + WS_Y);
  float* X = (float*)(p.ws + WS_X); u16* XB = (u16*)(p.ws + WS_XB);
  float4 v[4][4];
#pragma unroll
  for (int q = 0; q < 4; ++q)
#pragma unroll
    for (int i = 0; i < 4; ++i) v[q][i] = ((const float4*)(Y + (size_t)(row0 + q) * 1024))[lane + 64 * i];
  float sm[4];
#pragma unroll
  for (int q = 0; q < 4; ++q) { sm[q] = 0.f;
#pragma unroll
    for (int i = 0; i < 4; ++i) sm[q] += v[q][i].x + v[q][i].y + v[q][i].z + v[q][i].w; }
#pragma unroll
  for (int o = 32; o >= 1; o >>= 1)
#pragma unroll
    for (int q = 0; q < 4; ++q) sm[q] += __shfl_xor(sm[q], o);
  float qq[4];
#pragma unroll
  for (int q = 0; q < 4; ++q) { const float mu = sm[q] * (1.f / 1024.f); qq[q] = 0.f;
#pragma unroll
    for (int i = 0; i < 4; ++i) { v[q][i].x -= mu; v[q][i].y -= mu; v[q][i].z -= mu; v[q][i].w -= mu; qq[q] += v[q][i].x * v[q][i].x + v[q][i].y * v[q][i].y + v[q][i].z * v[q][i].z + v[q][i].w * v[q][i].w; } }
#pragma unroll
  for (int o = 32; o >= 1; o >>= 1)
#pragma unroll
    for (int q = 0; q < 4; ++q) qq[q] += __shfl_xor(qq[q], o);
#pragma unroll
  for (int q = 0; q < 4; ++q) {
    const int row = row0 + q;
    const float rs = rsqrtf(qq[q] * (1.f / 1024.f) + LN_EPS);
    float4* xo = last ? (float4*)(p.out + O_YP + (size_t)row * 1024) : (float4*)(X + (size_t)row * 1024);
#pragma unroll
    for (int i = 0; i < 4; ++i) {
      float4 o;
      o.x = v[q][i].x * rs * gv[i].x + bv[i].x; o.y = v[q][i].y * rs * gv[i].y + bv[i].y;
      o.z = v[q][i].z * rs * gv[i].z + bv[i].z; o.w = v[q][i].w * rs * gv[i].w + bv[i].w;
      xo[lane + 64 * i] = o;
      if (!last) { uint2 ob; ob.x = pack2(o.x, o.y); ob.y = pack2(o.z, o.w); *(uint2*)(XB + (size_t)row * 1024 + (lane + 64 * i) * 4) = ob; }
    }
  }
}
DI void phase_ln(const Params& p, const float* __restrict__ gam, const float* __restrict__ bet, bool last, int nkk) {
  const int lane = tidx() & 63;
  const int wid = bidx() * 4 + (tidx() >> 6), nw = NVB * 4;
  float4 gv[4], bv[4];
#pragma unroll
  for (int i = 0; i < 4; ++i) { gv[i] = ((const float4*)gam)[lane + 64 * i]; bv[i] = ((const float4*)bet)[lane + 64 * i]; }
  for (int rr = wid; rr < MT; rr += nw) ln_row(p, rr < MS ? MP + rr : rr - MS, gv, bv, last, nkk, lane);
}

enum { G_QKV, G_AO, G_RIN, G_RO, G_FIN, G_FOUT };
template <int G>
DI void gemm_phase(const Params& p, int layer, u16* lds, int vb, bool noepi = false, bool fuse_ln = false) {
  const int j = layer >> 1;
  const u16* A; const u16* Bt; int K, N;
  if (G == G_QKV) { A = (const u16*)(p.ws + WS_XB); Bt = (const u16*)(p.ws + WS_WQKV) + (size_t)j * 1536 * 1024; K = 1024; N = 1536; }
  else if (G == G_AO) { A = (const u16*)(p.ws + WS_ACT2); Bt = (const u16*)(p.ws + WS_WAO) + (size_t)j * 1024 * 1024; K = 1024; N = 1024; }
  else if (G == G_RIN) { A = (const u16*)(p.ws + WS_XB); Bt = (const u16*)(p.ws + WS_WRIN) + (size_t)j * 6144 * 1024; K = 1024; N = 6144; }
  else if (G == G_RO) { A = (const u16*)(p.ws + WS_ACT2); Bt = (const u16*)(p.ws + WS_WRO) + (size_t)j * 1024 * 2048; K = 2048; N = 1024; }
  else if (G == G_FIN) { A = (const u16*)(p.ws + WS_XB); Bt = (const u16*)(p.ws + WS_WFIN) + (size_t)layer * 5632 * 1024; K = 1024; N = 5632; }
  else { A = (const u16*)(p.ws + WS_ACT2); Bt = (const u16*)(p.ws + WS_WFOUT) + (size_t)layer * 1024 * 2816; K = 2816; N = 1024; }
  constexpr bool LNF = (G == G_AO || G == G_RO || G == G_FOUT);
  constexpr bool SPLIT = LNF || (G == G_RIN);
  const int ntn = N >> 8, ntiles = (SPLIT ? 64 : 65) * ntn;
  const int t = tid512(), lane = t & 63, w = t >> 6, wm = w >> 2, wn = w & 3;
  const int per = (int)gridDim.x >> 3;
  const int xcd = vb / per, rank = vb - xcd * per;
  const int lo = (int)(((long long)xcd * ntiles) >> 3), hi = (int)(((long long)(xcd + 1) * ntiles) >> 3);
  for (int L = lo + rank; L < hi; L += per) {
    int tm, tn;
    const int full = 64 * ntn;
    if (L < full) { const int sr = L / (8 * ntn), rem = L - sr * 8 * ntn; tn = rem >> 3; tm = 8 * sr + (rem & 7); }
    else { tn = L - full; tm = 64; }
    f32x16 acc[4][2];
    gemm_core(A + (size_t)tm * 256 * K, K, Bt + (size_t)tn * 256 * K, K, K, lds, acc);
    if (tm == 64 && wm == 1) continue;
    if (noepi) { float sacc = 0.f;
#pragma unroll
      for (int a = 0; a < 4; ++a)
#pragma unroll
        for (int b = 0; b < 2; ++b)
#pragma unroll
          for (int i = 0; i < 16; ++i) sacc += acc[a][b][i];
      if (sacc == 1.2345e30f) p.out[0] = 0.f; continue; }
    const int nb = tn * 256 + wn * 64;
    float* park = (float*)lds + w * 4096 + lane;
#pragma unroll
    for (int mi = 0; mi < 2; ++mi)
#pragma unroll
      for (int ni = 0; ni < 2; ++ni)
#pragma unroll
        for (int i = 0; i < 16; ++i) park[(mi * 32 + ni * 16 + i) * 64] = acc[2 + mi][ni][i];
    f32x16 ac[2][2];
    ac[0][0] = acc[0][0]; ac[0][1] = acc[0][1]; ac[1][0] = acc[1][0]; ac[1][1] = acc[1][1];
#pragma unroll 1
    for (int hf = 0; hf < 2; ++hf) {
      if (hf) {
#pragma unroll
        for (int mi = 0; mi < 2; ++mi)
#pragma unroll
          for (int ni = 0; ni < 2; ++ni)
#pragma unroll
            for (int i = 0; i < 16; ++i) ac[mi][ni][i] = park[(mi * 32 + ni * 16 + i) * 64];
      }
      const int mb = tm * 256 + wm * 128 + hf * 64;
      if (G == G_QKV) epi_qkv(p, j, ac, mb, nb, lane);
      else if (G == G_RIN) epi_rin(p, j, ac, mb, nb, lane);
      else if (G == G_FIN) epi_fin(p, layer, ac, mb, nb, lane);
      else epi_res(p, ac, mb, nb, lane);
    }
    if (LNF && fuse_ln) signal_cnt((unsigned*)(p.ws + WS_BAR) + LN_CNT_WORD0 + (layer * 2 + (G == G_FOUT ? 1 : 0)) * 65 + tm);
  }
  if (SPLIT) {
    const int nkk = K >> 6, r = lane & 31, h = lane >> 5;
    float* PART = (float*)(p.ws + (LNF ? WS_PART : WS_PART2));
    for (int e = vb; e < ntn * nkk; e += (int)gridDim.x) {
      const int tn = e / nkk, ks = e - tn * nkk;
      f32x16 acc[4][2];
      gemm_core(A + (size_t)MP * K + ks * 64, K, Bt + (size_t)tn * 256 * K + ks * 64, K, 64, lds, acc);
      if (wm == 0) {
        float* o = PART + (size_t)e * 128 * 256 + wn * 64 + r;
#pragma unroll
        for (int mi = 0; mi < 4; ++mi)
#pragma unroll
          for (int ni = 0; ni < 2; ++ni)
#pragma unroll
            for (int i = 0; i < 16; ++i) o[(size_t)(mi * 32 + crow(i, h)) * 256 + ni * 32] = acc[mi][ni][i];
      }
      if (LNF && fuse_ln) signal_cnt((unsigned*)(p.ws + WS_BAR) + LN_CNT_WORD0 + (layer * 2 + (G == G_FOUT ? 1 : 0)) * 65 + 64);
    }
    if (LNF && fuse_ln) {
      unsigned* bar = (unsigned*)(p.ws + WS_BAR);
      unsigned* cnt = bar + LN_CNT_WORD0 + (layer * 2 + (G == G_FOUT ? 1 : 0)) * 65;
      const float* gam = (G == G_FOUT ? p.in[I_LFG] : p.in[I_LMG]) + layer * 1024;
      const float* bet = (G == G_FOUT ? p.in[I_LFB] : p.in[I_LMB]) + layer * 1024;
      const bool last = (G == G_FOUT) && layer == 3;
      float4 gv[4], bv[4];
#pragma unroll
      for (int i = 0; i < 4; ++i) { gv[i] = ((const float4*)gam)[lane + 64 * i]; bv[i] = ((const float4*)bet)[lane + 64 * i]; }
      for (int L = lo + rank; L < hi; L += per) {
        const int sr = L / (8 * ntn), rem = L - sr * 8 * ntn, tn = rem >> 3, tm = 8 * sr + (rem & 7);
        wait_cnt(cnt + tm, 4u, bar);
        ln_rows4(p, tm * 256 + tn * 64 + w * 8, gv, bv, last, lane);
        ln_rows4(p, tm * 256 + tn * 64 + w * 8 + 4, gv, bv, last, lane);
      }
      const int G_ = (int)gridDim.x;
      if (vb >= G_ - 16) {
        wait_cnt(cnt + 64, (unsigned)(4 * nkk), bar);
        ln_row(p, MP + (vb - (G_ - 16)) * 8 + w, gv, bv, last, nkk, lane);
      }
    }
  }
}

DI void transpose_job(const float* __restrict__ src, u16* __restrict__ dst, int K, int N, float* tl) {
  const int t = tidx();
  const int tn = N >> 6, ntiles = (K >> 6) * tn;
  for (int tile = bidx(); tile < ntiles; tile += NVB) {
    const int k0 = (tile / tn) << 6, n0 = (tile % tn) << 6;
    __syncthreads();
#pragma unroll
    for (int i = 0; i < 16; ++i) { const int k = (t >> 6) + 4 * i; tl[k * 65 + (t & 63)] = src[(size_t)(k0 + k) * N + n0 + (t & 63)]; }
    __syncthreads();
    const int n = t >> 2, kq = (t & 3) * 16;
    uint4 v0, v1;
    v0.x = pack2(tl[(kq + 0) * 65 + n], tl[(kq + 1) * 65 + n]); v0.y = pack2(tl[(kq + 2) * 65 + n], tl[(kq + 3) * 65 + n]);
    v0.z = pack2(tl[(kq + 4) * 65 + n], tl[(kq + 5) * 65 + n]); v0.w = pack2(tl[(kq + 6) * 65 + n], tl[(kq + 7) * 65 + n]);
    v1.x = pack2(tl[(kq + 8) * 65 + n], tl[(kq + 9) * 65 + n]); v1.y = pack2(tl[(kq + 10) * 65 + n], tl[(kq + 11) * 65 + n]);
    v1.z = pack2(tl[(kq + 12) * 65 + n], tl[(kq + 13) * 65 + n]); v1.w = pack2(tl[(kq + 14) * 65 + n], tl[(kq + 15) * 65 + n]);
    u16* o = dst + (size_t)(n0 + n) * K + k0 + kq;
    *(uint4*)o = v0; *(uint4*)(o + 8) = v1;
  }
}

DI void phase_prep(const Params& p, u16* lds) {
  float* tl = (float*)lds;
  for (int j = 0; j < 2; ++j) {
    transpose_job(p.in[I_WQKV] + (size_t)j * 1024 * 1536, (u16*)(p.ws + WS_WQKV) + (size_t)j * 1536 * 1024, 1024, 1536, tl);
    transpose_job(p.in[I_WAO] + (size_t)j * 1024 * 1024, (u16*)(p.ws + WS_WAO) + (size_t)j * 1024 * 1024, 1024, 1024, tl);
    transpose_job(p.in[I_WRIN] + (size_t)j * 1024 * 6144, (u16*)(p.ws + WS_WRIN) + (size_t)j * 6144 * 1024, 1024, 6144, tl);
    transpose_job(p.in[I_WRO] + (size_t)j * 2048 * 1024, (u16*)(p.ws + WS_WRO) + (size_t)j * 1024 * 2048, 2048, 1024, tl);
  }
  for (int i = 0; i < 4; ++i) {
    transpose_job(p.in[I_WFIN] + (size_t)i * 1024 * 5632, (u16*)(p.ws + WS_WFIN) + (size_t)i * 5632 * 1024, 1024, 5632, tl);
    transpose_job(p.in[I_WFOUT] + (size_t)i * 2816 * 1024, (u16*)(p.ws + WS_WFOUT) + (size_t)i * 1024 * 2816, 2816, 1024, tl);
  }
  const size_t gid = (size_t)bidx() * 256 + tidx(), gstride = (size_t)NVB * 256;
  {
    float4* X = (float4*)(p.ws + WS_X); uint2* XB = (uint2*)(p.ws + WS_XB);
    const size_t nv = (size_t)MT * 256, npv = (size_t)MP * 256;
    for (size_t v0 = gid; v0 < nv; v0 += 4 * gstride) {
      float4 xb[4];
#pragma unroll
      for (int u = 0; u < 4; ++u) { const size_t v = v0 + u * gstride; if (v < nv) xb[u] = (v < npv) ? ((const float4*)p.in[I_XP])[v] : ((const float4*)p.in[I_XS])[v - npv]; }
#pragma unroll
      for (int u = 0; u < 4; ++u) { const size_t v = v0 + u * gstride; if (v < nv) { X[v] = xb[u]; uint2 o; o.x = pack2(xb[u].x, xb[u].y); o.y = pack2(xb[u].z, xb[u].w); XB[v] = o; } }
    }
  }
  {
    float* cosT = (float*)(p.ws + WS_TROPE); float* sinT = cosT + 8193 * 32;
    for (size_t v = gid; v < 8193ull * 32; v += gstride) {
      const int pos = (int)(v >> 5), i = (int)(v & 31);
      const double inv = exp(-9.210340371976182736 * (double)i / 32.0);
      float s, c; sincos_d((double)pos * inv, s, c); cosT[v] = c; sinT[v] = s;
    }
    float* cosR = (float*)(p.ws + WS_TRET); float* sinR = cosR + 8193 * 128;
    for (size_t v = gid; v < 8193ull * 128; v += gstride) {
      const int pos = (int)(v >> 7), i = (int)(v & 127);
      const double inv = exp(-9.210340371976182736 * (double)i / 127.0);
      float s, c; sincos_d((double)pos * inv, s, c); cosR[v] = c; sinR[v] = s;
    }
  }
}

DI void attn_prompt_item(const Params& p, int j, int item, u16* lds) {
  const int g = item & 3, kvh = (item >> 2) & 3, qb = (item >> 4) & 63, b = item >> 10;
  const int head = kvh * 4 + g;
  const int t = tidx(), lane = t & 63, w = t >> 6, r = lane & 31, h = lane >> 5;
  u16* Ks = lds;
  u16* Vts = lds + 256 * 72;
  const u16* Q = (const u16*)(p.ws + A_Q); const u16* KB = (const u16*)(p.ws + A_K); const u16* VT = (const u16*)(p.ws + A_VT);
  u16* OB = (u16*)(p.ws + WS_ACT2);
  const int tok0 = qb * 128 - 128;
  __syncthreads();
#pragma unroll
  for (int i = 0; i < 8; ++i) {
    const int c = t + 256 * i, key = c >> 3, part = c & 7, tok = tok0 + key;
    uint4 v = make_uint4(0, 0, 0, 0);
    if (tok >= 0) v = *(const uint4*)(KB + (size_t)(b * 8192 + tok) * 256 + kvh * 64 + part * 8);
    *(uint4*)(Ks + key * 72 + part * 8) = v;
  }
#pragma unroll
  for (int i = 0; i < 8; ++i) {
    const int c = t + 256 * i, d = c >> 5, part = c & 31, tok = tok0 + part * 8;
    uint4 v = make_uint4(0, 0, 0, 0);
    if (tok >= 0) v = *(const uint4*)(VT + (size_t)(b * 256 + kvh * 64 + d) * 8192 + tok);
    *(uint4*)(Vts + d * 264 + part * 8) = v;
  }
  const size_t qrow = (size_t)b * 8192 + qb * 128 + 32 * w + r;
  bf16x8 bq[4];
#pragma unroll
  for (int kk = 0; kk < 4; ++kk) bq[kk] = *(const bf16x8*)(Q + qrow * 1024 + head * 64 + kk * 16 + h * 8);
  __syncthreads();
  f32x16 S[5];
#pragma unroll
  for (int jb = 0; jb < 5; ++jb) {
#pragma unroll
    for (int i = 0; i < 16; ++i) S[jb][i] = 0.f;
    const u16* kp = Ks + (32 * (w + jb) + r) * 72 + h * 8;
#pragma unroll
    for (int kk = 0; kk < 4; ++kk) S[jb] = MFMA(*(const bf16x8*)(kp + kk * 16), bq[kk], S[jb]);
  }
  const float sink = p.in[I_SINK][j * 16 + head];
  float m = -INFINITY;
#pragma unroll
  for (int jb = 0; jb < 5; ++jb)
#pragma unroll
    for (int reg = 0; reg < 16; ++reg) {
      const int cr = crow(reg, h);
      const int rel = 128 + r - 32 * jb - cr;
      const bool valid = (rel >= 0) && (rel <= 128) && (qb > 0 || (32 * (w + jb) + cr) >= 128);
      const float s = valid ? S[jb][reg] : -INFINITY;
      S[jb][reg] = s; m = fmaxf(m, s);
    }
  m = fmaxf(m, __shfl_xor(m, 32));
  m = fmaxf(m, sink);
  float l = 0.f;
#pragma unroll
  for (int jb = 0; jb < 5; ++jb)
#pragma unroll
    for (int reg = 0; reg < 16; ++reg) { const float e = __expf(S[jb][reg] - m); S[jb][reg] = e; l += e; }
  l += __shfl_xor(l, 32);
  const float inv = 1.f / (l + __expf(sink - m));
  f32x16 O[2];
#pragma unroll
  for (int db = 0; db < 2; ++db)
#pragma unroll
    for (int i = 0; i < 16; ++i) O[db][i] = 0.f;
#pragma unroll
  for (int jb = 0; jb < 5; ++jb)
#pragma unroll
    for (int s = 0; s < 2; ++s) {
      uint4 pb;
      pb.x = pack2(S[jb][8 * s + 0], S[jb][8 * s + 1]); pb.y = pack2(S[jb][8 * s + 2], S[jb][8 * s + 3]);
      pb.z = pack2(S[jb][8 * s + 4], S[jb][8 * s + 5]); pb.w = pack2(S[jb][8 * s + 6], S[jb][8 * s + 7]);
      const bf16x8 bfrag = __builtin_bit_cast(bf16x8, pb);
#pragma unroll
      for (int db = 0; db < 2; ++db) {
        const u16* vp = Vts + (32 * db + r) * 264 + 32 * (w + jb) + 16 * s + 4 * h;
        const uint2 lo = *(const uint2*)vp, hi = *(const uint2*)(vp + 8);
        uint4 av; av.x = lo.x; av.y = lo.y; av.z = hi.x; av.w = hi.y;
        O[db] = MFMA(__builtin_bit_cast(bf16x8, av), bfrag, O[db]);
      }
    }
#pragma unroll
  for (int db = 0; db < 2; ++db)
#pragma unroll
    for (int g4 = 0; g4 < 4; ++g4) {
      uint2 v; v.x = pack2(O[db][4 * g4] * inv, O[db][4 * g4 + 1] * inv); v.y = pack2(O[db][4 * g4 + 2] * inv, O[db][4 * g4 + 3] * inv);
      *(uint2*)(OB + qrow * 1024 + head * 64 + 32 * db + 8 * g4 + 4 * h) = v;
    }
}

DI void attn_sample_item(const Params& p, int j, int item, u16* lds) {
  const int kvh = item & 3, b = item >> 2;
  const int t = tidx(), lane = t & 63, g = t >> 6;
  float* Kc = (float*)lds;
  float* Vc = Kc + 129 * 65;
  float* qs = Vc + 129 * 65;
  float* ps = qs + 256;
  const float* ck = p.in[I_CK] + (size_t)(j * 128 + b) * 128 * 256;
  const float* cv = p.in[I_CV] + (size_t)(j * 128 + b) * 128 * 256;
  float* ok = p.out + O_KWS + (size_t)(j * 128 + b) * 128 * 256;
  float* ov = p.out + O_VWS + (size_t)(j * 128 + b) * 128 * 256;
  __syncthreads();
  {
    const int d = t & 63, w0 = t >> 6;
#pragma unroll 1
    for (int i0 = 0; i0 < 32; i0 += 8) {
      float kb[8], vb[8];
#pragma unroll
      for (int u = 0; u < 8; ++u) { const int wq = w0 + 4 * (i0 + u); kb[u] = ck[wq * 256 + kvh * 64 + d]; vb[u] = cv[wq * 256 + kvh * 64 + d]; }
#pragma unroll
      for (int u = 0; u < 8; ++u) {
        const int wq = w0 + 4 * (i0 + u);
        Kc[wq * 65 + d] = kb[u]; Vc[wq * 65 + d] = vb[u];
        if (wq >= 1) { ok[(wq - 1) * 256 + kvh * 64 + d] = kb[u]; ov[(wq - 1) * 256 + kvh * 64 + d] = vb[u]; }
      }
    }
  }
  if (t < 64) { Kc[128 * 65 + t] = ok[127 * 256 + kvh * 64 + t]; Vc[128 * 65 + t] = ov[127 * 256 + kvh * 64 + t]; }
  qs[t] = bf2f(((const u16*)(p.ws + A_Q))[(size_t)(MP + b) * 1024 + (kvh * 4 + g) * 64 + lane]);
  __syncthreads();
  const float sink = p.in[I_SINK][j * 16 + kvh * 4 + g];
  float s0 = 0.f, s1 = 0.f, s2 = 0.f;
#pragma unroll 8
  for (int d = 0; d < 64; ++d) {
    const float q = qs[g * 64 + d];
    s0 += q * Kc[lane * 65 + d]; s1 += q * Kc[(lane + 64) * 65 + d]; s2 += q * Kc[128 * 65 + d];
  }
  float m = fmaxf(fmaxf(s0, s1), s2);
  m = fmaxf(wave_max(m), sink);
  const float e0 = __expf(s0 - m), e1 = __expf(s1 - m), e2 = __expf(s2 - m);
  float l = wave_sum(e0 + e1) + e2;
  const float inv = 1.f / (l + __expf(sink - m));
  ps[g * 132 + lane] = e0 * inv; ps[g * 132 + 64 + lane] = e1 * inv;
  if (lane == 0) ps[g * 132 + 128] = e2 * inv;
  __syncthreads();
  float o = 0.f;
#pragma unroll 4
  for (int k = 0; k < 129; ++k) o += ps[g * 132 + k] * Vc[k * 65 + lane];
  ((u16*)(p.ws + WS_ACT2))[(size_t)(MP + b) * 1024 + (kvh * 4 + g) * 64 + lane] = f2bf(o);
}

DI void phase_attn(const Params& p, int layer, u16* lds) {
  const int j = layer >> 1;
  for (int item = bidx(); item < 2048 + 512; item += NVB) {
    if (item < 2048) attn_prompt_item(p, j, item, lds);
    else attn_sample_item(p, j, item - 2048, lds);
  }
}

DI void unpack8(const uint4 x, float (&o)[8]) {
  o[0] = __uint_as_float(x.x << 16); o[1] = __uint_as_float(x.x & 0xffff0000u); o[2] = __uint_as_float(x.y << 16); o[3] = __uint_as_float(x.y & 0xffff0000u);
  o[4] = __uint_as_float(x.z << 16); o[5] = __uint_as_float(x.z & 0xffff0000u); o[6] = __uint_as_float(x.w << 16); o[7] = __uint_as_float(x.w & 0xffff0000u);
}
DI void phase_conv(const Params& p, int i) {
  const u16* __restrict__ UA = (const u16*)(p.ws + F_UA); const u16* __restrict__ UG = (const u16*)(p.ws + F_UG);
  u16* __restrict__ H = (u16*)(p.ws + WS_ACT2);
  const float* cw = p.in[I_CW] + (size_t)i * 3 * DFF; const float* cb = p.in[I_CB] + (size_t)i * DFF;
  const float* sc = p.in[I_SC] + (size_t)i * 128 * 2 * DFF;
  const int gid = bidx() * 256 + tidx(), gstride = NVB * 256;
  for (int it = gid; it < 1024 * 352 + 128 * 352; it += gstride) {
    const bool smp = it >= 1024 * 352;
    const int it2 = smp ? it - 1024 * 352 : it;
    const int ch = it2 / 352, f = (it2 - ch * 352) * 8, row0 = smp ? MP + ch : ch * 16;
    float w0[8], w1[8], w2[8], bb[8];
#pragma unroll
    for (int k = 0; k < 8; ++k) { w0[k] = cw[f + k]; w1[k] = cw[DFF + f + k]; w2[k] = cw[2 * DFF + f + k]; bb[k] = cb[f + k]; }
    if (!smp) {
      float a1[8], a2[8];
      const int pos0 = row0 & 8191;
      if (pos0 >= 2) { unpack8(*(const uint4*)(UA + (size_t)(row0 - 1) * DFF + f), a1); unpack8(*(const uint4*)(UA + (size_t)(row0 - 2) * DFF + f), a2); }
      else {
#pragma unroll
        for (int k = 0; k < 8; ++k) { a1[k] = 0.f; a2[k] = 0.f; }
      }
#pragma unroll 1
      for (int rr = 0; rr < 16; rr += 4) {
        const size_t o = (size_t)(row0 + rr) * DFF + f;
        uint4 xa[4], xg[4];
#pragma unroll
        for (int u = 0; u < 4; ++u) { xa[u] = *(const uint4*)(UA + o + (size_t)u * DFF); xg[u] = *(const uint4*)(UG + o + (size_t)u * DFF); }
#pragma unroll
        for (int u = 0; u < 4; ++u) {
          float a0[8], gg[8];
          unpack8(xa[u], a0); unpack8(xg[u], gg);
          unsigned ho[4];
#pragma unroll
          for (int k = 0; k < 4; ++k) {
            const float c0 = bb[2 * k] + a2[2 * k] * w0[2 * k] + a1[2 * k] * w1[2 * k] + a0[2 * k] * w2[2 * k];
            const float c1 = bb[2 * k + 1] + a2[2 * k + 1] * w0[2 * k + 1] + a1[2 * k + 1] * w1[2 * k + 1] + a0[2 * k + 1] * w2[2 * k + 1];
            ho[k] = pack2(silu(c0) * gg[2 * k], silu(c1) * gg[2 * k + 1]);
          }
          *(uint4*)(H + o + (size_t)u * DFF) = make_uint4(ho[0], ho[1], ho[2], ho[3]);
#pragma unroll
          for (int k = 0; k < 8; ++k) { a2[k] = a1[k]; a1[k] = a0[k]; }
        }
      }
    } else {
      const int b = row0 - MP;
      const size_t o = (size_t)row0 * DFF + f;
      float a0[8], gg[8];
      unpack8(*(const uint4*)(UA + o), a0); unpack8(*(const uint4*)(UG + o), gg);
      const float4* s0p = (const float4*)(sc + (size_t)(b * 2 + 0) * DFF + f); const float4* s1p = (const float4*)(sc + (size_t)(b * 2 + 1) * DFF + f);
      float4* o0 = (float4*)(p.out + O_CSS + ((size_t)(i * 128 + b) * 2 + 0) * DFF + f);
      const float4 p0 = s0p[0], p1 = s0p[1], q0 = s1p[0], q1 = s1p[1];
      o0[0] = q0; o0[1] = q1;
      const float x2[8] = {p0.x, p0.y, p0.z, p0.w, p1.x, p1.y, p1.z, p1.w}, x1[8] = {q0.x, q0.y, q0.z, q0.w, q1.x, q1.y, q1.z, q1.w};
      unsigned ho[4];
#pragma unroll
      for (int k = 0; k < 4; ++k) {
        const float c0 = bb[2 * k] + x2[2 * k] * w0[2 * k] + x1[2 * k] * w1[2 * k] + a0[2 * k] * w2[2 * k];
        const float c1 = bb[2 * k + 1] + x2[2 * k + 1] * w0[2 * k + 1] + x1[2 * k + 1] * w1[2 * k + 1] + a0[2 * k + 1] * w2[2 * k + 1];
        ho[k] = pack2(silu(c0) * gg[2 * k], silu(c1) * gg[2 * k + 1]);
      }
      *(uint4*)(H + o) = make_uint4(ho[0], ho[1], ho[2], ho[3]);
    }
  }
}

DI void ret_u_tile(const Params& p, int tile, u16* lds) {
  const int te = tile & 1, hh = (tile >> 1) & 3, c = (tile >> 3) & 63, b = tile >> 9;
  const u16* VT = (const u16*)(p.ws + R_VT) + (size_t)(b * 2048 + hh * 512 + te * 256) * 8192 + c * 128;
  const u16* KT = (const u16*)(p.ws + R_KT) + (size_t)(b * 1024 + hh * 256) * 8192 + c * 128;
  f32x16 acc[4][2];
  gemm_core(VT, 8192, KT, 8192, 128, lds, acc);
  const int t = tid512(), lane = t & 63, w = t >> 6, wm = w >> 2, wn = w & 3, r = lane & 31, h = lane >> 5;
  u16* UT = (u16*)(p.ws + WS_US) + (size_t)((b * 64 + c) * 4 + hh) * 512 * 256;
#pragma unroll
  for (int mi = 0; mi < 4; ++mi)
#pragma unroll
    for (int ni = 0; ni < 2; ++ni)
#pragma unroll
      for (int reg = 0; reg < 16; ++reg)
        UT[(size_t)(te * 256 + wm * 128 + mi * 32 + crow(reg, h)) * 256 + wn * 64 + ni * 32 + r] = f2bf(acc[mi][ni][reg]);
}

DI float block_sum(float v, float* red) {
  v = wave_sum(v);
  __syncthreads();
  if ((tidx() & 63) == 0) red[tidx() >> 6] = v;
  __syncthreads();
  return red[0] + red[1] + red[2] + red[3];
}

DI void ret_sample_item(const Params& p, int j, int item, u16* lds) {
  const int hh = item & 3, b = item >> 2, t = tidx(), tc = t & 127, par = t >> 7;
  float* qs = (float*)lds; float* ks = qs + 256; float* red = ks + 256; float4* red4 = (float4*)(red + 8);
  const float* __restrict__ P2 = (const float*)(p.ws + WS_PART2);
  __syncthreads();
  float qr = 0.f, kr = 0.f;
  float4 vv = make_float4(0.f, 0.f, 0.f, 0.f), gq = make_float4(0.f, 0.f, 0.f, 0.f);
  {
    const float* pq = P2 + ((size_t)(hh * 16) * 128 + b) * 256 + t;
    const float* pk = P2 + ((size_t)((4 + hh) * 16) * 128 + b) * 256 + t;
    const float* pv = P2 + ((size_t)((8 + 2 * hh + (tc >> 6)) * 16) * 128 + b) * 256 + ((4 * tc) & 255);
    const float* pg = P2 + ((size_t)((16 + 2 * hh + (tc >> 6)) * 16) * 128 + b) * 256 + ((4 * tc) & 255);
    float qb[16], kb[16]; float4 vb4[16], gb4[16];
#pragma unroll
    for (int u = 0; u < 16; ++u) { qb[u] = pq[(size_t)u * 128 * 256]; kb[u] = pk[(size_t)u * 128 * 256]; }
#pragma unroll
    for (int u = 0; u < 16; ++u) { vb4[u] = *(const float4*)(pv + (size_t)u * 128 * 256); gb4[u] = *(const float4*)(pg + (size_t)u * 128 * 256); }
#pragma unroll
    for (int u = 0; u < 16; ++u) {
      qr += qb[u]; kr += kb[u];
      vv.x += vb4[u].x; vv.y += vb4[u].y; vv.z += vb4[u].z; vv.w += vb4[u].w;
      gq.x += gb4[u].x; gq.y += gb4[u].y; gq.z += gb4[u].z; gq.w += gb4[u].w;
    }
  }
  qs[t] = qr; ks[t] = kr;
  __syncthreads();
  float qv, kv;
  {
    const float* cosR = (const float*)(p.ws + WS_TRET); const float* sinR = cosR + 8193 * 128;
    const float c = cosR[8192 * 128 + (t >> 1)], sn = sinR[8192 * 128 + (t >> 1)];
    const float oq = qs[t ^ 1], ok_ = ks[t ^ 1];
    const float rq = (t & 1) ? (qr * c + oq * sn) : (qr * c - oq * sn);
    const float rk = (t & 1) ? (kr * c + ok_ * sn) : (kr * c - ok_ * sn);
    const float lg = lg2gamma(hh);
    qv = rq * exp2f(lg); kv = rk * 0.0625f * exp2f(-lg);
  }
  __syncthreads();
  qs[t] = qv; ks[t] = kv;
  const float qk = block_sum(qv * kv, red);
  const float gamma = 1.f - exp2f(-5.f - (float)hh);
  const float4* __restrict__ s0 = (const float4*)(p.in[I_SR] + ((size_t)((j * 128 + b) * 4 + hh) * 256) * 512) + tc;
  float4* __restrict__ so = (float4*)(p.out + O_RSS + ((size_t)((j * 128 + b) * 4 + hh) * 256) * 512) + tc;
  float4 o = make_float4(0.f, 0.f, 0.f, 0.f);
#pragma unroll 1
  for (int d0 = par; d0 < 256; d0 += 16) {
    float4 sv[8];
#pragma unroll
    for (int u = 0; u < 8; ++u) { const f32x4 t4 = __builtin_nontemporal_load((const f32x4*)(s0 + (size_t)(d0 + 2 * u) * 128)); sv[u] = make_float4(t4[0], t4[1], t4[2], t4[3]); }
#pragma unroll
    for (int u = 0; u < 8; ++u) {
      const float q = qs[d0 + 2 * u], k = ks[d0 + 2 * u];
      o.x += q * sv[u].x; o.y += q * sv[u].y; o.z += q * sv[u].z; o.w += q * sv[u].w;
      float4 n; n.x = gamma * (sv[u].x + k * vv.x); n.y = gamma * (sv[u].y + k * vv.y); n.z = gamma * (sv[u].z + k * vv.z); n.w = gamma * (sv[u].w + k * vv.w);
      { f32x4 n4; n4[0] = n.x; n4[1] = n.y; n4[2] = n.z; n4[3] = n.w; __builtin_nontemporal_store(n4, (f32x4*)(so + (size_t)(d0 + 2 * u) * 128)); }
    }
  }
  red4[t] = o;
  __syncthreads();
  float s1 = 0.f;
  if (par == 0) {
    const float4 o2 = red4[t + 128];
    o.x += o2.x + qk * vv.x; o.y += o2.y + qk * vv.y; o.z += o2.z + qk * vv.z; o.w += o2.w + qk * vv.w;
    s1 = o.x + o.y + o.z + o.w;
  }
  const float mu = block_sum(s1, red) * (1.f / 512.f);
  float s2 = 0.f;
  if (par == 0) { o.x -= mu; o.y -= mu; o.z -= mu; o.w -= mu; s2 = o.x * o.x + o.y * o.y + o.z * o.z + o.w * o.w; }
  const float var = block_sum(s2, red) * (1.f / 512.f);
  const float rs = rsqrtf(var + GN_EPS);
  if (par == 0) {
    u16* OB = (u16*)(p.ws + WS_ACT2) + (size_t)(MP + b) * 2048 + hh * 512 + 4 * tc;
    uint2 ov; ov.x = pack2(o.x * rs * silu(gq.x), o.y * rs * silu(gq.y)); ov.y = pack2(o.z * rs * silu(gq.z), o.w * rs * silu(gq.w));
    *(uint2*)OB = ov;
  }
}

DI void phase_ret_u(const Params& p, int layer, u16* lds) {
  const int j = layer >> 1;
  const int half = __builtin_amdgcn_readfirstlane(tid512() >> 8);
  const int G = (int)gridDim.x, gs = G >> 1, br = bid_real();
  if (br < gs) {
    for (int it = br; it < 256; it += gs) ret_sample_item(p, j, 2 * it + half, lds + half * LDS_HALF_E);
  } else {
    for (int it = br - gs; it < 1024; it += G - gs) ret_u_tile(p, it, lds);
  }
}

DI void phase_ret_scan(const Params& p, int layer) {
  const int j = layer >> 1;
  u16* UT = (u16*)(p.ws + WS_US);
  const size_t cstride = 4ull * 512 * 256;
  for (int v = bidx() * 256 + tidx(); v < 131072; v += NVB * 256) {
    const int d8 = v & 31, e = (v >> 5) & 511, hh = (v >> 14) & 3, b = v >> 16;
    u16* base = UT + ((size_t)(b * 64 * 4 + hh) * 512 + e) * 256 + d8 * 8;
    const float cd = exp2f(128.f * lg2gamma(hh));
    float s[8];
#pragma unroll
    for (int k = 0; k < 8; ++k) s[k] = 0.f;
#pragma unroll 1
    for (int c0 = 0; c0 < 64; c0 += 16) {
      uint4 ub[16];
#pragma unroll
      for (int q = 0; q < 16; ++q) ub[q] = *(const uint4*)(base + (size_t)(c0 + q) * cstride);
#pragma unroll
      for (int q = 0; q < 16; ++q) {
        uint4 o; o.x = pack2(s[0], s[1]); o.y = pack2(s[2], s[3]); o.z = pack2(s[4], s[5]); o.w = pack2(s[6], s[7]);
        *(uint4*)(base + (size_t)(c0 + q) * cstride) = o;
        const unsigned us[4] = {ub[q].x, ub[q].y, ub[q].z, ub[q].w};
#pragma unroll
        for (int k = 0; k < 4; ++k) {
          s[2 * k] = cd * (s[2 * k] + __uint_as_float(us[k] << 16));
          s[2 * k + 1] = cd * (s[2 * k + 1] + __uint_as_float(us[k] & 0xffff0000u));
        }
      }
    }
    float* o = p.out + O_RSP + ((size_t)((j * 2 + b) * 4 + hh) * 256 + d8 * 8) * 512 + e;
#pragma unroll
    for (int k = 0; k < 8; ++k) o[(size_t)k * 512] = s[k];
  }
}

DI void ret_out_item(const Params& p, int item, u16* lds) {
  const int rh = item & 1, hh = (item >> 1) & 3, c = (item >> 3) & 63, b = item >> 9;
  const int t = tidx(), lane = t & 63, w = t >> 6, r = lane & 31, h = lane >> 5;
  const size_t row0 = (size_t)b * 8192 + c * 128, trow0 = row0 + rh * 64;
  const u16* QR = (const u16*)(p.ws + R_Q); const u16* KR = (const u16*)(p.ws + R_K);
  const u16* VT = (const u16*)(p.ws + R_VT) + (size_t)(b * 2048 + hh * 512) * 8192 + c * 128;
  const u16* PT = (const u16*)(p.ws + WS_US) + (size_t)((b * 64 + c) * 4 + hh) * 512 * 256;
  u16* inner = lds;
  float* red1 = (float*)lds;
  float* red2 = red1 + 64 * 132;
  float* smu = red2 + 64 * 132;
  float* srs = smu + 64;
  __syncthreads();
  {
    f32x16 T[2];
#pragma unroll
    for (int ib = 0; ib < 2; ++ib)
#pragma unroll
      for (int i = 0; i < 16; ++i) T[ib][i] = 0.f;
    if (rh == 1 || w < 2) {
      const u16* kp = KR + (row0 + 32 * w + r) * 1024 + hh * 256 + h * 8;
      const u16* qp0 = QR + (trow0 + r) * 1024 + hh * 256 + h * 8;
      const u16* qp1 = qp0 + 32 * 1024;
#pragma unroll 4
      for (int ks = 0; ks < 16; ++ks) {
        const bf16x8 a = *(const bf16x8*)(kp + ks * 16);
        T[0] = MFMA(a, *(const bf16x8*)(qp0 + ks * 16), T[0]);
        T[1] = MFMA(a, *(const bf16x8*)(qp1 + ks * 16), T[1]);
      }
    }
#pragma unroll
    for (int ib = 0; ib < 2; ++ib)
#pragma unroll
      for (int g4 = 0; g4 < 4; ++g4) {
        const int il = 32 * ib + r, ig = rh * 64 + il, j0 = 32 * w + 8 * g4 + 4 * h;
        const float v0 = (j0 + 0 <= ig) ? T[ib][4 * g4 + 0] : 0.f, v1 = (j0 + 1 <= ig) ? T[ib][4 * g4 + 1] : 0.f;
        const float v2 = (j0 + 2 <= ig) ? T[ib][4 * g4 + 2] : 0.f, v3 = (j0 + 3 <= ig) ? T[ib][4 * g4 + 3] : 0.f;
        uint2 v; v.x = pack2(v0, v1); v.y = pack2(v2, v3);
        *(uint2*)(inner + il * 136 + j0) = v;
      }
  }
  __syncthreads();
  f32x16 acc[2][4];
#pragma unroll
  for (int rb = 0; rb < 2; ++rb)
#pragma unroll
    for (int eb = 0; eb < 4; ++eb)
#pragma unroll
      for (int i = 0; i < 16; ++i) acc[rb][eb][i] = 0.f;
#define RO_MFMA8(A0, A1, B0, B1, B2, B3) \
      acc[0][0] = MFMA(A0, B0, acc[0][0]); acc[1][0] = MFMA(A1, B0, acc[1][0]); acc[0][1] = MFMA(A0, B1, acc[0][1]); acc[1][1] = MFMA(A1, B1, acc[1][1]); \
      acc[0][2] = MFMA(A0, B2, acc[0][2]); acc[1][2] = MFMA(A1, B2, acc[1][2]); acc[0][3] = MFMA(A0, B3, acc[0][3]); acc[1][3] = MFMA(A1, B3, acc[1][3]);
  {
    const u16* ap = inner + r * 136 + h * 8;
    const u16* bp = VT + (size_t)(128 * w + r) * 8192 + h * 8;
    const int ngr = rh ? 2 : 1;
#pragma unroll 1
    for (int g = 0; g < ngr; ++g) {
      bf16x8 bb[4][4];
#pragma unroll
      for (int q = 0; q < 4; ++q)
#pragma unroll
        for (int eb = 0; eb < 4; ++eb) bb[q][eb] = *(const bf16x8*)(bp + (size_t)(32 * eb) * 8192 + (4 * g + q) * 16);
      __builtin_amdgcn_sched_barrier(0);
#pragma unroll
      for (int q = 0; q < 4; ++q) {
        const bf16x8 a0 = *(const bf16x8*)(ap + (4 * g + q) * 16), a1 = *(const bf16x8*)(ap + 32 * 136 + (4 * g + q) * 16);
        RO_MFMA8(a0, a1, bb[q][0], bb[q][1], bb[q][2], bb[q][3])
      }
    }
  }
  {
    const u16* ap = QR + (trow0 + r) * 1024 + hh * 256 + h * 8;
    const u16* bp = PT + (size_t)(128 * w + r) * 256 + h * 8;
#pragma unroll 1
    for (int g = 0; g < 4; ++g) {
      bf16x8 bb[4][4], aa[2][2];
#pragma unroll
      for (int q = 0; q < 4; ++q)
#pragma unroll
        for (int eb = 0; eb < 4; ++eb) bb[q][eb] = *(const bf16x8*)(bp + (size_t)(32 * eb) * 256 + (4 * g + q) * 16);
#pragma unroll
      for (int q = 0; q < 2; ++q) { aa[q][0] = *(const bf16x8*)(ap + (4 * g + q) * 16); aa[q][1] = *(const bf16x8*)(ap + 32 * 1024 + (4 * g + q) * 16); }
      __builtin_amdgcn_sched_barrier(0);
#pragma unroll
      for (int q = 0; q < 2; ++q) { RO_MFMA8(aa[q][0], aa[q][1], bb[q][0], bb[q][1], bb[q][2], bb[q][3]) }
#pragma unroll
      for (int q = 0; q < 2; ++q) { aa[q][0] = *(const bf16x8*)(ap + (4 * g + 2 + q) * 16); aa[q][1] = *(const bf16x8*)(ap + 32 * 1024 + (4 * g + 2 + q) * 16); }
#pragma unroll
      for (int q = 0; q < 2; ++q) { RO_MFMA8(aa[q][0], aa[q][1], bb[2 + q][0], bb[2 + q][1], bb[2 + q][2], bb[2 + q][3]) }
    }
  }
#undef RO_MFMA8
  __syncthreads();
#pragma unroll
  for (int rb = 0; rb < 2; ++rb)
#pragma unroll
    for (int reg = 0; reg < 16; ++reg) {
      float s1 = 0.f, s2 = 0.f;
#pragma unroll
      for (int eb = 0; eb < 4; ++eb) { const float v = acc[rb][eb][reg]; s1 += v; s2 += v * v; }
      const int row = 32 * rb + crow(reg, h);
      red1[row * 132 + w * 32 + r] = s1; red2[row * 132 + w * 32 + r] = s2;
    }
  __syncthreads();
  {
    const int row = t >> 2, q = t & 3;
    float s1 = 0.f, s2 = 0.f;
#pragma unroll
    for (int k = 0; k < 32; ++k) { s1 += red1[row * 132 + q * 32 + k]; s2 += red2[row * 132 + q * 32 + k]; }
    s1 += __shfl_xor(s1, 1); s2 += __shfl_xor(s2, 1);
    s1 += __shfl_xor(s1, 2); s2 += __shfl_xor(s2, 2);
    const float mu = s1 * (1.f / 512.f);
    const float var = fmaxf(s2 * (1.f / 512.f) - mu * mu, 0.f);
    if (q == 0) { smu[row] = mu; srs[row] = rsqrtf(var + GN_EPS); }
  }
  __syncthreads();
  const u16* __restrict__ GS = (const u16*)(p.ws + R_GS); u16* __restrict__ OB = (u16*)(p.ws + WS_ACT2);
#pragma unroll
  for (int rb = 0; rb < 2; ++rb)
#pragma unroll
    for (int rq = 0; rq < 4; ++rq) {
      u16 gg[4][4];
#pragma unroll
      for (int q = 0; q < 4; ++q)
#pragma unroll
        for (int eb = 0; eb < 4; ++eb) gg[q][eb] = GS[(trow0 + 32 * rb + crow(4 * rq + q, h)) * 2048 + hh * 512 + 128 * w + r + 32 * eb];
#pragma unroll
      for (int q = 0; q < 4; ++q) {
        const int reg = 4 * rq + q, row = 32 * rb + crow(reg, h);
        const float mu = smu[row], rs = srs[row];
        const size_t o = (trow0 + row) * 2048 + hh * 512 + 128 * w + r;
#pragma unroll
        for (int eb = 0; eb < 4; ++eb) OB[o + 32 * eb] = f2bf((acc[rb][eb][reg] - mu) * rs * bf2f(gg[q][eb]));
      }
    }
}

enum { PH_PREP = 0, PH_QKV, PH_ATTN, PH_AO, PH_RIN, PH_RETU, PH_SCAN, PH_RETO, PH_RO, PH_LNM, PH_FIN, PH_CONV, PH_FOUT, PH_LNF };

DI void run_phase(const Params& p, int ph, int layer, u16* lds, int vb, bool noepi = false, bool fuse_ln = false) {
  u16* hl = lds + __builtin_amdgcn_readfirstlane(tid512() >> 8) * LDS_HALF_E;
  switch (ph) {
    case PH_PREP: phase_prep(p, hl); break;
    case PH_QKV: gemm_phase<G_QKV>(p, layer, lds, vb); break;
    case PH_ATTN: phase_attn(p, layer, hl); break;
    case PH_AO: gemm_phase<G_AO>(p, layer, lds, vb, false, fuse_ln); break;
    case PH_RIN: gemm_phase<G_RIN>(p, layer, lds, vb); break;
    case PH_RETU: phase_ret_u(p, layer, lds); break;
    case PH_SCAN: phase_ret_scan(p, layer); break;
    case PH_RETO: for (int item = bidx(); item < 1024; item += NVB) ret_out_item(p, item, hl); break;
    case PH_RO: gemm_phase<G_RO>(p, layer, lds, vb, false, fuse_ln); break;
    case PH_LNM: phase_ln(p, p.in[I_LMG] + layer * 1024, p.in[I_LMB] + layer * 1024, false, (layer & 1) ? 32 : 16); break;
    case PH_FIN: gemm_phase<G_FIN>(p, layer, lds, vb, noepi); break;
    case PH_CONV: phase_conv(p, layer); break;
    case PH_FOUT: gemm_phase<G_FOUT>(p, layer, lds, vb, false, fuse_ln); break;
    case PH_LNF: phase_ln(p, p.in[I_LFG] + layer * 1024, p.in[I_LFB] + layer * 1024, layer == 3, 44); break;
  }
}

#if !MEGA
__global__ void __launch_bounds__(512, 2) k_phase(Params p, int ph, int layer) {
  __shared__ __attribute__((aligned(16))) u16 lds[LDS_BYTES / 2];
  run_phase(p, ph, layer, lds, (int)blockIdx.x);
}

#else
#ifndef PROBE_MASK
#define PROBE_MASK 0
#endif
#ifndef PROBE_NOEPI
#define PROBE_NOEPI 0
#endif
__global__ void __launch_bounds__(512, 2) k_mega(Params p) {
  __shared__ __attribute__((aligned(16))) u16 lds[LDS_BYTES / 2];
  __shared__ uint4 xb_words;
  cg::grid_group grid = cg::this_grid();
  if (__builtin_amdgcn_workitem_id_x() == 0) xb_words = make_uint4(0u, 0u, 0u, (unsigned)__builtin_amdgcn_workgroup_id_x());
  __syncthreads();
  XcdBarrier xb = xcd_barrier_post((unsigned*)(p.ws + WS_BAR), (volatile LAS unsigned*)&xb_words);
  {
    Params q = p;
    asm volatile("" : "+s"(q.out)); asm volatile("" : "+s"(q.ws));
    const int rep0 = ((PROBE_MASK >> PH_PREP) & 1) ? 2 : 1;
    for (int rr = 0; rr < rep0; ++rr) run_phase(q, PH_PREP, 0, lds, 0);
    if (p.ws == nullptr) grid.sync();
    xcd_barrier(xb);
    if (__builtin_amdgcn_workitem_id_x() == 0) {
      unsigned* bar = (unsigned*)(p.ws + WS_BAR);
      const unsigned G = gridDim.x;
      unsigned cnt = 0u, mine = 0u, dense = 0u; bool uni = true;
#pragma unroll
      for (unsigned j = 0; j < 16; ++j) {
        const unsigned c = xb_ld(&bar[XB_XCNT(j)]);
        cnt += (c > 0u) ? 1u : 0u; mine = (j == xb.x) ? c : mine; dense += (j < xb.x && c > 0u) ? 1u : 0u;
        uni = uni && (c == 0u || c * 8u == G);
      }
      const unsigned rank = xb_words.z;
      xb_words.x = mine > 0u ? mine : 1u; xb_words.y = cnt > 0u ? cnt : 1u;
      xb_words.w = (uni && cnt == 8u && rank < (G >> 3)) ? dense * (G >> 3) + rank : (unsigned)__builtin_amdgcn_workgroup_id_x();
    }
    __syncthreads();
  }
#pragma unroll 1
  for (int step = 1; step < 29; ++step) {
    int ph, layer, idx;
    {
      const int s = step - 1;
      if (s < 6) { layer = 0; idx = s; } else if (s < 14) { layer = 1; idx = s - 6; } else if (s < 20) { layer = 2; idx = s - 14; } else { layer = 3; idx = s - 20; }
      if (layer & 1) ph = (idx < 5) ? (PH_RIN + idx) : (PH_FIN + idx - 5);
      else ph = (idx < 3) ? (PH_QKV + idx) : (PH_FIN + idx - 3);
    }
    Params q = p;
#pragma unroll
    for (int i = 0; i < 19; ++i) asm volatile("" : "+s"(q.in[i]));
    asm volatile("" : "+s"(q.out)); asm volatile("" : "+s"(q.ws));
    const int rep = ((PROBE_MASK >> ph) & 1) ? 2 : 1;
    const int vb = (int)xb_words.w;
    for (int rr = 0; rr < rep; ++rr) run_phase(q, ph, layer, lds, vb, PROBE_NOEPI && rr > 0, true);
    if (step < 28) xcd_barrier(xb);
  }
}
#endif

extern "C" void kernel_launch(void* const* d_in, const int* in_sizes, int n_in, void* d_out, int out_size, void* d_ws, size_t ws_size, hipStream_t stream) {
  static int grid_blocks = 0;
  if (!grid_blocks) {
    int dev = 0, cus = 0, per_cu = 0;
    (void)hipGetDevice(&dev);
    (void)hipDeviceGetAttribute(&cus, hipDeviceAttributeMultiprocessorCount, dev);
#if MEGA
    (void)hipOccupancyMaxActiveBlocksPerMultiprocessor(&per_cu, k_mega, 512, 0);
#else
    (void)hipOccupancyMaxActiveBlocksPerMultiprocessor(&per_cu, k_phase, 512, 0);
#endif
    if (per_cu < 1) per_cu = 1;
    if (per_cu > 1) per_cu = 1;
    grid_blocks = cus * per_cu;
    if (n_in != 19 || ws_size < WS_END) fprintf(stderr, "kernel_launch: unexpected n_in %d or ws %zu < %zu\n", n_in, ws_size, (size_t)WS_END);
  }
  Params p{};
  for (int i = 0; i < 19; ++i) p.in[i] = (const float*)d_in[i];
  p.out = (float*)d_out; p.ws = (unsigned char*)d_ws;
#if MEGA
  (void)hipMemsetAsync((unsigned char*)d_ws + WS_BAR, 0, 16384, stream);
  void* args[] = {&p};
  hipError_t e = hipLaunchCooperativeKernel((void*)k_mega, dim3(grid_blocks), dim3(512), args, 0, stream);
  if (e != hipSuccess) fprintf(stderr, "cooperative launch failed: %s (grid %d)\n", hipGetErrorString(e), grid_blocks);
#else
  auto L = [&](int ph, int layer) { hipLaunchKernelGGL(k_phase, dim3(grid_blocks), dim3(512), 0, stream, p, ph, layer); };
  L(PH_PREP, 0);
  for (int layer = 0; layer < 4; ++layer) {
    if ((layer & 1) == 0) { L(PH_QKV, layer); L(PH_ATTN, layer); L(PH_AO, layer); }
    else { L(PH_RIN, layer); L(PH_RETU, layer); L(PH_SCAN, layer); L(PH_RETO, layer); L(PH_RO, layer); }
    L(PH_LNM, layer); L(PH_FIN, layer); L(PH_CONV, layer); L(PH_FOUT, layer); L(PH_LNF, layer);
  }
#endif
}
```

```cpp
#include <hip/hip_runtime.h>
#include <hip/hip_cooperative_groups.h>
#include <cstdio>
namespace cg = cooperative_groups;

#ifndef MEGA
#define MEGA 1
#endif

typedef unsigned short u16;
using f32x4 = __attribute__((ext_vector_type(4))) float;
using bf16x8 = __attribute__((ext_vector_type(8))) short;
using f32x16 = __attribute__((ext_vector_type(16))) float;
#define DI __device__ __forceinline__
#define MFMA(a, b, c) __builtin_amdgcn_mfma_f32_32x32x16_bf16((a), (b), (c), 0, 0, 0)

constexpr int D = 1024, SEQ = 8192, MP = 16384, MS = 128, MT = MP + MS;
constexpr int DFF = 2816;
constexpr float ALPHA = 1.6817928305074290f;
constexpr float LN_EPS = 1e-5f, GN_EPS = 1e-5f;

constexpr size_t O_YP = 0;
constexpr size_t O_YS = O_YP + (size_t)MP * D;
constexpr size_t O_KWP = O_YS + (size_t)MS * D;
constexpr size_t O_VWP = O_KWP + 2ull * 2 * 128 * 256;
constexpr size_t O_RSP = O_VWP + 2ull * 2 * 128 * 256;
constexpr size_t O_CSP = O_RSP + 2ull * 2 * 4 * 256 * 512;
constexpr size_t O_KWS = O_CSP + 4ull * 2 * 2 * DFF;
constexpr size_t O_VWS = O_KWS + 2ull * 128 * 128 * 256;
constexpr size_t O_RSS = O_VWS + 2ull * 128 * 128 * 256;
constexpr size_t O_CSS = O_RSS + 2ull * 128 * 4 * 256 * 512;

constexpr size_t al(size_t x) { return (x + 255) & ~size_t(255); }
constexpr size_t WS_WQKV = 0;
constexpr size_t WS_WAO = WS_WQKV + 2ull * 1536 * 1024 * 2;
constexpr size_t WS_WRIN = WS_WAO + 2ull * 1024 * 1024 * 2;
constexpr size_t WS_WRO = WS_WRIN + 2ull * 6144 * 1024 * 2;
constexpr size_t WS_WFIN = WS_WRO + 2ull * 1024 * 2048 * 2;
constexpr size_t WS_WFOUT = WS_WFIN + 4ull * 5632 * 1024 * 2;
constexpr size_t WS_TROPE = WS_WFOUT + 4ull * 1024 * 2816 * 2;
constexpr size_t WS_TRET = WS_TROPE + al(2ull * 8193 * 32 * 4);
constexpr size_t WS_X = WS_TRET + al(2ull * 8193 * 128 * 4);
constexpr size_t WS_XB = WS_X + (size_t)MT * 1024 * 4;
constexpr size_t WS_Y = WS_XB + (size_t)MT * 1024 * 2;
constexpr size_t WS_ACT = WS_Y + (size_t)MT * 1024 * 4;
constexpr size_t WS_ACT2 = WS_ACT + 268435456ull;
constexpr size_t WS_US = WS_ACT2 + (size_t)MT * 2816 * 2;
constexpr size_t WS_SMP = WS_US + 134217728ull;
constexpr size_t WS_BAR = WS_SMP + 128ull * 4096 * 4;
constexpr size_t WS_PART = WS_BAR + 16384;
constexpr size_t WS_PART2 = WS_PART + 4ull * 44 * 128 * 256 * 4;
constexpr size_t WS_END = WS_PART2 + 24ull * 16 * 128 * 256 * 4;
constexpr size_t A_Q = WS_ACT;
constexpr size_t A_K = A_Q + (size_t)MT * 1024 * 2;
constexpr size_t A_VT = A_K + (size_t)MP * 256 * 2;
constexpr size_t R_Q = WS_ACT;
constexpr size_t R_K = R_Q + (size_t)MT * 1024 * 2;
constexpr size_t R_KT = R_K + (size_t)MT * 1024 * 2;
constexpr size_t R_VT = R_KT + 2ull * 1024 * 8192 * 2;
constexpr size_t R_GS = R_VT + 2ull * 2048 * 8192 * 2;
static_assert(R_GS + (size_t)MT * 2048 * 2 <= WS_ACT2, "act region");
constexpr size_t F_UA = WS_ACT;
constexpr size_t F_UG = F_UA + (size_t)MT * 2816 * 2;

struct Params {
  const float* in[19];
  float* out;
  unsigned char* ws;
};
enum { I_XP = 0, I_XS, I_CK, I_CV, I_SR, I_SC, I_WQKV, I_SINK, I_WAO, I_WRIN, I_WRO, I_WFIN, I_CW, I_CB, I_WFOUT, I_LMG, I_LMB, I_LFG, I_LFB };

DI int tid512() { int t = __builtin_amdgcn_workitem_id_x(); asm volatile("" : "+v"(t)); return t; }
DI int bid_real() { int b = __builtin_amdgcn_workgroup_id_x(); asm volatile("" : "+s"(b)); return b; }
DI int tidx() { return tid512() & 255; }
DI int bidx() { return 2 * bid_real() + __builtin_amdgcn_readfirstlane(tid512() >> 8); }
#define NVB (2 * (int)gridDim.x)
DI u16 f2bf(float x) { return __builtin_bit_cast(u16, (__bf16)x); }
DI float bf2f(u16 v) { return __uint_as_float(((unsigned)v) << 16); }
DI unsigned pack2(float a, float b) { return (unsigned)f2bf(a) | ((unsigned)f2bf(b) << 16); }
DI int crow(int reg, int h) { return (reg & 3) + 8 * (reg >> 2) + 4 * h; }
DI float silu(float x) { return x / (1.f + __expf(-x)); }
DI float lg2gamma(int hh) { return hh == 0 ? -0.04580368961312479f : hh == 1 ? -0.02272007650008353f : hh == 2 ? -0.011315313227834146f : -0.005646563141142063f; }

DI float wave_max(float v) {
#pragma unroll
  for (int o = 32; o >= 1; o >>= 1) v = fmaxf(v, __shfl_xor(v, o));
  return v;
}
DI float wave_sum(float v) {
#pragma unroll
  for (int o = 32; o >= 1; o >>= 1) v += __shfl_xor(v, o);
  return v;
}

DI void sincos_d(double x, float& s, float& c) {
  const double n = rint(x * 0.63661977236758134308);
  double r = fma(-n, 1.57079632673412561417e+00, x);
  r = fma(-n, 6.07710050650619224932e-11, r);
  const double r2 = r * r;
  double sp = 1.0 / 6227020800.0;
  sp = fma(sp, r2, -1.0 / 39916800.0); sp = fma(sp, r2, 1.0 / 362880.0); sp = fma(sp, r2, -1.0 / 5040.0);
  sp = fma(sp, r2, 1.0 / 120.0); sp = fma(sp, r2, -1.0 / 6.0); sp = fma(sp, r2, 1.0);
  const double sn = sp * r;
  double cp = -1.0 / 87178291200.0;
  cp = fma(cp, r2, 1.0 / 479001600.0); cp = fma(cp, r2, -1.0 / 3628800.0); cp = fma(cp, r2, 1.0 / 40320.0);
  cp = fma(cp, r2, -1.0 / 720.0); cp = fma(cp, r2, 1.0 / 24.0); cp = fma(cp, r2, -0.5); cp = fma(cp, r2, 1.0);
  const int q = ((int)n) & 3;
  const double ss = (q & 1) ? cp : sn, cc = (q & 1) ? sn : cp;
  s = (float)((q == 2 || q == 3) ? -ss : ss);
  c = (float)((q == 1 || q == 2) ? -cc : cc);
}

constexpr int LSTR = 72;
constexpr int TILE_E = 256 * LSTR;
constexpr int LDS_BYTES = 4 * TILE_E * 2;
constexpr int LDS_HALF_E = LDS_BYTES / 4;

DI void gemm_core(const u16* __restrict__ A, size_t lda, const u16* __restrict__ Bt, size_t ldb, int K, u16* lds, f32x16 (&acc)[4][2]) {
  const int t = tid512(), lane = t & 63, w = t >> 6, wm = w >> 2, wn = w & 3, r = lane & 31, h = lane >> 5;
  u16* As = lds; u16* Bs = lds + 2 * TILE_E;
  const int lrow = t >> 3, lk = (t & 7) * 8;
  const u16* Ag = A + (size_t)lrow * lda + lk;
  const u16* Bg = Bt + (size_t)lrow * ldb + lk;
#define GLOAD(P, ko) \
  P##a0 = *(const uint4*)(Ag + (ko)); P##a1 = *(const uint4*)(Ag + (size_t)64 * lda + (ko)); P##a2 = *(const uint4*)(Ag + (size_t)128 * lda + (ko)); P##a3 = *(const uint4*)(Ag + (size_t)192 * lda + (ko)); \
  P##b0 = *(const uint4*)(Bg + (ko)); P##b1 = *(const uint4*)(Bg + (size_t)64 * ldb + (ko)); P##b2 = *(const uint4*)(Bg + (size_t)128 * ldb + (ko)); P##b3 = *(const uint4*)(Bg + (size_t)192 * ldb + (ko));
#define LSTORE(P, buf) { u16* ad_ = As + (buf) * TILE_E + lrow * LSTR + lk; u16* bd_ = Bs + (buf) * TILE_E + lrow * LSTR + lk; \
  *(uint4*)(ad_) = P##a0; *(uint4*)(ad_ + 64 * LSTR) = P##a1; *(uint4*)(ad_ + 128 * LSTR) = P##a2; *(uint4*)(ad_ + 192 * LSTR) = P##a3; \
  *(uint4*)(bd_) = P##b0; *(uint4*)(bd_ + 64 * LSTR) = P##b1; *(uint4*)(bd_ + 128 * LSTR) = P##b2; *(uint4*)(bd_ + 192 * LSTR) = P##b3; }
#define COMPUTE(buf) { \
    const u16* as = As + (buf) * TILE_E + (wm * 128 + r) * LSTR + h * 8; \
    const u16* bs = Bs + (buf) * TILE_E + (wn * 64 + r) * LSTR + h * 8; \
    _Pragma("unroll") for (int kk = 0; kk < 4; ++kk) { \
      const bf16x8 b0 = *(const bf16x8*)(bs + kk * 16), b1 = *(const bf16x8*)(bs + 32 * LSTR + kk * 16); \
      _Pragma("unroll") for (int mi = 0; mi < 4; ++mi) { \
        const bf16x8 a = *(const bf16x8*)(as + mi * 32 * LSTR + kk * 16); \
        acc[mi][0] = MFMA(a, b0, acc[mi][0]); acc[mi][1] = MFMA(a, b1, acc[mi][1]); } } }
  uint4 pa0, pa1, pa2, pa3, pb0, pb1, pb2, pb3;
  const int nk = K >> 6;
  {
    uint4 qa0, qa1, qa2, qa3, qb0, qb1, qb2, qb3;
    GLOAD(q, 0)
    if (nk > 1) { GLOAD(p, 64) }
    __syncthreads();
    LSTORE(q, 0)
  }
#pragma unroll
  for (int a = 0; a < 4; ++a)
#pragma unroll
    for (int b = 0; b < 2; ++b)
#pragma unroll
      for (int i = 0; i < 16; ++i) acc[a][b][i] = 0.f;
  __syncthreads();
#pragma unroll 1
  for (int kt = 0; kt < nk; ++kt) {
    const int buf = kt & 1;
    if (kt + 1 < nk) LSTORE(p, buf ^ 1)
    if (kt + 2 < nk) { const int ko = (kt + 2) << 6; GLOAD(p, ko) }
    __builtin_amdgcn_sched_barrier(0);
    COMPUTE(buf)
    __syncthreads();
  }
#undef COMPUTE
#undef GLOAD
#undef LSTORE
}

DI void epi_qkv(const Params& p, int j, f32x16 (&acc)[2][2], int mb, int nb, int lane) {
  const int r = lane & 31, h = lane >> 5, slot = nb >> 6;
  const float* cosT = (const float*)(p.ws + WS_TROPE); const float* sinT = cosT + 8193 * 32;
  const bool smp = mb >= MP;
  if (slot < 20) {
    u16* Q = (u16*)(p.ws + A_Q); u16* KB = (u16*)(p.ws + A_K);
#pragma unroll
    for (int mi = 0; mi < 2; ++mi) {
      float cc[16], ss[16];
#pragma unroll
      for (int reg = 0; reg < 16; ++reg) {
        const int row = mb + mi * 32 + crow(reg, h);
        const int pos = smp ? 8192 : (row & 8191);
        cc[reg] = cosT[pos * 32 + r]; ss[reg] = sinT[pos * 32 + r];
      }
#pragma unroll
      for (int reg = 0; reg < 16; ++reg) {
        const int row = mb + mi * 32 + crow(reg, h);
        const int pos = smp ? 8192 : (row & 8191);
        const float c = cc[reg], s = ss[reg];
        const float x1 = acc[mi][0][reg], x2 = acc[mi][1][reg];
        const float o1 = x1 * c - x2 * s, o2 = x2 * c + x1 * s;
        if (slot < 16) {
          Q[(size_t)row * 1024 + nb + r] = f2bf(o1 * 0.125f); Q[(size_t)row * 1024 + nb + 32 + r] = f2bf(o2 * 0.125f);
        } else {
          const int kvh = slot - 16;
          if (!smp) {
            KB[(size_t)row * 256 + kvh * 64 + r] = f2bf(o1); KB[(size_t)row * 256 + kvh * 64 + 32 + r] = f2bf(o2);
            if (pos >= 8064) { const int b = row >> 13; float* o = p.out + O_KWP + ((size_t)((j * 2 + b) * 128 + (pos - 8064)) * 4 + kvh) * 64; o[r] = o1; o[32 + r] = o2; }
          } else {
            const int b = row - MP; float* o = p.out + O_KWS + ((size_t)((j * 128 + b) * 128 + 127) * 4 + kvh) * 64; o[r] = o1; o[32 + r] = o2;
          }
        }
      }
    }
  } else {
    const int kvh = slot - 20;
    if (!smp) {
      u16* VT = (u16*)(p.ws + A_VT);
      const int b = mb >> 13;
#pragma unroll
      for (int mi = 0; mi < 2; ++mi)
#pragma unroll
        for (int ni = 0; ni < 2; ++ni)
#pragma unroll
          for (int g4 = 0; g4 < 4; ++g4) {
            const int t0 = (mb & 8191) + mi * 32 + 8 * g4 + 4 * h, d = ni * 32 + r;
            uint2 v; v.x = pack2(acc[mi][ni][4 * g4], acc[mi][ni][4 * g4 + 1]); v.y = pack2(acc[mi][ni][4 * g4 + 2], acc[mi][ni][4 * g4 + 3]);
            *(uint2*)(VT + (size_t)(b * 256 + kvh * 64 + d) * 8192 + t0) = v;
            if (t0 >= 8064) {
#pragma unroll
              for (int q = 0; q < 4; ++q) p.out[O_VWP + ((size_t)((j * 2 + b) * 128 + (t0 + q - 8064)) * 4 + kvh) * 64 + d] = acc[mi][ni][4 * g4 + q];
            }
          }
    } else {
#pragma unroll
      for (int mi = 0; mi < 2; ++mi)
#pragma unroll
        for (int ni = 0; ni < 2; ++ni)
#pragma unroll
          for (int reg = 0; reg < 16; ++reg) {
            const int b = mb - MP + mi * 32 + crow(reg, h);
            p.out[O_VWS + ((size_t)((j * 128 + b) * 128 + 127) * 4 + kvh) * 64 + ni * 32 + r] = acc[mi][ni][reg];
          }
    }
  }
}

DI void epi_res(const Params& p, f32x16 (&acc)[2][2], int mb, int nb, int lane) {
  const int r = lane & 31, h = lane >> 5;
  const float* __restrict__ X = (const float*)(p.ws + WS_X); float* __restrict__ Y = (float*)(p.ws + WS_Y);
#pragma unroll
  for (int mi = 0; mi < 2; ++mi) {
    float xv[2][16];
#pragma unroll
    for (int ni = 0; ni < 2; ++ni)
#pragma unroll
      for (int reg = 0; reg < 16; ++reg) xv[ni][reg] = X[(size_t)(mb + mi * 32 + crow(reg, h)) * 1024 + nb + ni * 32 + r];
#pragma unroll
    for (int ni = 0; ni < 2; ++ni)
#pragma unroll
      for (int reg = 0; reg < 16; ++reg) Y[(size_t)(mb + mi * 32 + crow(reg, h)) * 1024 + nb + ni * 32 + r] = ALPHA * xv[ni][reg] + acc[mi][ni][reg];
  }
}

DI void epi_rin(const Params& p, int j, f32x16 (&acc)[2][2], int mb, int nb, int lane) {
  const int r = lane & 31, h = lane >> 5, slot = nb >> 6;
  const bool smp = mb >= MP;
  const int b = mb >> 13;
  if (slot < 32) {
    const bool isq = slot < 16;
    const int hh = (slot & 15) >> 2, cbase = nb & 255, ncol = nb & 1023;
    const float lg = lg2gamma(hh);
    const float* cosR = (const float*)(p.ws + WS_TRET); const float* sinR = cosR + 8193 * 128;
#pragma unroll
    for (int mi = 0; mi < 2; ++mi)
#pragma unroll
      for (int ni = 0; ni < 2; ++ni) {
        const int pidx = (cbase + ni * 32 + r) >> 1;
        float cc[16], ss[16];
#pragma unroll
        for (int reg = 0; reg < 16; ++reg) {
          const int row = mb + mi * 32 + crow(reg, h);
          const int pos = smp ? 8192 : (row & 8191);
          cc[reg] = cosR[pos * 128 + pidx]; ss[reg] = sinR[pos * 128 + pidx];
        }
#pragma unroll
        for (int reg = 0; reg < 16; ++reg) {
          const int row = mb + mi * 32 + crow(reg, h);
          const int pos = smp ? 8192 : (row & 8191);
          const float mine = acc[mi][ni][reg], other = __shfl_xor(mine, 1);
          const float rot = (r & 1) ? (mine * cc[reg] + other * ss[reg]) : (mine * cc[reg] - other * ss[reg]);
          const float e = (float)((smp ? 0 : (pos & 127)) + 1) * lg;
          acc[mi][ni][reg] = isq ? rot * exp2f(e) : rot * 0.0625f * exp2f(-e);
        }
        __builtin_amdgcn_sched_barrier(0);
      }
    if (smp) {
      float* S = (float*)(p.ws + WS_SMP) + (isq ? 0 : 128 * 1024);
#pragma unroll
      for (int mi = 0; mi < 2; ++mi)
#pragma unroll
        for (int ni = 0; ni < 2; ++ni)
#pragma unroll
          for (int reg = 0; reg < 16; ++reg)
            S[(size_t)(mb - MP + mi * 32 + crow(reg, h)) * 1024 + ncol + ni * 32 + r] = acc[mi][ni][reg];
    } else {
      u16* N = (u16*)(p.ws + (isq ? R_Q : R_K));
#pragma unroll
      for (int mi = 0; mi < 2; ++mi)
#pragma unroll
        for (int ni = 0; ni < 2; ++ni)
#pragma unroll
          for (int reg = 0; reg < 16; ++reg)
            N[(size_t)(mb + mi * 32 + crow(reg, h)) * 1024 + ncol + ni * 32 + r] = f2bf(acc[mi][ni][reg]);
      if (!isq) {
        u16* KT = (u16*)(p.ws + R_KT);
#pragma unroll
        for (int mi = 0; mi < 2; ++mi)
#pragma unroll
          for (int ni = 0; ni < 2; ++ni)
#pragma unroll
            for (int g4 = 0; g4 < 4; ++g4) {
              const int t0 = (mb & 8191) + mi * 32 + 8 * g4 + 4 * h;
              uint2 v; v.x = pack2(acc[mi][ni][4 * g4], acc[mi][ni][4 * g4 + 1]); v.y = pack2(acc[mi][ni][4 * g4 + 2], acc[mi][ni][4 * g4 + 3]);
              *(uint2*)(KT + (size_t)(b * 1024 + ncol + ni * 32 + r) * 8192 + t0) = v;
            }
      }
    }
  } else if (slot < 64) {
    const int cv = nb - 2048;
    if (smp) {
      float* SV = (float*)(p.ws + WS_SMP) + 2 * 128 * 1024;
#pragma unroll
      for (int mi = 0; mi < 2; ++mi)
#pragma unroll
        for (int ni = 0; ni < 2; ++ni)
#pragma unroll
          for (int reg = 0; reg < 16; ++reg)
            SV[(size_t)(mb - MP + mi * 32 + crow(reg, h)) * 2048 + cv + ni * 32 + r] = acc[mi][ni][reg];
    } else {
      u16* VT = (u16*)(p.ws + R_VT);
#pragma unroll
      for (int mi = 0; mi < 2; ++mi)
#pragma unroll
        for (int ni = 0; ni < 2; ++ni)
#pragma unroll
          for (int g4 = 0; g4 < 4; ++g4) {
            const int t0 = (mb & 8191) + mi * 32 + 8 * g4 + 4 * h;
            uint2 v; v.x = pack2(acc[mi][ni][4 * g4], acc[mi][ni][4 * g4 + 1]); v.y = pack2(acc[mi][ni][4 * g4 + 2], acc[mi][ni][4 * g4 + 3]);
            *(uint2*)(VT + (size_t)(b * 2048 + cv + ni * 32 + r) * 8192 + t0) = v;
          }
    }
  } else {
    u16* GS = (u16*)(p.ws + R_GS);
    const int cg_ = nb - 4096;
#pragma unroll
    for (int mi = 0; mi < 2; ++mi)
#pragma unroll
      for (int ni = 0; ni < 2; ++ni)
#pragma unroll
        for (int reg = 0; reg < 16; ++reg)
          GS[(size_t)(mb + mi * 32 + crow(reg, h)) * 2048 + cg_ + ni * 32 + r] = f2bf(silu(acc[mi][ni][reg]));
  }
}

DI void epi_fin(const Params& p, int i, f32x16 (&acc)[2][2], int mb, int nb, int lane) {
  const int r = lane & 31, h = lane >> 5;
  const bool smp = mb >= MP;
  if (nb < DFF) {
    u16* UA = (u16*)(p.ws + F_UA);
#pragma unroll
    for (int mi = 0; mi < 2; ++mi)
#pragma unroll
      for (int ni = 0; ni < 2; ++ni)
#pragma unroll
        for (int reg = 0; reg < 16; ++reg) {
          const int row = mb + mi * 32 + crow(reg, h), col = nb + ni * 32 + r;
          const float v = acc[mi][ni][reg];
          UA[(size_t)row * DFF + col] = f2bf(v);
          if (smp) {
            p.out[O_CSS + ((size_t)(i * 128 + (row - MP)) * 2 + 1) * DFF + col] = v;
          } else {
            const int pos = row & 8191;
            if (pos >= 8190) p.out[O_CSP + ((size_t)(i * 2 + (row >> 13)) * 2 + (pos - 8190)) * DFF + col] = v;
          }
        }
  } else {
    u16* UG = (u16*)(p.ws + F_UG);
#pragma unroll
    for (int mi = 0; mi < 2; ++mi)
#pragma unroll
      for (int ni = 0; ni < 2; ++ni)
#pragma unroll
        for (int reg = 0; reg < 16; ++reg)
          UG[(size_t)(mb + mi * 32 + crow(reg, h)) * DFF + (nb - DFF) + ni * 32 + r] = f2bf(acc[mi][ni][reg]);
  }
}

#define XB_TMO      128
#define XB_XCNT(j)  (256  + 64 * (j))
#define XB_XSUB(j)  (1280 + 64 * (j))
#define XB_XGEN(j)  (2304 + 64 * (j))
#define XB_TOP      3328
#define XB_TOPGEN   3392
#define XCD_BAR_WORDS 3456
#define XB_SPIN_CAP (1u << 20)
#define LAS __attribute__((address_space(3)))
DI unsigned xb_ld(unsigned* p) { return __hip_atomic_load(p, __ATOMIC_RELAXED, __HIP_MEMORY_SCOPE_AGENT); }
DI unsigned xb_add(unsigned* p, unsigned v) { return __hip_atomic_fetch_add(p, v, __ATOMIC_RELAXED, __HIP_MEMORY_SCOPE_AGENT); }
DI unsigned xb_xcc_id() { return (unsigned)__builtin_amdgcn_s_getreg((3 << 11) | 20) & 0xFu; }
#define XB_SPIN(cond, bar) do { unsigned _sp = 0; while (cond) { __builtin_amdgcn_s_sleep(1); \
    if ((++_sp & 255u) == 0u) { if (xb_ld(&(bar)[XB_TMO])) break; if (_sp > XB_SPIN_CAP) { atomicAdd(&(bar)[XB_TMO], 1u); break; } } } } while (0)
struct XcdBarrier { unsigned* bar; unsigned x; volatile LAS unsigned* st; };
DI XcdBarrier xcd_barrier_post(unsigned* bar, volatile LAS unsigned* st) {
  XcdBarrier b; b.bar = bar; b.x = xb_xcc_id(); b.st = st;
  if (__builtin_amdgcn_workitem_id_x() == 0) st[2] = xb_add(&bar[XB_XCNT(b.x)], 1u);
  return b;
}
DI void xcd_barrier_complete(unsigned* bar, unsigned x, unsigned& nloc, unsigned& nx) {
  const unsigned G = gridDim.x;
  unsigned sum, cnt, mine, sp = 0u;
  for (;;) {
    sum = 0u; cnt = 0u; mine = 0u;
#pragma unroll
    for (unsigned j = 0; j < 16; ++j) { const unsigned c = xb_ld(&bar[XB_XCNT(j)]); sum += c; cnt += (c > 0u) ? 1u : 0u; mine = (j == x) ? c : mine; }
    if (sum == G) break;
    __builtin_amdgcn_s_sleep(1);
    if ((++sp & 255u) == 0u) { if (xb_ld(&bar[XB_TMO])) break; if (sp > XB_SPIN_CAP) { atomicAdd(&bar[XB_TMO], 1u); break; } }
  }
  nloc = mine > 0u ? mine : 1u; nx = cnt > 0u ? cnt : 1u;
}
DI void xcd_barrier(const XcdBarrier& b) {
  asm volatile("s_waitcnt vmcnt(0)" ::: "memory");
  __syncthreads();
  if (__builtin_amdgcn_workitem_id_x() == 0) {
    unsigned* bar = b.bar;
    __builtin_amdgcn_s_waitcnt(0);
    unsigned nloc = b.st[0], nx = b.st[1];
    if (nloc == 0u) { xcd_barrier_complete(bar, b.x, nloc, nx); b.st[0] = nloc; b.st[1] = nx; }
    const unsigned old = xb_add(&bar[XB_XSUB(b.x)], 1u);
    const unsigned gen = old / nloc;
    if (old + 1u == (gen + 1u) * nloc) {
      __builtin_amdgcn_fence(__ATOMIC_RELEASE, "agent");
      asm volatile("s_waitcnt vmcnt(0)" ::: "memory");
      const unsigned og = xb_add(&bar[XB_TOP], 1u);
      const unsigned tg = og / nx;
      if (og + 1u == (tg + 1u) * nx) xb_add(&bar[XB_TOPGEN], 1u);
      else XB_SPIN(xb_ld(&bar[XB_TOPGEN]) == tg, bar);
      __builtin_amdgcn_fence(__ATOMIC_ACQUIRE, "agent");
      xb_add(&bar[XB_XGEN(b.x)], 1u);
      asm volatile("s_waitcnt vmcnt(0)" ::: "memory");
    } else {
      XB_SPIN(xb_ld(&bar[XB_XGEN(b.x)]) == gen, bar);
      __builtin_amdgcn_fence(__ATOMIC_ACQUIRE, "agent");
      asm volatile("s_waitcnt vmcnt(0)" ::: "memory");
    }
  }
  __syncthreads();
}

DI void signal_cnt(unsigned* c) {
  asm volatile("s_waitcnt vmcnt(0)" ::: "memory");
  __syncthreads();
  if (__builtin_amdgcn_workitem_id_x() == 0) { __builtin_amdgcn_fence(__ATOMIC_RELEASE, "agent"); asm volatile("s_waitcnt vmcnt(0)" ::: "memory"); (void)xb_add(c, 1u); }
}
DI void wait_cnt(unsigned* c, unsigned target, unsigned* bar) {
  if (__builtin_amdgcn_workitem_id_x() == 0) { XB_SPIN(xb_ld(c) < target, bar); __builtin_amdgcn_fence(__ATOMIC_ACQUIRE, "agent"); asm volatile("s_waitcnt vmcnt(0)" ::: "memory"); }
  __syncthreads();
}
constexpr int LN_CNT_WORD0 = XCD_BAR_WORDS;

DI void ln_row(const Params& p, int row, const float4 (&gv)[4], const float4 (&bv)[4], bool last, int nkk, int lane) {
  const float* Y = (const float*)(p.ws + WS_Y);
  float* X = (float*)(p.ws + WS_X); u16* XB = (u16*)(p.ws + WS_XB);
  float4 v[4];
  if (row < MP) {
    const float4* y = (const float4*)(Y + (size_t)row * 1024);
#pragma unroll
    for (int i = 0; i < 4; ++i) v[i] = y[lane + 64 * i];
  } else {
    const float4* x = (const float4*)(X + (size_t)row * 1024);
#pragma unroll
    for (int i = 0; i < 4; ++i) { const float4 t = x[lane + 64 * i]; v[i].x = ALPHA * t.x; v[i].y = ALPHA * t.y; v[i].z = ALPHA * t.z; v[i].w = ALPHA * t.w; }
    const float* __restrict__ PART = (const float*)(p.ws + WS_PART);
    for (int ks = 0; ks < nkk; ks += 4) {
      float4 t[4][4];
#pragma unroll
      for (int u = 0; u < 4; ++u)
#pragma unroll
        for (int i = 0; i < 4; ++i)
          t[u][i] = *(const float4*)(PART + ((size_t)(i * nkk + ks + u) * 128 + (row - MP)) * 256 + lane * 4);
#pragma unroll
      for (int u = 0; u < 4; ++u)
#pragma unroll
        for (int i = 0; i < 4; ++i) { v[i].x += t[u][i].x; v[i].y += t[u][i].y; v[i].z += t[u][i].z; v[i].w += t[u][i].w; }
    }
  }
  float sm = 0.f;
#pragma unroll
  for (int i = 0; i < 4; ++i) sm += v[i].x + v[i].y + v[i].z + v[i].w;
  const float mu = wave_sum(sm) * (1.f / 1024.f);
  float q = 0.f;
#pragma unroll
  for (int i = 0; i < 4; ++i) { v[i].x -= mu; v[i].y -= mu; v[i].z -= mu; v[i].w -= mu; q += v[i].x * v[i].x + v[i].y * v[i].y + v[i].z * v[i].z + v[i].w * v[i].w; }
  const float rs = rsqrtf(wave_sum(q) * (1.f / 1024.f) + LN_EPS);
  float4* xo = last ? (float4*)(p.out + (row < MP ? O_YP + (size_t)row * 1024 : O_YS + (size_t)(row - MP) * 1024)) : (float4*)(X + (size_t)row * 1024);
#pragma unroll
  for (int i = 0; i < 4; ++i) {
    float4 o;
    o.x = v[i].x * rs * gv[i].x + bv[i].x; o.y = v[i].y * rs * gv[i].y + bv[i].y;
    o.z = v[i].z * rs * gv[i].z + bv[i].z; o.w = v[i].w * rs * gv[i].w + bv[i].w;
    xo[lane + 64 * i] = o;
    if (!last) { uint2 ob; ob.x = pack2(o.x, o.y); ob.y = pack2(o.z, o.w); *(uint2*)(XB + (size_t)row * 1024 + (lane + 64 * i) * 4) = ob; }
  }
}
DI void ln_rows4(const Params& p, int row0, const float4 (&gv)[4], const float4 (&bv)[4], bool last, int lane) {
  const float* Y = (const float*)(p.ws + WS_Y);
  float* X = (float*)(p.ws + WS_X); u16* XB = (u16*)(p.ws + WS_XB);
  float4 v[4][4];
#pragma unroll
  for (int q = 0; q < 4; ++q)
#pragma unroll
    for (int i = 0; i < 4; ++i) v[q][i] = ((const float4*)(Y + (size_t)(row0 + q) * 1024))[lane + 64 * i];
  float sm[4];
#pragma unroll
  for (int q = 0; q < 4; ++q) { sm[q] = 0.f;
#pragma unroll
    for (int i = 0; i < 4; ++i) sm[q] += v[q][i].x + v[q][i].y + v[q][i].z + v[q][i].w; }
#pragma unroll
  for (int o = 32; o >= 1; o >>= 1)
#pragma unroll
    for (int q = 0; q < 4; ++q) sm[q] += __shfl_xor(sm[q], o);
  float qq[4];
#pragma unroll
  for (int q = 0; q < 4; ++q) { const float mu = sm[q] * (1.f / 1024.f); qq[q] = 0.f;
#pragma unroll
    for (int i = 0; i < 4; ++i) { v[q][i].x -= mu; v[q][i].y -= mu; v[q][i].z -= mu; v[q][i].w -= mu; qq[q] += v[q][i].x * v[q][i].x + v[q][i].y * v[q][i].y + v[q][i].z * v[q][i].z + v[q][i].w * v[q][i].w; } }
#pragma unroll
  for (int o = 32; o >= 1; o >>= 1)
#pragma unroll
    for (int q = 0; q < 4; ++q) qq[q] += __shfl_xor(qq[q], o);
#pragma unroll
  for (int q = 0; q < 4; ++q) {
    const int row = row0 + q;
    const float rs = rsqrtf(qq[q] * (1.f / 1024.f) + LN_EPS);
    float4* xo = last ? (float4*)(p.out + O_YP + (size_t)row * 1024) : (float4*)(X + (size_t)row * 1024);
#pragma unroll
    for (int i = 0; i < 4; ++i) {
      float4 o;
      o.x = v[q][i].x * rs * gv[i].x + bv[i].x; o.y = v[q][i].y * rs * gv[i].y + bv[i].y;
      o.z = v[q][i].z * rs * gv[i].z + bv[i].z; o.w = v[q][i].w * rs * gv[i].w + bv[i].w;
      xo[lane + 64 * i] = o;
      if (!last) { uint2 ob; ob.x = pack2(o.x, o.y); ob.y = pack2(o.z, o.w); *(uint2*)(XB + (size_t)row * 1024 + (lane + 64 * i) * 4) = ob; }
    }
  }
}
DI void phase_ln(const Params& p, const float* __restrict__ gam, const float* __restrict__ bet, bool last, int nkk) {
  const int lane = tidx() & 63;
  const int wid = bidx() * 4 + (tidx() >> 6), nw = NVB * 4;
  float4 gv[4], bv[4];
#pragma unroll
  for (int i = 0; i < 4; ++i) { gv[i] = ((const float4*)gam)[lane + 64 * i]; bv[i] = ((const float4*)bet)[lane + 64 * i]; }
  for (int rr = wid; rr < MT; rr += nw) ln_row(p, rr < MS ? MP + rr : rr - MS, gv, bv, last, nkk, lane);
}

enum { G_QKV, G_AO, G_RIN, G_RO, G_FIN, G_FOUT };
template <int G>
DI void gemm_phase(const Params& p, int layer, u16* lds, int vb, bool noepi = false, bool fuse_ln = false) {
  const int j = layer >> 1;
  const u16* A; const u16* Bt; int K, N;
  if (G == G_QKV) { A = (const u16*)(p.ws + WS_XB); Bt = (const u16*)(p.ws + WS_WQKV) + (size_t)j * 1536 * 1024; K = 1024; N = 1536; }
  else if (G == G_AO) { A = (const u16*)(p.ws + WS_ACT2); Bt = (const u16*)(p.ws + WS_WAO) + (size_t)j * 1024 * 1024; K = 1024; N = 1024; }
  else if (G == G_RIN) { A = (const u16*)(p.ws + WS_XB); Bt = (const u16*)(p.ws + WS_WRIN) + (size_t)j * 6144 * 1024; K = 1024; N = 6144; }
  else if (G == G_RO) { A = (const u16*)(p.ws + WS_ACT2); Bt = (const u16*)(p.ws + WS_WRO) + (size_t)j * 1024 * 2048; K = 2048; N = 1024; }
  else if (G == G_FIN) { A = (const u16*)(p.ws + WS_XB); Bt = (const u16*)(p.ws + WS_WFIN) + (size_t)layer * 5632 * 1024; K = 1024; N = 5632; }
  else { A = (const u16*)(p.ws + WS_ACT2); Bt = (const u16*)(p.ws + WS_WFOUT) + (size_t)layer * 1024 * 2816; K = 2816; N = 1024; }
  constexpr bool LNF = (G == G_AO || G == G_RO || G == G_FOUT);
  constexpr bool SPLIT = LNF || (G == G_RIN);
  const int ntn = N >> 8, ntiles = (SPLIT ? 64 : 65) * ntn;
  const int t = tid512(), lane = t & 63, w = t >> 6, wm = w >> 2, wn = w & 3;
  const int per = (int)gridDim.x >> 3;
  const int xcd = vb / per, rank = vb - xcd * per;
  const int lo = (int)(((long long)xcd * ntiles) >> 3), hi = (int)(((long long)(xcd + 1) * ntiles) >> 3);
  for (int L = lo + rank; L < hi; L += per) {
    int tm, tn;
    const int full = 64 * ntn;
    if (L < full) { const int sr = L / (8 * ntn), rem = L - sr * 8 * ntn; tn = rem >> 3; tm = 8 * sr + (rem & 7); }
    else { tn = L - full; tm = 64; }
    f32x16 acc[4][2];
    gemm_core(A + (size_t)tm * 256 * K, K, Bt + (size_t)tn * 256 * K, K, K, lds, acc);
    if (tm == 64 && wm == 1) continue;
    if (noepi) { float sacc = 0.f;
#pragma unroll
      for (int a = 0; a < 4; ++a)
#pragma unroll
        for (int b = 0; b < 2; ++b)
#pragma unroll
          for (int i = 0; i < 16; ++i) sacc += acc[a][b][i];
      if (sacc == 1.2345e30f) p.out[0] = 0.f; continue; }
    const int nb = tn * 256 + wn * 64;
    float* park = (float*)lds + w * 4096 + lane;
#pragma unroll
    for (int mi = 0; mi < 2; ++mi)
#pragma unroll
      for (int ni = 0; ni < 2; ++ni)
#pragma unroll
        for (int i = 0; i < 16; ++i) park[(mi * 32 + ni * 16 + i) * 64] = acc[2 + mi][ni][i];
    f32x16 ac[2][2];
    ac[0][0] = acc[0][0]; ac[0][1] = acc[0][1]; ac[1][0] = acc[1][0]; ac[1][1] = acc[1][1];
#pragma unroll 1
    for (int hf = 0; hf < 2; ++hf) {
      if (hf) {
#pragma unroll
        for (int mi = 0; mi < 2; ++mi)
#pragma unroll
          for (int ni = 0; ni < 2; ++ni)
#pragma unroll
            for (int i = 0; i < 16; ++i) ac[mi][ni][i] = park[(mi * 32 + ni * 16 + i) * 64];
      }
      const int mb = tm * 256 + wm * 128 + hf * 64;
      if (G == G_QKV) epi_qkv(p, j, ac, mb, nb, lane);
      else if (G == G_RIN) epi_rin(p, j, ac, mb, nb, lane);
      else if (G == G_FIN) epi_fin(p, layer, ac, mb, nb, lane);
      else epi_res(p, ac, mb, nb, lane);
    }
    if (LNF && fuse_ln) signal_cnt((unsigned*)(p.ws + WS_BAR) + LN_CNT_WORD0 + (layer * 2 + (G == G_FOUT ? 1 : 0)) * 65 + tm);
  }
  if (SPLIT) {
    const int nkk = K >> 6, r = lane & 31, h = lane >> 5;
    float* PART = (float*)(p.ws + (LNF ? WS_PART : WS_PART2));
    for (int e = vb; e < ntn * nkk; e += (int)gridDim.x) {
      const int tn = e / nkk, ks = e - tn * nkk;
      f32x16 acc[4][2];
      gemm_core(A + (size_t)MP * K + ks * 64, K, Bt + (size_t)tn * 256 * K + ks * 64, K, 64, lds, acc);
      if (wm == 0) {
        float* o = PART + (size_t)e * 128 * 256 + wn * 64 + r;
#pragma unroll
        for (int mi = 0; mi < 4; ++mi)
#pragma unroll
          for (int ni = 0; ni < 2; ++ni)
#pragma unroll
            for (int i = 0; i < 16; ++i) o[(size_t)(mi * 32 + crow(i, h)) * 256 + ni * 32] = acc[mi][ni][i];
      }
      if (LNF && fuse_ln) signal_cnt((unsigned*)(p.ws + WS_BAR) + LN_CNT_WORD0 + (layer * 2 + (G == G_FOUT ? 1 : 0)) * 65 + 64);
    }
    if (LNF && fuse_ln) {
      unsigned* bar = (unsigned*)(p.ws + WS_BAR);
      unsigned* cnt = bar + LN_CNT_WORD0 + (layer * 2 + (G == G_FOUT ? 1 : 0)) * 65;
      const float* gam = (G == G_FOUT ? p.in[I_LFG] : p.in[I_LMG]) + layer * 1024;
      const float* bet = (G == G_FOUT ? p.in[I_LFB] : p.in[I_LMB]) + layer * 1024;
      const bool last = (G == G_FOUT) && layer == 3;
      float4 gv[4], bv[4];
#pragma unroll
      for (int i = 0; i < 4; ++i) { gv[i] = ((const float4*)gam)[lane + 64 * i]; bv[i] = ((const float4*)bet)[lane + 64 * i]; }
      for (int L = lo + rank; L < hi; L += per) {
        const int sr = L / (8 * ntn), rem = L - sr * 8 * ntn, tn = rem >> 3, tm = 8 * sr + (rem & 7);
        wait_cnt(cnt + tm, 4u, bar);
        ln_rows4(p, tm * 256 + tn * 64 + w * 8, gv, bv, last, lane);
        ln_rows4(p, tm * 256 + tn * 64 + w * 8 + 4, gv, bv, last, lane);
      }
      const int G_ = (int)gridDim.x;
      if (vb >= G_ - 16) {
        wait_cnt(cnt + 64, (unsigned)(4 * nkk), bar);
        ln_row(p, MP + (vb - (G_ - 16)) * 8 + w, gv, bv, last, nkk, lane);
      }
    }
  }
}

DI void transpose_job(const float* __restrict__ src, u16* __restrict__ dst, int K, int N, float* tl) {
  const int t = tidx();
  const int tn = N >> 6, ntiles = (K >> 6) * tn;
  for (int tile = bidx(); tile < ntiles; tile += NVB) {
    const int k0 = (tile / tn) << 6, n0 = (tile % tn) << 6;
    __syncthreads();
#pragma unroll
    for (int i = 0; i < 16; ++i) { const int k = (t >> 6) + 4 * i; tl[k * 65 + (t & 63)] = src[(size_t)(k0 + k) * N + n0 + (t & 63)]; }
    __syncthreads();
    const int n = t >> 2, kq = (t & 3) * 16;
    uint4 v0, v1;
    v0.x = pack2(tl[(kq + 0) * 65 + n], tl[(kq + 1) * 65 + n]); v0.y = pack2(tl[(kq + 2) * 65 + n], tl[(kq + 3) * 65 + n]);
    v0.z = pack2(tl[(kq + 4) * 65 + n], tl[(kq + 5) * 65 + n]); v0.w = pack2(tl[(kq + 6) * 65 + n], tl[(kq + 7) * 65 + n]);
    v1.x = pack2(tl[(kq + 8) * 65 + n], tl[(kq + 9) * 65 + n]); v1.y = pack2(tl[(kq + 10) * 65 + n], tl[(kq + 11) * 65 + n]);
    v1.z = pack2(tl[(kq + 12) * 65 + n], tl[(kq + 13) * 65 + n]); v1.w = pack2(tl[(kq + 14) * 65 + n], tl[(kq + 15) * 65 + n]);
    u16* o = dst + (size_t)(n0 + n) * K + k0 + kq;
    *(uint4*)o = v0; *(uint4*)(o + 8) = v1;
  }
}

DI void phase_prep(const Params& p, u16* lds) {
  float* tl = (float*)lds;
  for (int j = 0; j < 2; ++j) {
    transpose_job(p.in[I_WQKV] + (size_t)j * 1024 * 1536, (u16*)(p.ws + WS_WQKV) + (size_t)j * 1536 * 1024, 1024, 1536, tl);
    transpose_job(p.in[I_WAO] + (size_t)j * 1024 * 1024, (u16*)(p.ws + WS_WAO) + (size_t)j * 1024 * 1024, 1024, 1024, tl);
    transpose_job(p.in[I_WRIN] + (size_t)j * 1024 * 6144, (u16*)(p.ws + WS_WRIN) + (size_t)j * 6144 * 1024, 1024, 6144, tl);
    transpose_job(p.in[I_WRO] + (size_t)j * 2048 * 1024, (u16*)(p.ws + WS_WRO) + (size_t)j * 1024 * 2048, 2048, 1024, tl);
  }
  for (int i = 0; i < 4; ++i) {
    transpose_job(p.in[I_WFIN] + (size_t)i * 1024 * 5632, (u16*)(p.ws + WS_WFIN) + (size_t)i * 5632 * 1024, 1024, 5632, tl);
    transpose_job(p.in[I_WFOUT] + (size_t)i * 2816 * 1024, (u16*)(p.ws + WS_WFOUT) + (size_t)i * 1024 * 2816, 2816, 1024, tl);
  }
  const size_t gid = (size_t)bidx() * 256 + tidx(), gstride = (size_t)NVB * 256;
  {
    float4* X = (float4*)(p.ws + WS_X); uint2* XB = (uint2*)(p.ws + WS_XB);
    const size_t nv = (size_t)MT * 256, npv = (size_t)MP * 256;
    for (size_t v0 = gid; v0 < nv; v0 += 4 * gstride) {
      float4 xb[4];
#pragma unroll
      for (int u = 0; u < 4; ++u) { const size_t v = v0 + u * gstride; if (v < nv) xb[u] = (v < npv) ? ((const float4*)p.in[I_XP])[v] : ((const float4*)p.in[I_XS])[v - npv]; }
#pragma unroll
      for (int u = 0; u < 4; ++u) { const size_t v = v0 + u * gstride; if (v < nv) { X[v] = xb[u]; uint2 o; o.x = pack2(xb[u].x, xb[u].y); o.y = pack2(xb[u].z, xb[u].w); XB[v] = o; } }
    }
  }
  {
    float* cosT = (float*)(p.ws + WS_TROPE); float* sinT = cosT + 8193 * 32;
    for (size_t v = gid; v < 8193ull * 32; v += gstride) {
      const int pos = (int)(v >> 5), i = (int)(v & 31);
      const double inv = exp(-9.210340371976182736 * (double)i / 32.0);
      float s, c; sincos_d((double)pos * inv, s, c); cosT[v] = c; sinT[v] = s;
    }
    float* cosR = (float*)(p.ws + WS_TRET); float* sinR = cosR + 8193 * 128;
    for (size_t v = gid; v < 8193ull * 128; v += gstride) {
      const int pos = (int)(v >> 7), i = (int)(v & 127);
      const double inv = exp(-9.210340371976182736 * (double)i / 127.0);
      float s, c; sincos_d((double)pos * inv, s, c); cosR[v] = c; sinR[v] = s;
    }
  }
}

DI void attn_prompt_item(const Params& p, int j, int item, u16* lds) {
  const int g = item & 3, kvh = (item >> 2) & 3, qb = (item >> 4) & 63, b = item >> 10;
  const int head = kvh * 4 + g;
  const int t = tidx(), lane = t & 63, w = t >> 6, r = lane & 31, h = lane >> 5;
  u16* Ks = lds;
  u16* Vts = lds + 256 * 72;
  const u16* Q = (const u16*)(p.ws + A_Q); const u16* KB = (const u16*)(p.ws + A_K); const u16* VT = (const u16*)(p.ws + A_VT);
  u16* OB = (u16*)(p.ws + WS_ACT2);
  const int tok0 = qb * 128 - 128;
  __syncthreads();
#pragma unroll
  for (int i = 0; i < 8; ++i) {
    const int c = t + 256 * i, key = c >> 3, part = c & 7, tok = tok0 + key;
    uint4 v = make_uint4(0, 0, 0, 0);
    if (tok >= 0) v = *(const uint4*)(KB + (size_t)(b * 8192 + tok) * 256 + kvh * 64 + part * 8);
    *(uint4*)(Ks + key * 72 + part * 8) = v;
  }
#pragma unroll
  for (int i = 0; i < 8; ++i) {
    const int c = t + 256 * i, d = c >> 5, part = c & 31, tok = tok0 + part * 8;
    uint4 v = make_uint4(0, 0, 0, 0);
    if (tok >= 0) v = *(const uint4*)(VT + (size_t)(b * 256 + kvh * 64 + d) * 8192 + tok);
    *(uint4*)(Vts + d * 264 + part * 8) = v;
  }
  const size_t qrow = (size_t)b * 8192 + qb * 128 + 32 * w + r;
  bf16x8 bq[4];
#pragma unroll
  for (int kk = 0; kk < 4; ++kk) bq[kk] = *(const bf16x8*)(Q + qrow * 1024 + head * 64 + kk * 16 + h * 8);
  __syncthreads();
  f32x16 S[5];
#pragma unroll
  for (int jb = 0; jb < 5; ++jb) {
#pragma unroll
    for (int i = 0; i < 16; ++i) S[jb][i] = 0.f;
    const u16* kp = Ks + (32 * (w + jb) + r) * 72 + h * 8;
#pragma unroll
    for (int kk = 0; kk < 4; ++kk) S[jb] = MFMA(*(const bf16x8*)(kp + kk * 16), bq[kk], S[jb]);
  }
  const float sink = p.in[I_SINK][j * 16 + head];
  float m = -INFINITY;
#pragma unroll
  for (int jb = 0; jb < 5; ++jb)
#pragma unroll
    for (int reg = 0; reg < 16; ++reg) {
      const int cr = crow(reg, h);
      const int rel = 128 + r - 32 * jb - cr;
      const bool valid = (rel >= 0) && (rel <= 128) && (qb > 0 || (32 * (w + jb) + cr) >= 128);
      const float s = valid ? S[jb][reg] : -INFINITY;
      S[jb][reg] = s; m = fmaxf(m, s);
    }
  m = fmaxf(m, __shfl_xor(m, 32));
  m = fmaxf(m, sink);
  float l = 0.f;
#pragma unroll
  for (int jb = 0; jb < 5; ++jb)
#pragma unroll
    for (int reg = 0; reg < 16; ++reg) { const float e = __expf(S[jb][reg] - m); S[jb][reg] = e; l += e; }
  l += __shfl_xor(l, 32);
  const float inv = 1.f / (l + __expf(sink - m));
  f32x16 O[2];
#pragma unroll
  for (int db = 0; db < 2; ++db)
#pragma unroll
    for (int i = 0; i < 16; ++i) O[db][i] = 0.f;
#pragma unroll
  for (int jb = 0; jb < 5; ++jb)
#pragma unroll
    for (int s = 0; s < 2; ++s) {
      uint4 pb;
      pb.x = pack2(S[jb][8 * s + 0], S[jb][8 * s + 1]); pb.y = pack2(S[jb][8 * s + 2], S[jb][8 * s + 3]);
      pb.z = pack2(S[jb][8 * s + 4], S[jb][8 * s + 5]); pb.w = pack2(S[jb][8 * s + 6], S[jb][8 * s + 7]);
      const bf16x8 bfrag = __builtin_bit_cast(bf16x8, pb);
#pragma unroll
      for (int db = 0; db < 2; ++db) {
        const u16* vp = Vts + (32 * db + r) * 264 + 32 * (w + jb) + 16 * s + 4 * h;
        const uint2 lo = *(const uint2*)vp, hi = *(const uint2*)(vp + 8);
        uint4 av; av.x = lo.x; av.y = lo.y; av.z = hi.x; av.w = hi.y;
        O[db] = MFMA(__builtin_bit_cast(bf16x8, av), bfrag, O[db]);
      }
    }
#pragma unroll
  for (int db = 0; db < 2; ++db)
#pragma unroll
    for (int g4 = 0; g4 < 4; ++g4) {
      uint2 v; v.x = pack2(O[db][4 * g4] * inv, O[db][4 * g4 + 1] * inv); v.y = pack2(O[db][4 * g4 + 2] * inv, O[db][4 * g4 + 3] * inv);
      *(uint2*)(OB + qrow * 1024 + head * 64 + 32 * db + 8 * g4 + 4 * h) = v;
    }
}

DI void attn_sample_item(const Params& p, int j, int item, u16* lds) {
  const int kvh = item & 3, b = item >> 2;
  const int t = tidx(), lane = t & 63, g = t >> 6;
  float* Kc = (float*)lds;
  float* Vc = Kc + 129 * 65;
  float* qs = Vc + 129 * 65;
  float* ps = qs + 256;
  const float* ck = p.in[I_CK] + (size_t)(j * 128 + b) * 128 * 256;
  const float* cv = p.in[I_CV] + (size_t)(j * 128 + b) * 128 * 256;
  float* ok = p.out + O_KWS + (size_t)(j * 128 + b) * 128 * 256;
  float* ov = p.out + O_VWS + (size_t)(j * 128 + b) * 128 * 256;
  __syncthreads();
  {
    const int d = t & 63, w0 = t >> 6;
#pragma unroll 1
    for (int i0 = 0; i0 < 32; i0 += 8) {
      float kb[8], vb[8];
#pragma unroll
      for (int u = 0; u < 8; ++u) { const int wq = w0 + 4 * (i0 + u); kb[u] = ck[wq * 256 + kvh * 64 + d]; vb[u] = cv[wq * 256 + kvh * 64 + d]; }
#pragma unroll
      for (int u = 0; u < 8; ++u) {
        const int wq = w0 + 4 * (i0 + u);
        Kc[wq * 65 + d] = kb[u]; Vc[wq * 65 + d] = vb[u];
        if (wq >= 1) { ok[(wq - 1) * 256 + kvh * 64 + d] = kb[u]; ov[(wq - 1) * 256 + kvh * 64 + d] = vb[u]; }
      }
    }
  }
  if (t < 64) { Kc[128 * 65 + t] = ok[127 * 256 + kvh * 64 + t]; Vc[128 * 65 + t] = ov[127 * 256 + kvh * 64 + t]; }
  qs[t] = bf2f(((const u16*)(p.ws + A_Q))[(size_t)(MP + b) * 1024 + (kvh * 4 + g) * 64 + lane]);
  __syncthreads();
  const float sink = p.in[I_SINK][j * 16 + kvh * 4 + g];
  float s0 = 0.f, s1 = 0.f, s2 = 0.f;
#pragma unroll 8
  for (int d = 0; d < 64; ++d) {
    const float q = qs[g * 64 + d];
    s0 += q * Kc[lane * 65 + d]; s1 += q * Kc[(lane + 64) * 65 + d]; s2 += q * Kc[128 * 65 + d];
  }
  float m = fmaxf(fmaxf(s0, s1), s2);
  m = fmaxf(wave_max(m), sink);
  const float e0 = __expf(s0 - m), e1 = __expf(s1 - m), e2 = __expf(s2 - m);
  float l = wave_sum(e0 + e1) + e2;
  const float inv = 1.f / (l + __expf(sink - m));
  ps[g * 132 + lane] = e0 * inv; ps[g * 132 + 64 + lane] = e1 * inv;
  if (lane == 0) ps[g * 132 + 128] = e2 * inv;
  __syncthreads();
  float o = 0.f;
#pragma unroll 4
  for (int k = 0; k < 129; ++k) o += ps[g * 132 + k] * Vc[k * 65 + lane];
  ((u16*)(p.ws + WS_ACT2))[(size_t)(MP + b) * 1024 + (kvh * 4 + g) * 64 + lane] = f2bf(o);
}

DI void phase_attn(const Params& p, int layer, u16* lds, int vb) {
  const int j = layer >> 1;
  const int vid = 2 * vb + __builtin_amdgcn_readfirstlane(tid512() >> 8);
  for (int item = vid; item < 2048 + 512; item += NVB) {
    if (item < 2048) attn_prompt_item(p, j, item, lds);
    else attn_sample_item(p, j, item - 2048, lds);
  }
}

DI void unpack8(const uint4 x, float (&o)[8]) {
  o[0] = __uint_as_float(x.x << 16); o[1] = __uint_as_float(x.x & 0xffff0000u); o[2] = __uint_as_float(x.y << 16); o[3] = __uint_as_float(x.y & 0xffff0000u);
  o[4] = __uint_as_float(x.z << 16); o[5] = __uint_as_float(x.z & 0xffff0000u); o[6] = __uint_as_float(x.w << 16); o[7] = __uint_as_float(x.w & 0xffff0000u);
}
DI void phase_conv(const Params& p, int i) {
  const u16* __restrict__ UA = (const u16*)(p.ws + F_UA); const u16* __restrict__ UG = (const u16*)(p.ws + F_UG);
  u16* __restrict__ H = (u16*)(p.ws + WS_ACT2);
  const float* cw = p.in[I_CW] + (size_t)i * 3 * DFF; const float* cb = p.in[I_CB] + (size_t)i * DFF;
  const float* sc = p.in[I_SC] + (size_t)i * 128 * 2 * DFF;
  const int gid = bidx() * 256 + tidx(), gstride = NVB * 256;
  for (int it = gid; it < 1024 * 352 + 128 * 352; it += gstride) {
    const bool smp = it >= 1024 * 352;
    const int it2 = smp ? it - 1024 * 352 : it;
    const int ch = it2 / 352, f = (it2 - ch * 352) * 8, row0 = smp ? MP + ch : ch * 16;
    float w0[8], w1[8], w2[8], bb[8];
#pragma unroll
    for (int k = 0; k < 8; ++k) { w0[k] = cw[f + k]; w1[k] = cw[DFF + f + k]; w2[k] = cw[2 * DFF + f + k]; bb[k] = cb[f + k]; }
    if (!smp) {
      float a1[8], a2[8];
      const int pos0 = row0 & 8191;
      if (pos0 >= 2) { unpack8(*(const uint4*)(UA + (size_t)(row0 - 1) * DFF + f), a1); unpack8(*(const uint4*)(UA + (size_t)(row0 - 2) * DFF + f), a2); }
      else {
#pragma unroll
        for (int k = 0; k < 8; ++k) { a1[k] = 0.f; a2[k] = 0.f; }
      }
#pragma unroll 1
      for (int rr = 0; rr < 16; rr += 4) {
        const size_t o = (size_t)(row0 + rr) * DFF + f;
        uint4 xa[4], xg[4];
#pragma unroll
        for (int u = 0; u < 4; ++u) { xa[u] = *(const uint4*)(UA + o + (size_t)u * DFF); xg[u] = *(const uint4*)(UG + o + (size_t)u * DFF); }
#pragma unroll
        for (int u = 0; u < 4; ++u) {
          float a0[8], gg[8];
          unpack8(xa[u], a0); unpack8(xg[u], gg);
          unsigned ho[4];
#pragma unroll
          for (int k = 0; k < 4; ++k) {
            const float c0 = bb[2 * k] + a2[2 * k] * w0[2 * k] + a1[2 * k] * w1[2 * k] + a0[2 * k] * w2[2 * k];
            const float c1 = bb[2 * k + 1] + a2[2 * k + 1] * w0[2 * k + 1] + a1[2 * k + 1] * w1[2 * k + 1] + a0[2 * k + 1] * w2[2 * k + 1];
            ho[k] = pack2(silu(c0) * gg[2 * k], silu(c1) * gg[2 * k + 1]);
          }
          *(uint4*)(H + o + (size_t)u * DFF) = make_uint4(ho[0], ho[1], ho[2], ho[3]);
#pragma unroll
          for (int k = 0; k < 8; ++k) { a2[k] = a1[k]; a1[k] = a0[k]; }
        }
      }
    } else {
      const int b = row0 - MP;
      const size_t o = (size_t)row0 * DFF + f;
      float a0[8], gg[8];
      unpack8(*(const uint4*)(UA + o), a0); unpack8(*(const uint4*)(UG + o), gg);
      const float4* s0p = (const float4*)(sc + (size_t)(b * 2 + 0) * DFF + f); const float4* s1p = (const float4*)(sc + (size_t)(b * 2 + 1) * DFF + f);
      float4* o0 = (float4*)(p.out + O_CSS + ((size_t)(i * 128 + b) * 2 + 0) * DFF + f);
      const float4 p0 = s0p[0], p1 = s0p[1], q0 = s1p[0], q1 = s1p[1];
      o0[0] = q0; o0[1] = q1;
      const float x2[8] = {p0.x, p0.y, p0.z, p0.w, p1.x, p1.y, p1.z, p1.w}, x1[8] = {q0.x, q0.y, q0.z, q0.w, q1.x, q1.y, q1.z, q1.w};
      unsigned ho[4];
#pragma unroll
      for (int k = 0; k < 4; ++k) {
        const float c0 = bb[2 * k] + x2[2 * k] * w0[2 * k] + x1[2 * k] * w1[2 * k] + a0[2 * k] * w2[2 * k];
        const float c1 = bb[2 * k + 1] + x2[2 * k + 1] * w0[2 * k + 1] + x1[2 * k + 1] * w1[2 * k + 1] + a0[2 * k + 1] * w2[2 * k + 1];
        ho[k] = pack2(silu(c0) * gg[2 * k], silu(c1) * gg[2 * k + 1]);
      }
      *(uint4*)(H + o) = make_uint4(ho[0], ho[1], ho[2], ho[3]);
    }
  }
}

DI void ret_u_tile(const Params& p, int tile, u16* lds) {
  const int te = tile & 1, hh = (tile >> 1) & 3, c = (tile >> 3) & 63, b = tile >> 9;
  const u16* VT = (const u16*)(p.ws + R_VT) + (size_t)(b * 2048 + hh * 512 + te * 256) * 8192 + c * 128;
  const u16* KT = (const u16*)(p.ws + R_KT) + (size_t)(b * 1024 + hh * 256) * 8192 + c * 128;
  f32x16 acc[4][2];
  gemm_core(VT, 8192, KT, 8192, 128, lds, acc);
  const int t = tid512(), lane = t & 63, w = t >> 6, wm = w >> 2, wn = w & 3, r = lane & 31, h = lane >> 5;
  u16* UT = (u16*)(p.ws + WS_US) + (size_t)((b * 64 + c) * 4 + hh) * 512 * 256;
#pragma unroll
  for (int mi = 0; mi < 4; ++mi)
#pragma unroll
    for (int ni = 0; ni < 2; ++ni)
#pragma unroll
      for (int reg = 0; reg < 16; ++reg)
        UT[(size_t)(te * 256 + wm * 128 + mi * 32 + crow(reg, h)) * 256 + wn * 64 + ni * 32 + r] = f2bf(acc[mi][ni][reg]);
}

DI float block_sum(float v, float* red) {
  v = wave_sum(v);
  __syncthreads();
  if ((tidx() & 63) == 0) red[tidx() >> 6] = v;
  __syncthreads();
  return red[0] + red[1] + red[2] + red[3];
}

DI void ret_sample_item(const Params& p, int j, int item, u16* lds) {
  const int hh = item & 3, b = item >> 2, t = tidx(), tc = t & 127, par = t >> 7;
  float* qs = (float*)lds; float* ks = qs + 256; float* red = ks + 256; float4* red4 = (float4*)(red + 8);
  const float* __restrict__ P2 = (const float*)(p.ws + WS_PART2);
  __syncthreads();
  float qr = 0.f, kr = 0.f;
  float4 vv = make_float4(0.f, 0.f, 0.f, 0.f), gq = make_float4(0.f, 0.f, 0.f, 0.f);
  {
    const float* pq = P2 + ((size_t)(hh * 16) * 128 + b) * 256 + t;
    const float* pk = P2 + ((size_t)((4 + hh) * 16) * 128 + b) * 256 + t;
    const float* pv = P2 + ((size_t)((8 + 2 * hh + (tc >> 6)) * 16) * 128 + b) * 256 + ((4 * tc) & 255);
    const float* pg = P2 + ((size_t)((16 + 2 * hh + (tc >> 6)) * 16) * 128 + b) * 256 + ((4 * tc) & 255);
    float qb[16], kb[16]; float4 vb4[16], gb4[16];
#pragma unroll
    for (int u = 0; u < 16; ++u) { qb[u] = pq[(size_t)u * 128 * 256]; kb[u] = pk[(size_t)u * 128 * 256]; }
#pragma unroll
    for (int u = 0; u < 16; ++u) { vb4[u] = *(const float4*)(pv + (size_t)u * 128 * 256); gb4[u] = *(const float4*)(pg + (size_t)u * 128 * 256); }
#pragma unroll
    for (int u = 0; u < 16; ++u) {
      qr += qb[u]; kr += kb[u];
      vv.x += vb4[u].x; vv.y += vb4[u].y; vv.z += vb4[u].z; vv.w += vb4[u].w;
      gq.x += gb4[u].x; gq.y += gb4[u].y; gq.z += gb4[u].z; gq.w += gb4[u].w;
    }
  }
  qs[t] = qr; ks[t] = kr;
  __syncthreads();
  float qv, kv;
  {
    const float* cosR = (const float*)(p.ws + WS_TRET); const float* sinR = cosR + 8193 * 128;
    const float c = cosR[8192 * 128 + (t >> 1)], sn = sinR[8192 * 128 + (t >> 1)];
    const float oq = qs[t ^ 1], ok_ = ks[t ^ 1];
    const float rq = (t & 1) ? (qr * c + oq * sn) : (qr * c - oq * sn);
    const float rk = (t & 1) ? (kr * c + ok_ * sn) : (kr * c - ok_ * sn);
    const float lg = lg2gamma(hh);
    qv = rq * exp2f(lg); kv = rk * 0.0625f * exp2f(-lg);
  }
  __syncthreads();
  qs[t] = qv; ks[t] = kv;
  const float qk = block_sum(qv * kv, red);
  const float gamma = 1.f - exp2f(-5.f - (float)hh);
  const float4* __restrict__ s0 = (const float4*)(p.in[I_SR] + ((size_t)((j * 128 + b) * 4 + hh) * 256) * 512) + tc;
  float4* __restrict__ so = (float4*)(p.out + O_RSS + ((size_t)((j * 128 + b) * 4 + hh) * 256) * 512) + tc;
  float4 o = make_float4(0.f, 0.f, 0.f, 0.f);
#pragma unroll 1
  for (int d0 = par; d0 < 256; d0 += 16) {
    float4 sv[8];
#pragma unroll
    for (int u = 0; u < 8; ++u) { const f32x4 t4 = __builtin_nontemporal_load((const f32x4*)(s0 + (size_t)(d0 + 2 * u) * 128)); sv[u] = make_float4(t4[0], t4[1], t4[2], t4[3]); }
#pragma unroll
    for (int u = 0; u < 8; ++u) {
      const float q = qs[d0 + 2 * u], k = ks[d0 + 2 * u];
      o.x += q * sv[u].x; o.y += q * sv[u].y; o.z += q * sv[u].z; o.w += q * sv[u].w;
      float4 n; n.x = gamma * (sv[u].x + k * vv.x); n.y = gamma * (sv[u].y + k * vv.y); n.z = gamma * (sv[u].z + k * vv.z); n.w = gamma * (sv[u].w + k * vv.w);
      { f32x4 n4; n4[0] = n.x; n4[1] = n.y; n4[2] = n.z; n4[3] = n.w; __builtin_nontemporal_store(n4, (f32x4*)(so + (size_t)(d0 + 2 * u) * 128)); }
    }
  }
  red4[t] = o;
  __syncthreads();
  float s1 = 0.f;
  if (par == 0) {
    const float4 o2 = red4[t + 128];
    o.x += o2.x + qk * vv.x; o.y += o2.y + qk * vv.y; o.z += o2.z + qk * vv.z; o.w += o2.w + qk * vv.w;
    s1 = o.x + o.y + o.z + o.w;
  }
  const float mu = block_sum(s1, red) * (1.f / 512.f);
  float s2 = 0.f;
  if (par == 0) { o.x -= mu; o.y -= mu; o.z -= mu; o.w -= mu; s2 = o.x * o.x + o.y * o.y + o.z * o.z + o.w * o.w; }
  const float var = block_sum(s2, red) * (1.f / 512.f);
  const float rs = rsqrtf(var + GN_EPS);
  if (par == 0) {
    u16* OB = (u16*)(p.ws + WS_ACT2) + (size_t)(MP + b) * 2048 + hh * 512 + 4 * tc;
    uint2 ov; ov.x = pack2(o.x * rs * silu(gq.x), o.y * rs * silu(gq.y)); ov.y = pack2(o.z * rs * silu(gq.z), o.w * rs * silu(gq.w));
    *(uint2*)OB = ov;
  }
}

DI void phase_ret_u(const Params& p, int layer, u16* lds) {
  const int j = layer >> 1;
  const int half = __builtin_amdgcn_readfirstlane(tid512() >> 8);
  const int G = (int)gridDim.x, gs = G >> 1, br = bid_real();
  if (br < gs) {
    for (int it = br; it < 256; it += gs) ret_sample_item(p, j, 2 * it + half, lds + half * LDS_HALF_E);
  } else {
    for (int it = br - gs; it < 1024; it += G - gs) ret_u_tile(p, it, lds);
  }
}

DI void phase_ret_scan(const Params& p, int layer) {
  const int j = layer >> 1;
  u16* UT = (u16*)(p.ws + WS_US);
  const size_t cstride = 4ull * 512 * 256;
  for (int v = bidx() * 256 + tidx(); v < 131072; v += NVB * 256) {
    const int d8 = v & 31, e = (v >> 5) & 511, hh = (v >> 14) & 3, b = v >> 16;
    u16* base = UT + ((size_t)(b * 64 * 4 + hh) * 512 + e) * 256 + d8 * 8;
    const float cd = exp2f(128.f * lg2gamma(hh));
    float s[8];
#pragma unroll
    for (int k = 0; k < 8; ++k) s[k] = 0.f;
#pragma unroll 1
    for (int c0 = 0; c0 < 64; c0 += 16) {
      uint4 ub[16];
#pragma unroll
      for (int q = 0; q < 16; ++q) ub[q] = *(const uint4*)(base + (size_t)(c0 + q) * cstride);
#pragma unroll
      for (int q = 0; q < 16; ++q) {
        uint4 o; o.x = pack2(s[0], s[1]); o.y = pack2(s[2], s[3]); o.z = pack2(s[4], s[5]); o.w = pack2(s[6], s[7]);
        *(uint4*)(base + (size_t)(c0 + q) * cstride) = o;
        const unsigned us[4] = {ub[q].x, ub[q].y, ub[q].z, ub[q].w};
#pragma unroll
        for (int k = 0; k < 4; ++k) {
          s[2 * k] = cd * (s[2 * k] + __uint_as_float(us[k] << 16));
          s[2 * k + 1] = cd * (s[2 * k + 1] + __uint_as_float(us[k] & 0xffff0000u));
        }
      }
    }
    float* o = p.out + O_RSP + ((size_t)((j * 2 + b) * 4 + hh) * 256 + d8 * 8) * 512 + e;
#pragma unroll
    for (int k = 0; k < 8; ++k) o[(size_t)k * 512] = s[k];
  }
}

DI void ret_out_item(const Params& p, int item, u16* lds) {
  const int rh = item & 1, hh = (item >> 1) & 3, c = (item >> 3) & 63, b = item >> 9;
  const int t = tidx(), lane = t & 63, w = t >> 6, r = lane & 31, h = lane >> 5;
  const size_t row0 = (size_t)b * 8192 + c * 128, trow0 = row0 + rh * 64;
  const u16* QR = (const u16*)(p.ws + R_Q); const u16* KR = (const u16*)(p.ws + R_K);
  const u16* VT = (const u16*)(p.ws + R_VT) + (size_t)(b * 2048 + hh * 512) * 8192 + c * 128;
  const u16* PT = (const u16*)(p.ws + WS_US) + (size_t)((b * 64 + c) * 4 + hh) * 512 * 256;
  u16* inner = lds;
  float* red1 = (float*)lds;
  float* red2 = red1 + 64 * 132;
  float* smu = red2 + 64 * 132;
  float* srs = smu + 64;
  __syncthreads();
  {
    f32x16 T[2];
#pragma unroll
    for (int ib = 0; ib < 2; ++ib)
#pragma unroll
      for (int i = 0; i < 16; ++i) T[ib][i] = 0.f;
    if (rh == 1 || w < 2) {
      const u16* kp = KR + (row0 + 32 * w + r) * 1024 + hh * 256 + h * 8;
      const u16* qp0 = QR + (trow0 + r) * 1024 + hh * 256 + h * 8;
      const u16* qp1 = qp0 + 32 * 1024;
#pragma unroll 4
      for (int ks = 0; ks < 16; ++ks) {
        const bf16x8 a = *(const bf16x8*)(kp + ks * 16);
        T[0] = MFMA(a, *(const bf16x8*)(qp0 + ks * 16), T[0]);
        T[1] = MFMA(a, *(const bf16x8*)(qp1 + ks * 16), T[1]);
      }
    }
#pragma unroll
    for (int ib = 0; ib < 2; ++ib)
#pragma unroll
      for (int g4 = 0; g4 < 4; ++g4) {
        const int il = 32 * ib + r, ig = rh * 64 + il, j0 = 32 * w + 8 * g4 + 4 * h;
        const float v0 = (j0 + 0 <= ig) ? T[ib][4 * g4 + 0] : 0.f, v1 = (j0 + 1 <= ig) ? T[ib][4 * g4 + 1] : 0.f;
        const float v2 = (j0 + 2 <= ig) ? T[ib][4 * g4 + 2] : 0.f, v3 = (j0 + 3 <= ig) ? T[ib][4 * g4 + 3] : 0.f;
        uint2 v; v.x = pack2(v0, v1); v.y = pack2(v2, v3);
        *(uint2*)(inner + il * 136 + j0) = v;
      }
  }
  __syncthreads();
  f32x16 acc[2][4];
#pragma unroll
  for (int rb = 0; rb < 2; ++rb)
#pragma unroll
    for (int eb = 0; eb < 4; ++eb)
#pragma unroll
      for (int i = 0; i < 16; ++i) acc[rb][eb][i] = 0.f;
#define RO_MFMA8(A0, A1, B0, B1, B2, B3) \
      acc[0][0] = MFMA(A0, B0, acc[0][0]); acc[1][0] = MFMA(A1, B0, acc[1][0]); acc[0][1] = MFMA(A0, B1, acc[0][1]); acc[1][1] = MFMA(A1, B1, acc[1][1]); \
      acc[0][2] = MFMA(A0, B2, acc[0][2]); acc[1][2] = MFMA(A1, B2, acc[1][2]); acc[0][3] = MFMA(A0, B3, acc[0][3]); acc[1][3] = MFMA(A1, B3, acc[1][3]);
  {
    const u16* ap = inner + r * 136 + h * 8;
    const u16* bp = VT + (size_t)(128 * w + r) * 8192 + h * 8;
    const int ngr = rh ? 2 : 1;
#pragma unroll 1
    for (int g = 0; g < ngr; ++g) {
      bf16x8 bb[4][4];
#pragma unroll
      for (int q = 0; q < 4; ++q)
#pragma unroll
        for (int eb = 0; eb < 4; ++eb) bb[q][eb] = *(const bf16x8*)(bp + (size_t)(32 * eb) * 8192 + (4 * g + q) * 16);
      __builtin_amdgcn_sched_barrier(0);
#pragma unroll
      for (int q = 0; q < 4; ++q) {
        const bf16x8 a0 = *(const bf16x8*)(ap + (4 * g + q) * 16), a1 = *(const bf16x8*)(ap + 32 * 136 + (4 * g + q) * 16);
        RO_MFMA8(a0, a1, bb[q][0], bb[q][1], bb[q][2], bb[q][3])
      }
    }
  }
  {
    const u16* ap = QR + (trow0 + r) * 1024 + hh * 256 + h * 8;
    const u16* bp = PT + (size_t)(128 * w + r) * 256 + h * 8;
#pragma unroll 1
    for (int g = 0; g < 4; ++g) {
      bf16x8 bb[4][4], aa[2][2];
#pragma unroll
      for (int q = 0; q < 4; ++q)
#pragma unroll
        for (int eb = 0; eb < 4; ++eb) bb[q][eb] = *(const bf16x8*)(bp + (size_t)(32 * eb) * 256 + (4 * g + q) * 16);
#pragma unroll
      for (int q = 0; q < 2; ++q) { aa[q][0] = *(const bf16x8*)(ap + (4 * g + q) * 16); aa[q][1] = *(const bf16x8*)(ap + 32 * 1024 + (4 * g + q) * 16); }
      __builtin_amdgcn_sched_barrier(0);
#pragma unroll
      for (int q = 0; q < 2; ++q) { RO_MFMA8(aa[q][0], aa[q][1], bb[q][0], bb[q][1], bb[q][2], bb[q][3]) }
#pragma unroll
      for (int q = 0; q < 2; ++q) { aa[q][0] = *(const bf16x8*)(ap + (4 * g + 2 + q) * 16); aa[q][1] = *(const bf16x8*)(ap + 32 * 1024 + (4 * g + 2 + q) * 16); }
#pragma unroll
      for (int q = 0; q < 2; ++q) { RO_MFMA8(aa[q][0], aa[q][1], bb[2 + q][0], bb[2 + q][1], bb[2 + q][2], bb[2 + q][3]) }
    }
  }
#undef RO_MFMA8
  __syncthreads();
#pragma unroll
  for (int rb = 0; rb < 2; ++rb)
#pragma unroll
    for (int reg = 0; reg < 16; ++reg) {
      float s1 = 0.f, s2 = 0.f;
#pragma unroll
      for (int eb = 0; eb < 4; ++eb) { const float v = acc[rb][eb][reg]; s1 += v; s2 += v * v; }
      const int row = 32 * rb + crow(reg, h);
      red1[row * 132 + w * 32 + r] = s1; red2[row * 132 + w * 32 + r] = s2;
    }
  __syncthreads();
  {
    const int row = t >> 2, q = t & 3;
    float s1 = 0.f, s2 = 0.f;
#pragma unroll
    for (int k = 0; k < 32; ++k) { s1 += red1[row * 132 + q * 32 + k]; s2 += red2[row * 132 + q * 32 + k]; }
    s1 += __shfl_xor(s1, 1); s2 += __shfl_xor(s2, 1);
    s1 += __shfl_xor(s1, 2); s2 += __shfl_xor(s2, 2);
    const float mu = s1 * (1.f / 512.f);
    const float var = fmaxf(s2 * (1.f / 512.f) - mu * mu, 0.f);
    if (q == 0) { smu[row] = mu; srs[row] = rsqrtf(var + GN_EPS); }
  }
  __syncthreads();
  const u16* __restrict__ GS = (const u16*)(p.ws + R_GS); u16* __restrict__ OB = (u16*)(p.ws + WS_ACT2);
#pragma unroll
  for (int rb = 0; rb < 2; ++rb)
#pragma unroll
    for (int rq = 0; rq < 4; ++rq) {
      u16 gg[4][4];
#pragma unroll
      for (int q = 0; q < 4; ++q)
#pragma unroll
        for (int eb = 0; eb < 4; ++eb) gg[q][eb] = GS[(trow0 + 32 * rb + crow(4 * rq + q, h)) * 2048 + hh * 512 + 128 * w + r + 32 * eb];
#pragma unroll
      for (int q = 0; q < 4; ++q) {
        const int reg = 4 * rq + q, row = 32 * rb + crow(reg, h);
        const float mu = smu[row], rs = srs[row];
        const size_t o = (trow0 + row) * 2048 + hh * 512 + 128 * w + r;
#pragma unroll
        for (int eb = 0; eb < 4; ++eb) OB[o + 32 * eb] = f2bf((acc[rb][eb][reg] - mu) * rs * bf2f(gg[q][eb]));
      }
    }
}

enum { PH_PREP = 0, PH_QKV, PH_ATTN, PH_AO, PH_RIN, PH_RETU, PH_SCAN, PH_RETO, PH_RO, PH_LNM, PH_FIN, PH_CONV, PH_FOUT, PH_LNF };

DI void run_phase(const Params& p, int ph, int layer, u16* lds, int vb, bool noepi = false, bool fuse_ln = false) {
  u16* hl = lds + __builtin_amdgcn_readfirstlane(tid512() >> 8) * LDS_HALF_E;
  switch (ph) {
    case PH_PREP: phase_prep(p, hl); break;
    case PH_QKV: gemm_phase<G_QKV>(p, layer, lds, vb); break;
    case PH_ATTN: phase_attn(p, layer, hl, vb); break;
    case PH_AO: gemm_phase<G_AO>(p, layer, lds, vb, false, fuse_ln); break;
    case PH_RIN: gemm_phase<G_RIN>(p, layer, lds, vb); break;
    case PH_RETU: phase_ret_u(p, layer, lds); break;
    case PH_SCAN: phase_ret_scan(p, layer); break;
    case PH_RETO: for (int item = bidx(); item < 1024; item += NVB) ret_out_item(p, item, hl); break;
    case PH_RO: gemm_phase<G_RO>(p, layer, lds, vb, false, fuse_ln); break;
    case PH_LNM: phase_ln(p, p.in[I_LMG] + layer * 1024, p.in[I_LMB] + layer * 1024, false, (layer & 1) ? 32 : 16); break;
    case PH_FIN: gemm_phase<G_FIN>(p, layer, lds, vb, noepi); break;
    case PH_CONV: phase_conv(p, layer); break;
    case PH_FOUT: gemm_phase<G_FOUT>(p, layer, lds, vb, false, fuse_ln); break;
    case PH_LNF: phase_ln(p, p.in[I_LFG] + layer * 1024, p.in[I_LFB] + layer * 1024, layer == 3, 44); break;
  }
}

#if !MEGA
__global__ void __launch_bounds__(512, 2) k_phase(Params p, int ph, int layer) {
  __shared__ __attribute__((aligned(16))) u16 lds[LDS_BYTES / 2];
  run_phase(p, ph, layer, lds, (int)blockIdx.x);
}

#else
#ifndef PROBE_MASK
#define PROBE_MASK 0
#endif
#ifndef PROBE_NOEPI
#define PROBE_NOEPI 0
#endif
__global__ void __launch_bounds__(512, 2) k_mega(Params p) {
  __shared__ __attribute__((aligned(16))) u16 lds[LDS_BYTES / 2];
  __shared__ uint4 xb_words;
  cg::grid_group grid = cg::this_grid();
  if (__builtin_amdgcn_workitem_id_x() == 0) xb_words = make_uint4(0u, 0u, 0u, (unsigned)__builtin_amdgcn_workgroup_id_x());
  __syncthreads();
  XcdBarrier xb = xcd_barrier_post((unsigned*)(p.ws + WS_BAR), (volatile LAS unsigned*)&xb_words);
  {
    Params q = p;
    asm volatile("" : "+s"(q.out)); asm volatile("" : "+s"(q.ws));
    const int rep0 = ((PROBE_MASK >> PH_PREP) & 1) ? 2 : 1;
    for (int rr = 0; rr < rep0; ++rr) run_phase(q, PH_PREP, 0, lds, 0);
    if (p.ws == nullptr) grid.sync();
    xcd_barrier(xb);
    if (__builtin_amdgcn_workitem_id_x() == 0) {
      unsigned* bar = (unsigned*)(p.ws + WS_BAR);
      const unsigned G = gridDim.x;
      unsigned cnt = 0u, mine = 0u, dense = 0u; bool uni = true;
#pragma unroll
      for (unsigned j = 0; j < 16; ++j) {
        const unsigned c = xb_ld(&bar[XB_XCNT(j)]);
        cnt += (c > 0u) ? 1u : 0u; mine = (j == xb.x) ? c : mine; dense += (j < xb.x && c > 0u) ? 1u : 0u;
        uni = uni && (c == 0u || c * 8u == G);
      }
      const unsigned rank = xb_words.z;
      xb_words.x = mine > 0u ? mine : 1u; xb_words.y = cnt > 0u ? cnt : 1u;
      xb_words.w = (uni && cnt == 8u && rank < (G >> 3)) ? dense * (G >> 3) + rank : (unsigned)__builtin_amdgcn_workgroup_id_x();
    }
    __syncthreads();
  }
#pragma unroll 1
  for (int step = 1; step < 29; ++step) {
    int ph, layer, idx;
    {
      const int s = step - 1;
      if (s < 6) { layer = 0; idx = s; } else if (s < 14) { layer = 1; idx = s - 6; } else if (s < 20) { layer = 2; idx = s - 14; } else { layer = 3; idx = s - 20; }
      if (layer & 1) ph = (idx < 5) ? (PH_RIN + idx) : (PH_FIN + idx - 5);
      else ph = (idx < 3) ? (PH_QKV + idx) : (PH_FIN + idx - 3);
    }
    Params q = p;
#pragma unroll
    for (int i = 0; i < 19; ++i) asm volatile("" : "+s"(q.in[i]));
    asm volatile("" : "+s"(q.out)); asm volatile("" : "+s"(q.ws));
    const int rep = ((PROBE_MASK >> ph) & 1) ? 2 : 1;
    const int vb = (int)xb_words.w;
    for (int rr = 0; rr < rep; ++rr) run_phase(q, ph, layer, lds, vb, PROBE_NOEPI && rr > 0, true);
    if (step < 28) xcd_barrier(xb);
  }
}
#endif

extern "C" void kernel_launch(void* const* d_in, const int* in_sizes, int n_in, void* d_out, int out_size, void* d_ws, size_t ws_size, hipStream_t stream) {
  static int grid_blocks = 0;
  if (!grid_blocks) {
    int dev = 0, cus = 0, per_cu = 0;
    (void)hipGetDevice(&dev);
    (void)hipDeviceGetAttribute(&cus, hipDeviceAttributeMultiprocessorCount, dev);
#if MEGA
    (void)hipOccupancyMaxActiveBlocksPerMultiprocessor(&per_cu, k_mega, 512, 0);
#else
    (void)hipOccupancyMaxActiveBlocksPerMultiprocessor(&per_cu, k_phase, 512, 0);
#endif
    if (per_cu < 1) per_cu = 1;
    if (per_cu > 1) per_cu = 1;
    grid_blocks = cus * per_cu;
    if (n_in != 19 || ws_size < WS_END) fprintf(stderr, "kernel_launch: unexpected n_in %d or ws %zu < %zu\n", n_in, ws_size, (size_t)WS_END);
  }
  Params p{};
  for (int i = 0; i < 19; ++i) p.in[i] = (const float*)d_in[i];
  p.out = (float*)d_out; p.ws = (unsigned char*)d_ws;
#if MEGA
  (void)hipMemsetAsync((unsigned char*)d_ws + WS_BAR, 0, 16384, stream);
  void* args[] = {&p};
  hipError_t e = hipLaunchCooperativeKernel((void*)k_mega, dim3(grid_blocks), dim3(512), args, 0, stream);
  if (e != hipSuccess) fprintf(stderr, "cooperative launch failed: %s (grid %d)\n", hipGetErrorString(e), grid_blocks);
#else
  auto L = [&](int ph, int layer) { hipLaunchKernelGGL(k_phase, dim3(grid_blocks), dim3(512), 0, stream, p, ph, layer); };
  L(PH_PREP, 0);
  for (int layer = 0; layer < 4; ++layer) {
    if ((layer & 1) == 0) { L(PH_QKV, layer); L(PH_ATTN, layer); L(PH_AO, layer); }
    else { L(PH_RIN, layer); L(PH_RETU, layer); L(PH_SCAN, layer); L(PH_RETO, layer); L(PH_RO, layer); }
    L(PH_LNM, layer); L(PH_FIN, layer); L(PH_CONV, layer); L(PH_FOUT, layer); L(PH_LNF, layer);
  }
#endif
}
```

```cpp
#include <hip/hip_runtime.h>
#include <hip/hip_cooperative_groups.h>
#include <cstdio>
namespace cg = cooperative_groups;

#ifndef MEGA
#define MEGA 1
#endif

typedef unsigned short u16;
using f32x4 = __attribute__((ext_vector_type(4))) float;
using bf16x8 = __attribute__((ext_vector_type(8))) short;
using f32x16 = __attribute__((ext_vector_type(16))) float;
#define DI __device__ __forceinline__
#define MFMA(a, b, c) __builtin_amdgcn_mfma_f32_32x32x16_bf16((a), (b), (c), 0, 0, 0)

constexpr int D = 1024, SEQ = 8192, MP = 16384, MS = 128, MT = MP + MS;
constexpr int DFF = 2816;
constexpr float ALPHA = 1.6817928305074290f;
constexpr float LN_EPS = 1e-5f, GN_EPS = 1e-5f;

constexpr size_t O_YP = 0;
constexpr size_t O_YS = O_YP + (size_t)MP * D;
constexpr size_t O_KWP = O_YS + (size_t)MS * D;
constexpr size_t O_VWP = O_KWP + 2ull * 2 * 128 * 256;
constexpr size_t O_RSP = O_VWP + 2ull * 2 * 128 * 256;
constexpr size_t O_CSP = O_RSP + 2ull * 2 * 4 * 256 * 512;
constexpr size_t O_KWS = O_CSP + 4ull * 2 * 2 * DFF;
constexpr size_t O_VWS = O_KWS + 2ull * 128 * 128 * 256;
constexpr size_t O_RSS = O_VWS + 2ull * 128 * 128 * 256;
constexpr size_t O_CSS = O_RSS + 2ull * 128 * 4 * 256 * 512;

constexpr size_t al(size_t x) { return (x + 255) & ~size_t(255); }
constexpr size_t WS_WQKV = 0;
constexpr size_t WS_WAO = WS_WQKV + 2ull * 1536 * 1024 * 2;
constexpr size_t WS_WRIN = WS_WAO + 2ull * 1024 * 1024 * 2;
constexpr size_t WS_WRO = WS_WRIN + 2ull * 6144 * 1024 * 2;
constexpr size_t WS_WFIN = WS_WRO + 2ull * 1024 * 2048 * 2;
constexpr size_t WS_WFOUT = WS_WFIN + 4ull * 5632 * 1024 * 2;
constexpr size_t WS_TROPE = WS_WFOUT + 4ull * 1024 * 2816 * 2;
constexpr size_t WS_TRET = WS_TROPE + al(2ull * 8193 * 32 * 4);
constexpr size_t WS_X = WS_TRET + al(2ull * 8193 * 128 * 4);
constexpr size_t WS_XB = WS_X + (size_t)MT * 1024 * 4;
constexpr size_t WS_Y = WS_XB + (size_t)MT * 1024 * 2;
constexpr size_t WS_ACT = WS_Y + (size_t)MT * 1024 * 4;
constexpr size_t WS_ACT2 = WS_ACT + 268435456ull;
constexpr size_t WS_US = WS_ACT2 + (size_t)MT * 2816 * 2;
constexpr size_t WS_SMP = WS_US + 134217728ull;
constexpr size_t WS_BAR = WS_SMP + 128ull * 4096 * 4;
constexpr size_t WS_PART = WS_BAR + 16384;
constexpr size_t WS_PART2 = WS_PART + 4ull * 44 * 128 * 256 * 4;
constexpr size_t WS_END = WS_PART2 + 24ull * 16 * 128 * 256 * 4;
constexpr size_t A_Q = WS_ACT;
constexpr size_t A_K = A_Q + (size_t)MT * 1024 * 2;
constexpr size_t A_VT = A_K + (size_t)MP * 256 * 2;
constexpr size_t R_Q = WS_ACT;
constexpr size_t R_K = R_Q + (size_t)MT * 1024 * 2;
constexpr size_t R_KT = R_K + (size_t)MT * 1024 * 2;
constexpr size_t R_VT = R_KT + 2ull * 1024 * 8192 * 2;
constexpr size_t R_GS = R_VT + 2ull * 2048 * 8192 * 2;
static_assert(R_GS + (size_t)MT * 2048 * 2 <= WS_ACT2, "act region");
constexpr size_t F_UA = WS_ACT;
constexpr size_t F_UG = F_UA + (size_t)MT * 2816 * 2;

struct Params {
  const float* in[19];
  float* out;
  unsigned char* ws;
};
enum { I_XP = 0, I_XS, I_CK, I_CV, I_SR, I_SC, I_WQKV, I_SINK, I_WAO, I_WRIN, I_WRO, I_WFIN, I_CW, I_CB, I_WFOUT, I_LMG, I_LMB, I_LFG, I_LFB };

DI int tid512() { int t = __builtin_amdgcn_workitem_id_x(); asm volatile("" : "+v"(t)); return t; }
DI int bid_real() { int b = __builtin_amdgcn_workgroup_id_x(); asm volatile("" : "+s"(b)); return b; }
DI int tidx() { return tid512() & 255; }
DI int bidx() { return 2 * bid_real() + __builtin_amdgcn_readfirstlane(tid512() >> 8); }
#define NVB (2 * (int)gridDim.x)
DI u16 f2bf(float x) { return __builtin_bit_cast(u16, (__bf16)x); }
DI float bf2f(u16 v) { return __uint_as_float(((unsigned)v) << 16); }
DI unsigned pack2(float a, float b) { return (unsigned)f2bf(a) | ((unsigned)f2bf(b) << 16); }
DI int crow(int reg, int h) { return (reg & 3) + 8 * (reg >> 2) + 4 * h; }
DI float silu(float x) { return x / (1.f + __expf(-x)); }
DI float lg2gamma(int hh) { return hh == 0 ? -0.04580368961312479f : hh == 1 ? -0.02272007650008353f : hh == 2 ? -0.011315313227834146f : -0.005646563141142063f; }

DI float wave_max(float v) {
#pragma unroll
  for (int o = 32; o >= 1; o >>= 1) v = fmaxf(v, __shfl_xor(v, o));
  return v;
}
DI float wave_sum(float v) {
#pragma unroll
  for (int o = 32; o >= 1; o >>= 1) v += __shfl_xor(v, o);
  return v;
}

DI void sincos_d(double x, float& s, float& c) {
  const double n = rint(x * 0.63661977236758134308);
  double r = fma(-n, 1.57079632673412561417e+00, x);
  r = fma(-n, 6.07710050650619224932e-11, r);
  const double r2 = r * r;
  double sp = 1.0 / 6227020800.0;
  sp = fma(sp, r2, -1.0 / 39916800.0); sp = fma(sp, r2, 1.0 / 362880.0); sp = fma(sp, r2, -1.0 / 5040.0);
  sp = fma(sp, r2, 1.0 / 120.0); sp = fma(sp, r2, -1.0 / 6.0); sp = fma(sp, r2, 1.0);
  const double sn = sp * r;
  double cp = -1.0 / 87178291200.0;
  cp = fma(cp, r2, 1.0 / 479001600.0); cp = fma(cp, r2, -1.0 / 3628800.0); cp = fma(cp, r2, 1.0 / 40320.0);
  cp = fma(cp, r2, -1.0 / 720.0); cp = fma(cp, r2, 1.0 / 24.0); cp = fma(cp, r2, -0.5); cp = fma(cp, r2, 1.0);
  const int q = ((int)n) & 3;
  const double ss = (q & 1) ? cp : sn, cc = (q & 1) ? sn : cp;
  s = (float)((q == 2 || q == 3) ? -ss : ss);
  c = (float)((q == 1 || q == 2) ? -cc : cc);
}

constexpr int LSTR = 72;
constexpr int TILE_E = 256 * LSTR;
constexpr int LDS_BYTES = 4 * TILE_E * 2;
constexpr int LDS_HALF_E = LDS_BYTES / 4;

DI void gemm_core(const u16* __restrict__ A, size_t lda, const u16* __restrict__ Bt, size_t ldb, int K, u16* lds, f32x16 (&acc)[4][2]) {
  const int t = tid512(), lane = t & 63, w = t >> 6, wm = w >> 2, wn = w & 3, r = lane & 31, h = lane >> 5;
  u16* As = lds; u16* Bs = lds + 2 * TILE_E;
  const int lrow = t >> 3, lk = (t & 7) * 8;
  const u16* Ag = A + (size_t)lrow * lda + lk;
  const u16* Bg = Bt + (size_t)lrow * ldb + lk;
#define GLOAD(P, ko) \
  P##a0 = *(const uint4*)(Ag + (ko)); P##a1 = *(const uint4*)(Ag + (size_t)64 * lda + (ko)); P##a2 = *(const uint4*)(Ag + (size_t)128 * lda + (ko)); P##a3 = *(const uint4*)(Ag + (size_t)192 * lda + (ko)); \
  P##b0 = *(const uint4*)(Bg + (ko)); P##b1 = *(const uint4*)(Bg + (size_t)64 * ldb + (ko)); P##b2 = *(const uint4*)(Bg + (size_t)128 * ldb + (ko)); P##b3 = *(const uint4*)(Bg + (size_t)192 * ldb + (ko));
#define LSTORE(P, buf) { u16* ad_ = As + (buf) * TILE_E + lrow * LSTR + lk; u16* bd_ = Bs + (buf) * TILE_E + lrow * LSTR + lk; \
  *(uint4*)(ad_) = P##a0; *(uint4*)(ad_ + 64 * LSTR) = P##a1; *(uint4*)(ad_ + 128 * LSTR) = P##a2; *(uint4*)(ad_ + 192 * LSTR) = P##a3; \
  *(uint4*)(bd_) = P##b0; *(uint4*)(bd_ + 64 * LSTR) = P##b1; *(uint4*)(bd_ + 128 * LSTR) = P##b2; *(uint4*)(bd_ + 192 * LSTR) = P##b3; }
#define COMPUTE(buf) { \
    const u16* as = As + (buf) * TILE_E + (wm * 128 + r) * LSTR + h * 8; \
    const u16* bs = Bs + (buf) * TILE_E + (wn * 64 + r) * LSTR + h * 8; \
    _Pragma("unroll") for (int kk = 0; kk < 4; ++kk) { \
      const bf16x8 b0 = *(const bf16x8*)(bs + kk * 16), b1 = *(const bf16x8*)(bs + 32 * LSTR + kk * 16); \
      _Pragma("unroll") for (int mi = 0; mi < 4; ++mi) { \
        const bf16x8 a = *(const bf16x8*)(as + mi * 32 * LSTR + kk * 16); \
        acc[mi][0] = MFMA(a, b0, acc[mi][0]); acc[mi][1] = MFMA(a, b1, acc[mi][1]); } } }
  uint4 pa0, pa1, pa2, pa3, pb0, pb1, pb2, pb3;
  const int nk = K >> 6;
  {
    uint4 qa0, qa1, qa2, qa3, qb0, qb1, qb2, qb3;
    GLOAD(q, 0)
    if (nk > 1) { GLOAD(p, 64) }
    __syncthreads();
    LSTORE(q, 0)
  }
#pragma unroll
  for (int a = 0; a < 4; ++a)
#pragma unroll
    for (int b = 0; b < 2; ++b)
#pragma unroll
      for (int i = 0; i < 16; ++i) acc[a][b][i] = 0.f;
  __syncthreads();
#pragma unroll 1
  for (int kt = 0; kt < nk; ++kt) {
    const int buf = kt & 1;
    if (kt + 1 < nk) LSTORE(p, buf ^ 1)
    if (kt + 2 < nk) { const int ko = (kt + 2) << 6; GLOAD(p, ko) }
    __builtin_amdgcn_sched_barrier(0);
    COMPUTE(buf)
    __syncthreads();
  }
#undef COMPUTE
#undef GLOAD
#undef LSTORE
}

DI void epi_qkv(const Params& p, int j, f32x16 (&acc)[2][2], int mb, int nb, int lane) {
  const int r = lane & 31, h = lane >> 5, slot = nb >> 6;
  const float* cosT = (const float*)(p.ws + WS_TROPE); const float* sinT = cosT + 8193 * 32;
  const bool smp = mb >= MP;
  if (slot < 20) {
    u16* Q = (u16*)(p.ws + A_Q); u16* KB = (u16*)(p.ws + A_K);
#pragma unroll
    for (int mi = 0; mi < 2; ++mi) {
      float cc[16], ss[16];
#pragma unroll
      for (int reg = 0; reg < 16; ++reg) {
        const int row = mb + mi * 32 + crow(reg, h);
        const int pos = smp ? 8192 : (row & 8191);
        cc[reg] = cosT[pos * 32 + r]; ss[reg] = sinT[pos * 32 + r];
      }
#pragma unroll
      for (int reg = 0; reg < 16; ++reg) {
        const int row = mb + mi * 32 + crow(reg, h);
        const int pos = smp ? 8192 : (row & 8191);
        const float c = cc[reg], s = ss[reg];
        const float x1 = acc[mi][0][reg], x2 = acc[mi][1][reg];
        const float o1 = x1 * c - x2 * s, o2 = x2 * c + x1 * s;
        if (slot < 16) {
          Q[(size_t)row * 1024 + nb + r] = f2bf(o1 * 0.125f); Q[(size_t)row * 1024 + nb + 32 + r] = f2bf(o2 * 0.125f);
        } else {
          const int kvh = slot - 16;
          if (!smp) {
            KB[(size_t)row * 256 + kvh * 64 + r] = f2bf(o1); KB[(size_t)row * 256 + kvh * 64 + 32 + r] = f2bf(o2);
            if (pos >= 8064) { const int b = row >> 13; float* o = p.out + O_KWP + ((size_t)((j * 2 + b) * 128 + (pos - 8064)) * 4 + kvh) * 64; o[r] = o1; o[32 + r] = o2; }
          } else {
            const int b = row - MP; float* o = p.out + O_KWS + ((size_t)((j * 128 + b) * 128 + 127) * 4 + kvh) * 64; o[r] = o1; o[32 + r] = o2;
          }
        }
      }
    }
  } else {
    const int kvh = slot - 20;
    if (!smp) {
      u16* VT = (u16*)(p.ws + A_VT);
      const int b = mb >> 13;
#pragma unroll
      for (int mi = 0; mi < 2; ++mi)
#pragma unroll
        for (int ni = 0; ni < 2; ++ni)
#pragma unroll
          for (int g4 = 0; g4 < 4; ++g4) {
            const int t0 = (mb & 8191) + mi * 32 + 8 * g4 + 4 * h, d = ni * 32 + r;
            uint2 v; v.x = pack2(acc[mi][ni][4 * g4], acc[mi][ni][4 * g4 + 1]); v.y = pack2(acc[mi][ni][4 * g4 + 2], acc[mi][ni][4 * g4 + 3]);
            *(uint2*)(VT + (size_t)(b * 256 + kvh * 64 + d) * 8192 + t0) = v;
            if (t0 >= 8064) {
#pragma unroll
              for (int q = 0; q < 4; ++q) p.out[O_VWP + ((size_t)((j * 2 + b) * 128 + (t0 + q - 8064)) * 4 + kvh) * 64 + d] = acc[mi][ni][4 * g4 + q];
            }
          }
    } else {
#pragma unroll
      for (int mi = 0; mi < 2; ++mi)
#pragma unroll
        for (int ni = 0; ni < 2; ++ni)
#pragma unroll
          for (int reg = 0; reg < 16; ++reg) {
            const int b = mb - MP + mi * 32 + crow(reg, h);
            p.out[O_VWS + ((size_t)((j * 128 + b) * 128 + 127) * 4 + kvh) * 64 + ni * 32 + r] = acc[mi][ni][reg];
          }
    }
  }
}

DI void epi_res(const Params& p, f32x16 (&acc)[2][2], int mb, int nb, int lane) {
  const int r = lane & 31, h = lane >> 5;
  const float* __restrict__ X = (const float*)(p.ws + WS_X); float* __restrict__ Y = (float*)(p.ws + WS_Y);
#pragma unroll
  for (int mi = 0; mi < 2; ++mi) {
    float xv[2][16];
#pragma unroll
    for (int ni = 0; ni < 2; ++ni)
#pragma unroll
      for (int reg = 0; reg < 16; ++reg) xv[ni][reg] = X[(size_t)(mb + mi * 32 + crow(reg, h)) * 1024 + nb + ni * 32 + r];
#pragma unroll
    for (int ni = 0; ni < 2; ++ni)
#pragma unroll
      for (int reg = 0; reg < 16; ++reg) Y[(size_t)(mb + mi * 32 + crow(reg, h)) * 1024 + nb + ni * 32 + r] = ALPHA * xv[ni][reg] + acc[mi][ni][reg];
  }
}

DI void epi_rin(const Params& p, int j, f32x16 (&acc)[2][2], int mb, int nb, int lane) {
  const int r = lane & 31, h = lane >> 5, slot = nb >> 6;
  const bool smp = mb >= MP;
  const int b = mb >> 13;
  if (slot < 32) {
    const bool isq = slot < 16;
    const int hh = (slot & 15) >> 2, cbase = nb & 255, ncol = nb & 1023;
    const float lg = lg2gamma(hh);
    const float* cosR = (const float*)(p.ws + WS_TRET); const float* sinR = cosR + 8193 * 128;
#pragma unroll
    for (int mi = 0; mi < 2; ++mi)
#pragma unroll
      for (int ni = 0; ni < 2; ++ni) {
        const int pidx = (cbase + ni * 32 + r) >> 1;
        float cc[16], ss[16];
#pragma unroll
        for (int reg = 0; reg < 16; ++reg) {
          const int row = mb + mi * 32 + crow(reg, h);
          const int pos = smp ? 8192 : (row & 8191);
          cc[reg] = cosR[pos * 128 + pidx]; ss[reg] = sinR[pos * 128 + pidx];
        }
#pragma unroll
        for (int reg = 0; reg < 16; ++reg) {
          const int row = mb + mi * 32 + crow(reg, h);
          const int pos = smp ? 8192 : (row & 8191);
          const float mine = acc[mi][ni][reg], other = __shfl_xor(mine, 1);
          const float rot = (r & 1) ? (mine * cc[reg] + other * ss[reg]) : (mine * cc[reg] - other * ss[reg]);
          const float e = (float)((smp ? 0 : (pos & 127)) + 1) * lg;
          acc[mi][ni][reg] = isq ? rot * exp2f(e) : rot * 0.0625f * exp2f(-e);
        }
        __builtin_amdgcn_sched_barrier(0);
      }
    if (smp) {
      float* S = (float*)(p.ws + WS_SMP) + (isq ? 0 : 128 * 1024);
#pragma unroll
      for (int mi = 0; mi < 2; ++mi)
#pragma unroll
        for (int ni = 0; ni < 2; ++ni)
#pragma unroll
          for (int reg = 0; reg < 16; ++reg)
            S[(size_t)(mb - MP + mi * 32 + crow(reg, h)) * 1024 + ncol + ni * 32 + r] = acc[mi][ni][reg];
    } else {
      u16* N = (u16*)(p.ws + (isq ? R_Q : R_K));
#pragma unroll
      for (int mi = 0; mi < 2; ++mi)
#pragma unroll
        for (int ni = 0; ni < 2; ++ni)
#pragma unroll
          for (int reg = 0; reg < 16; ++reg)
            N[(size_t)(mb + mi * 32 + crow(reg, h)) * 1024 + ncol + ni * 32 + r] = f2bf(acc[mi][ni][reg]);
      if (!isq) {
        u16* KT = (u16*)(p.ws + R_KT);
#pragma unroll
        for (int mi = 0; mi < 2; ++mi)
#pragma unroll
          for (int ni = 0; ni < 2; ++ni)
#pragma unroll
            for (int g4 = 0; g4 < 4; ++g4) {
              const int t0 = (mb & 8191) + mi * 32 + 8 * g4 + 4 * h;
              uint2 v; v.x = pack2(acc[mi][ni][4 * g4], acc[mi][ni][4 * g4 + 1]); v.y = pack2(acc[mi][ni][4 * g4 + 2], acc[mi][ni][4 * g4 + 3]);
              *(uint2*)(KT + (size_t)(b * 1024 + ncol + ni * 32 + r) * 8192 + t0) = v;
            }
      }
    }
  } else if (slot < 64) {
    const int cv = nb - 2048;
    if (smp) {
      float* SV = (float*)(p.ws + WS_SMP) + 2 * 128 * 1024;
#pragma unroll
      for (int mi = 0; mi < 2; ++mi)
#pragma unroll
        for (int ni = 0; ni < 2; ++ni)
#pragma unroll
          for (int reg = 0; reg < 16; ++reg)
            SV[(size_t)(mb - MP + mi * 32 + crow(reg, h)) * 2048 + cv + ni * 32 + r] = acc[mi][ni][reg];
    } else {
      u16* VT = (u16*)(p.ws + R_VT);
#pragma unroll
      for (int mi = 0; mi < 2; ++mi)
#pragma unroll
        for (int ni = 0; ni < 2; ++ni)
#pragma unroll
          for (int g4 = 0; g4 < 4; ++g4) {
            const int t0 = (mb & 8191) + mi * 32 + 8 * g4 + 4 * h;
            uint2 v; v.x = pack2(acc[mi][ni][4 * g4], acc[mi][ni][4 * g4 + 1]); v.y = pack2(acc[mi][ni][4 * g4 + 2], acc[mi][ni][4 * g4 + 3]);
            *(uint2*)(VT + (size_t)(b * 2048 + cv + ni * 32 + r) * 8192 + t0) = v;
          }
    }
  } else {
    u16* GS = (u16*)(p.ws + R_GS);
    const int cg_ = nb - 4096;
#pragma unroll
    for (int mi = 0; mi < 2; ++mi)
#pragma unroll
      for (int ni = 0; ni < 2; ++ni)
#pragma unroll
        for (int reg = 0; reg < 16; ++reg)
          GS[(size_t)(mb + mi * 32 + crow(reg, h)) * 2048 + cg_ + ni * 32 + r] = f2bf(silu(acc[mi][ni][reg]));
  }
}

DI void epi_fin(const Params& p, int i, f32x16 (&acc)[2][2], int mb, int nb, int lane) {
  const int r = lane & 31, h = lane >> 5;
  const bool smp = mb >= MP;
  if (nb < DFF) {
    u16* UA = (u16*)(p.ws + F_UA);
#pragma unroll
    for (int mi = 0; mi < 2; ++mi)
#pragma unroll
      for (int ni = 0; ni < 2; ++ni)
#pragma unroll
        for (int reg = 0; reg < 16; ++reg) {
          const int row = mb + mi * 32 + crow(reg, h), col = nb + ni * 32 + r;
          const float v = acc[mi][ni][reg];
          UA[(size_t)row * DFF + col] = f2bf(v);
          if (smp) {
            p.out[O_CSS + ((size_t)(i * 128 + (row - MP)) * 2 + 1) * DFF + col] = v;
          } else {
            const int pos = row & 8191;
            if (pos >= 8190) p.out[O_CSP + ((size_t)(i * 2 + (row >> 13)) * 2 + (pos - 8190)) * DFF + col] = v;
          }
        }
  } else {
    u16* UG = (u16*)(p.ws + F_UG);
#pragma unroll
    for (int mi = 0; mi < 2; ++mi)
#pragma unroll
      for (int ni = 0; ni < 2; ++ni)
#pragma unroll
        for (int reg = 0; reg < 16; ++reg)
          UG[(size_t)(mb + mi * 32 + crow(reg, h)) * DFF + (nb - DFF) + ni * 32 + r] = f2bf(acc[mi][ni][reg]);
  }
}

#define XB_TMO      128
#define XB_XCNT(j)  (256  + 64 * (j))
#define XB_XSUB(j)  (1280 + 64 * (j))
#define XB_XGEN(j)  (2304 + 64 * (j))
#define XB_TOP      3328
#define XB_TOPGEN   3392
#define XCD_BAR_WORDS 3456
#define XB_SPIN_CAP (1u << 20)
#define LAS __attribute__((address_space(3)))
DI unsigned xb_ld(unsigned* p) { return __hip_atomic_load(p, __ATOMIC_RELAXED, __HIP_MEMORY_SCOPE_AGENT); }
DI unsigned xb_add(unsigned* p, unsigned v) { return __hip_atomic_fetch_add(p, v, __ATOMIC_RELAXED, __HIP_MEMORY_SCOPE_AGENT); }
DI unsigned xb_xcc_id() { return (unsigned)__builtin_amdgcn_s_getreg((3 << 11) | 20) & 0xFu; }
#define XB_SPIN(cond, bar) do { unsigned _sp = 0; while (cond) { __builtin_amdgcn_s_sleep(1); \
    if ((++_sp & 255u) == 0u) { if (xb_ld(&(bar)[XB_TMO])) break; if (_sp > XB_SPIN_CAP) { atomicAdd(&(bar)[XB_TMO], 1u); break; } } } } while (0)
struct XcdBarrier { unsigned* bar; unsigned x; volatile LAS unsigned* st; };
DI XcdBarrier xcd_barrier_post(unsigned* bar, volatile LAS unsigned* st) {
  XcdBarrier b; b.bar = bar; b.x = xb_xcc_id(); b.st = st;
  if (__builtin_amdgcn_workitem_id_x() == 0) st[2] = xb_add(&bar[XB_XCNT(b.x)], 1u);
  return b;
}
DI void xcd_barrier_complete(unsigned* bar, unsigned x, unsigned& nloc, unsigned& nx) {
  const unsigned G = gridDim.x;
  unsigned sum, cnt, mine, sp = 0u;
  for (;;) {
    sum = 0u; cnt = 0u; mine = 0u;
#pragma unroll
    for (unsigned j = 0; j < 16; ++j) { const unsigned c = xb_ld(&bar[XB_XCNT(j)]); sum += c; cnt += (c > 0u) ? 1u : 0u; mine = (j == x) ? c : mine; }
    if (sum == G) break;
    __builtin_amdgcn_s_sleep(1);
    if ((++sp & 255u) == 0u) { if (xb_ld(&bar[XB_TMO])) break; if (sp > XB_SPIN_CAP) { atomicAdd(&bar[XB_TMO], 1u); break; } }
  }
  nloc = mine > 0u ? mine : 1u; nx = cnt > 0u ? cnt : 1u;
}
DI void xcd_barrier(const XcdBarrier& b) {
  asm volatile("s_waitcnt vmcnt(0)" ::: "memory");
  __syncthreads();
  if (__builtin_amdgcn_workitem_id_x() == 0) {
    unsigned* bar = b.bar;
    __builtin_amdgcn_s_waitcnt(0);
    unsigned nloc = b.st[0], nx = b.st[1];
    if (nloc == 0u) { xcd_barrier_complete(bar, b.x, nloc, nx); b.st[0] = nloc; b.st[1] = nx; }
    const unsigned old = xb_add(&bar[XB_XSUB(b.x)], 1u);
    const unsigned gen = old / nloc;
    if (old + 1u == (gen + 1u) * nloc) {
      __builtin_amdgcn_fence(__ATOMIC_RELEASE, "agent");
      asm volatile("s_waitcnt vmcnt(0)" ::: "memory");
      const unsigned og = xb_add(&bar[XB_TOP], 1u);
      const unsigned tg = og / nx;
      if (og + 1u == (tg + 1u) * nx) xb_add(&bar[XB_TOPGEN], 1u);
      else XB_SPIN(xb_ld(&bar[XB_TOPGEN]) == tg, bar);
      __builtin_amdgcn_fence(__ATOMIC_ACQUIRE, "agent");
      xb_add(&bar[XB_XGEN(b.x)], 1u);
      asm volatile("s_waitcnt vmcnt(0)" ::: "memory");
    } else {
      XB_SPIN(xb_ld(&bar[XB_XGEN(b.x)]) == gen, bar);
      __builtin_amdgcn_fence(__ATOMIC_ACQUIRE, "agent");
      asm volatile("s_waitcnt vmcnt(0)" ::: "memory");
    }
  }
  __syncthreads();
}

DI void signal_cnt(unsigned* c) {
  asm volatile("s_waitcnt vmcnt(0)" ::: "memory");
  __syncthreads();
  if (__builtin_amdgcn_workitem_id_x() == 0) { __builtin_amdgcn_fence(__ATOMIC_RELEASE, "agent"); asm volatile("s_waitcnt vmcnt(0)" ::: "memory"); (void)xb_add(c, 1u); }
}
DI void wait_cnt(unsigned* c, unsigned target, unsigned* bar) {
  if (__builtin_amdgcn_workitem_id_x() == 0) { XB_SPIN(xb_ld(c) < target, bar); __builtin_amdgcn_fence(__ATOMIC_ACQUIRE, "agent"); asm volatile("s_waitcnt vmcnt(0)" ::: "memory"); }
  __syncthreads();
}
constexpr int LN_CNT_WORD0 = XCD_BAR_WORDS;

DI void ln_row(const Params& p, int row, const float4 (&gv)[4], const float4 (&bv)[4], bool last, int nkk, int lane) {
  const float* Y = (const float*)(p.ws + WS_Y);
  float* X = (float*)(p.ws + WS_X); u16* XB = (u16*)(p.ws + WS_XB);
  float4 v[4];
  if (row < MP) {
    const float4* y = (const float4*)(Y + (size_t)row * 1024);
#pragma unroll
    for (int i = 0; i < 4; ++i) v[i] = y[lane + 64 * i];
  } else {
    const float4* x = (const float4*)(X + (size_t)row * 1024);
#pragma unroll
    for (int i = 0; i < 4; ++i) { const float4 t = x[lane + 64 * i]; v[i].x = ALPHA * t.x; v[i].y = ALPHA * t.y; v[i].z = ALPHA * t.z; v[i].w = ALPHA * t.w; }
    const float* __restrict__ PART = (const float*)(p.ws + WS_PART);
    for (int ks = 0; ks < nkk; ks += 4) {
      float4 t[4][4];
#pragma unroll
      for (int u = 0; u < 4; ++u)
#pragma unroll
        for (int i = 0; i < 4; ++i)
          t[u][i] = *(const float4*)(PART + ((size_t)(i * nkk + ks + u) * 128 + (row - MP)) * 256 + lane * 4);
#pragma unroll
      for (int u = 0; u < 4; ++u)
#pragma unroll
        for (int i = 0; i < 4; ++i) { v[i].x += t[u][i].x; v[i].y += t[u][i].y; v[i].z += t[u][i].z; v[i].w += t[u][i].w; }
    }
  }
  float sm = 0.f;
#pragma unroll
  for (int i = 0; i < 4; ++i) sm += v[i].x + v[i].y + v[i].z + v[i].w;
  const float mu = wave_sum(sm) * (1.f / 1024.f);
  float q = 0.f;
#pragma unroll
  for (int i = 0; i < 4; ++i) { v[i].x -= mu; v[i].y -= mu; v[i].z -= mu; v[i].w -= mu; q += v[i].x * v[i].x + v[i].y * v[i].y + v[i].z * v[i].z + v[i].w * v[i].w; }
  const float rs = rsqrtf(wave_sum(q) * (1.f / 1024.f) + LN_EPS);
  float4* xo = last ? (float4*)(p.out + (row < MP ? O_YP + (size_t)row * 1024 : O_YS + (size_t)(row - MP) * 1024)) : (float4*)(X + (size_t)row * 1024);
#pragma unroll
  for (int i = 0; i < 4; ++i) {
    float4 o;
    o.x = v[i].x * rs * gv[i].x + bv[i].x; o.y = v[i].y * rs * gv[i].y + bv[i].y;
    o.z = v[i].z * rs * gv[i].z + bv[i].z; o.w = v[i].w * rs * gv[i].w + bv[i].w;
    xo[lane + 64 * i] = o;
    if (!last) { uint2 ob; ob.x = pack2(o.x, o.y); ob.y = pack2(o.z, o.w); *(uint2*)(XB + (size_t)row * 1024 + (lane + 64 * i) * 4) = ob; }
  }
}
DI void ln_rows4(const Params& p, int row0, const float4 (&gv)[4], const float4 (&bv)[4], bool last, int lane) {
  const float* Y = (const float*)(p.ws + WS_Y);
  float* X = (float*)(p.ws + WS_X); u16* XB = (u16*)(p.ws + WS_XB);
  float4 v[4][4];
#pragma unroll
  for (int q = 0; q < 4; ++q)
#pragma unroll
    for (int i = 0; i < 4; ++i) v[q][i] = ((const float4*)(Y + (size_t)(row0 + q) * 1024))[lane + 64 * i];
  float sm[4];
#pragma unroll
  for (int q = 0; q < 4; ++q) { sm[q] = 0.f;
#pragma unroll
    for (int i = 0; i < 4; ++i) sm[q] += v[q][i].x + v[q][i].y + v[q][i].z + v[q][i].w; }
#pragma unroll
  for (int o = 32; o >= 1; o >>= 1)
#pragma unroll
    for (int q = 0; q < 4; ++q) sm[q] += __shfl_xor(sm[q], o);
  float qq[4];
#pragma unroll
  for (int q = 0; q < 4; ++q) { const float mu = sm[q] * (1.f / 1024.f); qq[q] = 0.f;
#pragma unroll
    for (int i = 0; i < 4; ++i) { v[q][i].x -= mu; v[q][i].y -= mu; v[q][i].z -= mu; v[q][i].w -= mu; qq[q] += v[q][i].x * v[q][i].x + v[q][i].y * v[q][i].y + v[q][i].z * v[q][i].z + v[q][i].w * v[q][i].w; } }
#pragma unroll
  for (int o = 32; o >= 1; o >>= 1)
#pragma unroll
    for (int q = 0; q < 4; ++q) qq[q] += __shfl_xor(qq[q], o);
#pragma unroll
  for (int q = 0; q < 4; ++q) {
    const int row = row0 + q;
    const float rs = rsqrtf(qq[q] * (1.f / 1024.f) + LN_EPS);
    float4* xo = last ? (float4*)(p.out + O_YP + (size_t)row * 1024) : (float4*)(X + (size_t)row * 1024);
#pragma unroll
    for (int i = 0; i < 4; ++i) {
      float4 o;
      o.x = v[q][i].x * rs * gv[i].x + bv[i].x; o.y = v[q][i].y * rs * gv[i].y + bv[i].y;
      o.z = v[q][i].z * rs * gv[i].z + bv[i].z; o.w = v[q][i].w * rs * gv[i].w + bv[i].w;
      xo[lane + 64 * i] = o;
      if (!last) { uint2 ob; ob.x = pack2(o.x, o.y); ob.y = pack2(o.z, o.w); *(uint2*)(XB + (size_t)row * 1024 + (lane + 64 * i) * 4) = ob; }
    }
  }
}
DI void phase_ln(const Params& p, const float* __restrict__ gam, const float* __restrict__ bet, bool last, int nkk) {
  const int lane = tidx() & 63;
  const int wid = bidx() * 4 + (tidx() >> 6), nw = NVB * 4;
  float4 gv[4], bv[4];
#pragma unroll
  for (int i = 0; i < 4; ++i) { gv[i] = ((const float4*)gam)[lane + 64 * i]; bv[i] = ((const float4*)bet)[lane + 64 * i]; }
  for (int rr = wid; rr < MT; rr += nw) ln_row(p, rr < MS ? MP + rr : rr - MS, gv, bv, last, nkk, lane);
}

enum { G_QKV, G_AO, G_RIN, G_RO, G_FIN, G_FOUT };
template <int G>
DI void gemm_phase(const Params& p, int layer, u16* lds, int vb, bool noepi = false, bool fuse_ln = false) {
  const int j = layer >> 1;
  const u16* A; const u16* Bt; int K, N;
  if (G == G_QKV) { A = (const u16*)(p.ws + WS_XB); Bt = (const u16*)(p.ws + WS_WQKV) + (size_t)j * 1536 * 1024; K = 1024; N = 1536; }
  else if (G == G_AO) { A = (const u16*)(p.ws + WS_ACT2); Bt = (const u16*)(p.ws + WS_WAO) + (size_t)j * 1024 * 1024; K = 1024; N = 1024; }
  else if (G == G_RIN) { A = (const u16*)(p.ws + WS_XB); Bt = (const u16*)(p.ws + WS_WRIN) + (size_t)j * 6144 * 1024; K = 1024; N = 6144; }
  else if (G == G_RO) { A = (const u16*)(p.ws + WS_ACT2); Bt = (const u16*)(p.ws + WS_WRO) + (size_t)j * 1024 * 2048; K = 2048; N = 1024; }
  else if (G == G_FIN) { A = (const u16*)(p.ws + WS_XB); Bt = (const u16*)(p.ws + WS_WFIN) + (size_t)layer * 5632 * 1024; K = 1024; N = 5632; }
  else { A = (const u16*)(p.ws + WS_ACT2); Bt = (const u16*)(p.ws + WS_WFOUT) + (size_t)layer * 1024 * 2816; K = 2816; N = 1024; }
  constexpr bool LNF = (G == G_AO || G == G_RO || G == G_FOUT);
  constexpr bool SPLIT = LNF || (G == G_RIN);
  const int ntn = N >> 8, ntiles = (SPLIT ? 64 : 65) * ntn;
  const int t = tid512(), lane = t & 63, w = t >> 6, wm = w >> 2, wn = w & 3;
  const int per = (int)gridDim.x >> 3;
  const int xcd = vb / per, rank = vb - xcd * per;
  const int lo = (int)(((long long)xcd * ntiles) >> 3), hi = (int)(((long long)(xcd + 1) * ntiles) >> 3);
  for (int L = lo + rank; L < hi; L += per) {
    int tm, tn;
    const int full = 64 * ntn;
    if (L < full) { const int sr = L / (8 * ntn), rem = L - sr * 8 * ntn; tn = rem >> 3; tm = 8 * sr + (rem & 7); }
    else { tn = L - full; tm = 64; }
    f32x16 acc[4][2];
    gemm_core(A + (size_t)tm * 256 * K, K, Bt + (size_t)tn * 256 * K, K, K, lds, acc);
    if (tm == 64 && wm == 1) continue;
    if (noepi) { float sacc = 0.f;
#pragma unroll
      for (int a = 0; a < 4; ++a)
#pragma unroll
        for (int b = 0; b < 2; ++b)
#pragma unroll
          for (int i = 0; i < 16; ++i) sacc += acc[a][b][i];
      if (sacc == 1.2345e30f) p.out[0] = 0.f; continue; }
    const int nb = tn * 256 + wn * 64;
    float* park = (float*)lds + w * 4096 + lane;
#pragma unroll
    for (int mi = 0; mi < 2; ++mi)
#pragma unroll
      for (int ni = 0; ni < 2; ++ni)
#pragma unroll
        for (int i = 0; i < 16; ++i) park[(mi * 32 + ni * 16 + i) * 64] = acc[2 + mi][ni][i];
    f32x16 ac[2][2];
    ac[0][0] = acc[0][0]; ac[0][1] = acc[0][1]; ac[1][0] = acc[1][0]; ac[1][1] = acc[1][1];
#pragma unroll 1
    for (int hf = 0; hf < 2; ++hf) {
      if (hf) {
#pragma unroll
        for (int mi = 0; mi < 2; ++mi)
#pragma unroll
          for (int ni = 0; ni < 2; ++ni)
#pragma unroll
            for (int i = 0; i < 16; ++i) ac[mi][ni][i] = park[(mi * 32 + ni * 16 + i) * 64];
      }
      const int mb = tm * 256 + wm * 128 + hf * 64;
      if (G == G_QKV) epi_qkv(p, j, ac, mb, nb, lane);
      else if (G == G_RIN) epi_rin(p, j, ac, mb, nb, lane);
      else if (G == G_FIN) epi_fin(p, layer, ac, mb, nb, lane);
      else epi_res(p, ac, mb, nb, lane);
    }
    if (LNF && fuse_ln) signal_cnt((unsigned*)(p.ws + WS_BAR) + LN_CNT_WORD0 + (layer * 2 + (G == G_FOUT ? 1 : 0)) * 65 + tm);
  }
  if (SPLIT) {
    const int nkk = K >> 6, r = lane & 31, h = lane >> 5;
    float* PART = (float*)(p.ws + (LNF ? WS_PART : WS_PART2));
    for (int e = vb; e < ntn * nkk; e += (int)gridDim.x) {
      const int tn = e / nkk, ks = e - tn * nkk;
      f32x16 acc[4][2];
      gemm_core(A + (size_t)MP * K + ks * 64, K, Bt + (size_t)tn * 256 * K + ks * 64, K, 64, lds, acc);
      if (wm == 0) {
        float* o = PART + (size_t)e * 128 * 256 + wn * 64 + r;
#pragma unroll
        for (int mi = 0; mi < 4; ++mi)
#pragma unroll
          for (int ni = 0; ni < 2; ++ni)
#pragma unroll
            for (int i = 0; i < 16; ++i) o[(size_t)(mi * 32 + crow(i, h)) * 256 + ni * 32] = acc[mi][ni][i];
      }
      if (LNF && fuse_ln) signal_cnt((unsigned*)(p.ws + WS_BAR) + LN_CNT_WORD0 + (layer * 2 + (G == G_FOUT ? 1 : 0)) * 65 + 64);
    }
    if (LNF && fuse_ln) {
      unsigned* bar = (unsigned*)(p.ws + WS_BAR);
      unsigned* cnt = bar + LN_CNT_WORD0 + (layer * 2 + (G == G_FOUT ? 1 : 0)) * 65;
      const float* gam = (G == G_FOUT ? p.in[I_LFG] : p.in[I_LMG]) + layer * 1024;
      const float* bet = (G == G_FOUT ? p.in[I_LFB] : p.in[I_LMB]) + layer * 1024;
      const bool last = (G == G_FOUT) && layer == 3;
      float4 gv[4], bv[4];
#pragma unroll
      for (int i = 0; i < 4; ++i) { gv[i] = ((const float4*)gam)[lane + 64 * i]; bv[i] = ((const float4*)bet)[lane + 64 * i]; }
      for (int L = lo + rank; L < hi; L += per) {
        const int sr = L / (8 * ntn), rem = L - sr * 8 * ntn, tn = rem >> 3, tm = 8 * sr + (rem & 7);
        wait_cnt(cnt + tm, 4u, bar);
        ln_rows4(p, tm * 256 + tn * 64 + w * 8, gv, bv, last, lane);
        ln_rows4(p, tm * 256 + tn * 64 + w * 8 + 4, gv, bv, last, lane);
      }
      const int G_ = (int)gridDim.x;
      if (vb >= G_ - 16) {
        wait_cnt(cnt + 64, (unsigned)(4 * nkk), bar);
        ln_row(p, MP + (vb - (G_ - 16)) * 8 + w, gv, bv, last, nkk, lane);
      }
    }
  }
}

DI void transpose_job(const float* __restrict__ src, u16* __restrict__ dst, int K, int N, float* tl) {
  const int t = tidx();
  const int tn = N >> 6, ntiles = (K >> 6) * tn;
  for (int tile = bidx(); tile < ntiles; tile += NVB) {
    const int k0 = (tile / tn) << 6, n0 = (tile % tn) << 6;
    __syncthreads();
#pragma unroll
    for (int i = 0; i < 16; ++i) { const int k = (t >> 6) + 4 * i; tl[k * 65 + (t & 63)] = __builtin_nontemporal_load(src + (size_t)(k0 + k) * N + n0 + (t & 63)); }
    __syncthreads();
    const int n = t >> 2, kq = (t & 3) * 16;
    uint4 v0, v1;
    v0.x = pack2(tl[(kq + 0) * 65 + n], tl[(kq + 1) * 65 + n]); v0.y = pack2(tl[(kq + 2) * 65 + n], tl[(kq + 3) * 65 + n]);
    v0.z = pack2(tl[(kq + 4) * 65 + n], tl[(kq + 5) * 65 + n]); v0.w = pack2(tl[(kq + 6) * 65 + n], tl[(kq + 7) * 65 + n]);
    v1.x = pack2(tl[(kq + 8) * 65 + n], tl[(kq + 9) * 65 + n]); v1.y = pack2(tl[(kq + 10) * 65 + n], tl[(kq + 11) * 65 + n]);
    v1.z = pack2(tl[(kq + 12) * 65 + n], tl[(kq + 13) * 65 + n]); v1.w = pack2(tl[(kq + 14) * 65 + n], tl[(kq + 15) * 65 + n]);
    u16* o = dst + (size_t)(n0 + n) * K + k0 + kq;
    *(uint4*)o = v0; *(uint4*)(o + 8) = v1;
  }
}

DI void phase_prep(const Params& p, u16* lds) {
  float* tl = (float*)lds;
  for (int j = 0; j < 2; ++j) {
    transpose_job(p.in[I_WQKV] + (size_t)j * 1024 * 1536, (u16*)(p.ws + WS_WQKV) + (size_t)j * 1536 * 1024, 1024, 1536, tl);
    transpose_job(p.in[I_WAO] + (size_t)j * 1024 * 1024, (u16*)(p.ws + WS_WAO) + (size_t)j * 1024 * 1024, 1024, 1024, tl);
    transpose_job(p.in[I_WRIN] + (size_t)j * 1024 * 6144, (u16*)(p.ws + WS_WRIN) + (size_t)j * 6144 * 1024, 1024, 6144, tl);
    transpose_job(p.in[I_WRO] + (size_t)j * 2048 * 1024, (u16*)(p.ws + WS_WRO) + (size_t)j * 1024 * 2048, 2048, 1024, tl);
  }
  for (int i = 0; i < 4; ++i) {
    transpose_job(p.in[I_WFIN] + (size_t)i * 1024 * 5632, (u16*)(p.ws + WS_WFIN) + (size_t)i * 5632 * 1024, 1024, 5632, tl);
    transpose_job(p.in[I_WFOUT] + (size_t)i * 2816 * 1024, (u16*)(p.ws + WS_WFOUT) + (size_t)i * 1024 * 2816, 2816, 1024, tl);
  }
  const size_t gid = (size_t)bidx() * 256 + tidx(), gstride = (size_t)NVB * 256;
  {
    float4* X = (float4*)(p.ws + WS_X); uint2* XB = (uint2*)(p.ws + WS_XB);
    const size_t nv = (size_t)MT * 256, npv = (size_t)MP * 256;
    for (size_t v0 = gid; v0 < nv; v0 += 4 * gstride) {
      float4 xb[4];
#pragma unroll
      for (int u = 0; u < 4; ++u) { const size_t v = v0 + u * gstride; if (v < nv) xb[u] = (v < npv) ? ((const float4*)p.in[I_XP])[v] : ((const float4*)p.in[I_XS])[v - npv]; }
#pragma unroll
      for (int u = 0; u < 4; ++u) { const size_t v = v0 + u * gstride; if (v < nv) { X[v] = xb[u]; uint2 o; o.x = pack2(xb[u].x, xb[u].y); o.y = pack2(xb[u].z, xb[u].w); XB[v] = o; } }
    }
  }
  {
    float* cosT = (float*)(p.ws + WS_TROPE); float* sinT = cosT + 8193 * 32;
    for (size_t v = gid; v < 8193ull * 32; v += gstride) {
      const int pos = (int)(v >> 5), i = (int)(v & 31);
      const double inv = exp(-9.210340371976182736 * (double)i / 32.0);
      float s, c; sincos_d((double)pos * inv, s, c); cosT[v] = c; sinT[v] = s;
    }
    float* cosR = (float*)(p.ws + WS_TRET); float* sinR = cosR + 8193 * 128;
    for (size_t v = gid; v < 8193ull * 128; v += gstride) {
      const int pos = (int)(v >> 7), i = (int)(v & 127);
      const double inv = exp(-9.210340371976182736 * (double)i / 127.0);
      float s, c; sincos_d((double)pos * inv, s, c); cosR[v] = c; sinR[v] = s;
    }
  }
}

DI void attn_prompt_item(const Params& p, int j, int item, u16* lds) {
  const int g = item & 3, kvh = (item >> 2) & 3, qb = (item >> 4) & 63, b = item >> 10;
  const int head = kvh * 4 + g;
  const int t = tidx(), lane = t & 63, w = t >> 6, r = lane & 31, h = lane >> 5;
  u16* Ks = lds;
  u16* Vts = lds + 256 * 72;
  const u16* Q = (const u16*)(p.ws + A_Q); const u16* KB = (const u16*)(p.ws + A_K); const u16* VT = (const u16*)(p.ws + A_VT);
  u16* OB = (u16*)(p.ws + WS_ACT2);
  const int tok0 = qb * 128 - 128;
  __syncthreads();
#pragma unroll
  for (int i = 0; i < 8; ++i) {
    const int c = t + 256 * i, key = c >> 3, part = c & 7, tok = tok0 + key;
    uint4 v = make_uint4(0, 0, 0, 0);
    if (tok >= 0) v = *(const uint4*)(KB + (size_t)(b * 8192 + tok) * 256 + kvh * 64 + part * 8);
    *(uint4*)(Ks + key * 72 + part * 8) = v;
  }
#pragma unroll
  for (int i = 0; i < 8; ++i) {
    const int c = t + 256 * i, d = c >> 5, part = c & 31, tok = tok0 + part * 8;
    uint4 v = make_uint4(0, 0, 0, 0);
    if (tok >= 0) v = *(const uint4*)(VT + (size_t)(b * 256 + kvh * 64 + d) * 8192 + tok);
    *(uint4*)(Vts + d * 264 + part * 8) = v;
  }
  const size_t qrow = (size_t)b * 8192 + qb * 128 + 32 * w + r;
  bf16x8 bq[4];
#pragma unroll
  for (int kk = 0; kk < 4; ++kk) bq[kk] = *(const bf16x8*)(Q + qrow * 1024 + head * 64 + kk * 16 + h * 8);
  __syncthreads();
  f32x16 S[5];
#pragma unroll
  for (int jb = 0; jb < 5; ++jb) {
#pragma unroll
    for (int i = 0; i < 16; ++i) S[jb][i] = 0.f;
    const u16* kp = Ks + (32 * (w + jb) + r) * 72 + h * 8;
#pragma unroll
    for (int kk = 0; kk < 4; ++kk) S[jb] = MFMA(*(const bf16x8*)(kp + kk * 16), bq[kk], S[jb]);
  }
  const float sink = p.in[I_SINK][j * 16 + head];
  float m = -INFINITY;
#pragma unroll
  for (int jb = 0; jb < 5; ++jb)
#pragma unroll
    for (int reg = 0; reg < 16; ++reg) {
      const int cr = crow(reg, h);
      const int rel = 128 + r - 32 * jb - cr;
      const bool valid = (rel >= 0) && (rel <= 128) && (qb > 0 || (32 * (w + jb) + cr) >= 128);
      const float s = valid ? S[jb][reg] : -INFINITY;
      S[jb][reg] = s; m = fmaxf(m, s);
    }
  m = fmaxf(m, __shfl_xor(m, 32));
  m = fmaxf(m, sink);
  float l = 0.f;
#pragma unroll
  for (int jb = 0; jb < 5; ++jb)
#pragma unroll
    for (int reg = 0; reg < 16; ++reg) { const float e = __expf(S[jb][reg] - m); S[jb][reg] = e; l += e; }
  l += __shfl_xor(l, 32);
  const float inv = 1.f / (l + __expf(sink - m));
  f32x16 O[2];
#pragma unroll
  for (int db = 0; db < 2; ++db)
#pragma unroll
    for (int i = 0; i < 16; ++i) O[db][i] = 0.f;
#pragma unroll
  for (int jb = 0; jb < 5; ++jb)
#pragma unroll
    for (int s = 0; s < 2; ++s) {
      uint4 pb;
      pb.x = pack2(S[jb][8 * s + 0], S[jb][8 * s + 1]); pb.y = pack2(S[jb][8 * s + 2], S[jb][8 * s + 3]);
      pb.z = pack2(S[jb][8 * s + 4], S[jb][8 * s + 5]); pb.w = pack2(S[jb][8 * s + 6], S[jb][8 * s + 7]);
      const bf16x8 bfrag = __builtin_bit_cast(bf16x8, pb);
#pragma unroll
      for (int db = 0; db < 2; ++db) {
        const u16* vp = Vts + (32 * db + r) * 264 + 32 * (w + jb) + 16 * s + 4 * h;
        const uint2 lo = *(const uint2*)vp, hi = *(const uint2*)(vp + 8);
        uint4 av; av.x = lo.x; av.y = lo.y; av.z = hi.x; av.w = hi.y;
        O[db] = MFMA(__builtin_bit_cast(bf16x8, av), bfrag, O[db]);
      }
    }
#pragma unroll
  for (int db = 0; db < 2; ++db)
#pragma unroll
    for (int g4 = 0; g4 < 4; ++g4) {
      uint2 v; v.x = pack2(O[db][4 * g4] * inv, O[db][4 * g4 + 1] * inv); v.y = pack2(O[db][4 * g4 + 2] * inv, O[db][4 * g4 + 3] * inv);
      *(uint2*)(OB + qrow * 1024 + head * 64 + 32 * db + 8 * g4 + 4 * h) = v;
    }
}

DI void attn_sample_item(const Params& p, int j, int item, u16* lds) {
  const int kvh = item & 3, b = item >> 2;
  const int t = tidx(), lane = t & 63, g = t >> 6;
  float* Kc = (float*)lds;
  float* Vc = Kc + 129 * 65;
  float* qs = Vc + 129 * 65;
  float* ps = qs + 256;
  const float* ck = p.in[I_CK] + (size_t)(j * 128 + b) * 128 * 256;
  const float* cv = p.in[I_CV] + (size_t)(j * 128 + b) * 128 * 256;
  float* ok = p.out + O_KWS + (size_t)(j * 128 + b) * 128 * 256;
  float* ov = p.out + O_VWS + (size_t)(j * 128 + b) * 128 * 256;
  __syncthreads();
  {
    const int d = t & 63, w0 = t >> 6;
#pragma unroll 1
    for (int i0 = 0; i0 < 32; i0 += 8) {
      float kb[8], vb[8];
#pragma unroll
      for (int u = 0; u < 8; ++u) { const int wq = w0 + 4 * (i0 + u); kb[u] = __builtin_nontemporal_load(ck + wq * 256 + kvh * 64 + d); vb[u] = __builtin_nontemporal_load(cv + wq * 256 + kvh * 64 + d); }
#pragma unroll
      for (int u = 0; u < 8; ++u) {
        const int wq = w0 + 4 * (i0 + u);
        Kc[wq * 65 + d] = kb[u]; Vc[wq * 65 + d] = vb[u];
        if (wq >= 1) { __builtin_nontemporal_store(kb[u], ok + (wq - 1) * 256 + kvh * 64 + d); __builtin_nontemporal_store(vb[u], ov + (wq - 1) * 256 + kvh * 64 + d); }
      }
    }
  }
  if (t < 64) { Kc[128 * 65 + t] = ok[127 * 256 + kvh * 64 + t]; Vc[128 * 65 + t] = ov[127 * 256 + kvh * 64 + t]; }
  qs[t] = bf2f(((const u16*)(p.ws + A_Q))[(size_t)(MP + b) * 1024 + (kvh * 4 + g) * 64 + lane]);
  __syncthreads();
  const float sink = p.in[I_SINK][j * 16 + kvh * 4 + g];
  float s0 = 0.f, s1 = 0.f, s2 = 0.f;
#pragma unroll 8
  for (int d = 0; d < 64; ++d) {
    const float q = qs[g * 64 + d];
    s0 += q * Kc[lane * 65 + d]; s1 += q * Kc[(lane + 64) * 65 + d]; s2 += q * Kc[128 * 65 + d];
  }
  float m = fmaxf(fmaxf(s0, s1), s2);
  m = fmaxf(wave_max(m), sink);
  const float e0 = __expf(s0 - m), e1 = __expf(s1 - m), e2 = __expf(s2 - m);
  float l = wave_sum(e0 + e1) + e2;
  const float inv = 1.f / (l + __expf(sink - m));
  ps[g * 132 + lane] = e0 * inv; ps[g * 132 + 64 + lane] = e1 * inv;
  if (lane == 0) ps[g * 132 + 128] = e2 * inv;
  __syncthreads();
  float o = 0.f;
#pragma unroll 4
  for (int k = 0; k < 129; ++k) o += ps[g * 132 + k] * Vc[k * 65 + lane];
  ((u16*)(p.ws + WS_ACT2))[(size_t)(MP + b) * 1024 + (kvh * 4 + g) * 64 + lane] = f2bf(o);
}

DI void phase_attn(const Params& p, int layer, u16* lds, int vb) {
  const int j = layer >> 1;
  const int vid = 2 * vb + __builtin_amdgcn_readfirstlane(tid512() >> 8);
  for (int item = vid; item < 2048 + 512; item += NVB) {
    if (item < 2048) attn_prompt_item(p, j, item, lds);
    else attn_sample_item(p, j, item - 2048, lds);
  }
}

DI void unpack8(const uint4 x, float (&o)[8]) {
  o[0] = __uint_as_float(x.x << 16); o[1] = __uint_as_float(x.x & 0xffff0000u); o[2] = __uint_as_float(x.y << 16); o[3] = __uint_as_float(x.y & 0xffff0000u);
  o[4] = __uint_as_float(x.z << 16); o[5] = __uint_as_float(x.z & 0xffff0000u); o[6] = __uint_as_float(x.w << 16); o[7] = __uint_as_float(x.w & 0xffff0000u);
}
DI void phase_conv(const Params& p, int i) {
  const u16* __restrict__ UA = (const u16*)(p.ws + F_UA); const u16* __restrict__ UG = (const u16*)(p.ws + F_UG);
  u16* __restrict__ H = (u16*)(p.ws + WS_ACT2);
  const float* cw = p.in[I_CW] + (size_t)i * 3 * DFF; const float* cb = p.in[I_CB] + (size_t)i * DFF;
  const float* sc = p.in[I_SC] + (size_t)i * 128 * 2 * DFF;
  const int gid = bidx() * 256 + tidx(), gstride = NVB * 256;
  for (int it = gid; it < 1024 * 352 + 128 * 352; it += gstride) {
    const bool smp = it >= 1024 * 352;
    const int it2 = smp ? it - 1024 * 352 : it;
    const int ch = it2 / 352, f = (it2 - ch * 352) * 8, row0 = smp ? MP + ch : ch * 16;
    float w0[8], w1[8], w2[8], bb[8];
#pragma unroll
    for (int k = 0; k < 8; ++k) { w0[k] = cw[f + k]; w1[k] = cw[DFF + f + k]; w2[k] = cw[2 * DFF + f + k]; bb[k] = cb[f + k]; }
    if (!smp) {
      float a1[8], a2[8];
      const int pos0 = row0 & 8191;
      if (pos0 >= 2) { unpack8(*(const uint4*)(UA + (size_t)(row0 - 1) * DFF + f), a1); unpack8(*(const uint4*)(UA + (size_t)(row0 - 2) * DFF + f), a2); }
      else {
#pragma unroll
        for (int k = 0; k < 8; ++k) { a1[k] = 0.f; a2[k] = 0.f; }
      }
#pragma unroll 1
      for (int rr = 0; rr < 16; rr += 4) {
        const size_t o = (size_t)(row0 + rr) * DFF + f;
        uint4 xa[4], xg[4];
#pragma unroll
        for (int u = 0; u < 4; ++u) { xa[u] = *(const uint4*)(UA + o + (size_t)u * DFF); xg[u] = *(const uint4*)(UG + o + (size_t)u * DFF); }
#pragma unroll
        for (int u = 0; u < 4; ++u) {
          float a0[8], gg[8];
          unpack8(xa[u], a0); unpack8(xg[u], gg);
          unsigned ho[4];
#pragma unroll
          for (int k = 0; k < 4; ++k) {
            const float c0 = bb[2 * k] + a2[2 * k] * w0[2 * k] + a1[2 * k] * w1[2 * k] + a0[2 * k] * w2[2 * k];
            const float c1 = bb[2 * k + 1] + a2[2 * k + 1] * w0[2 * k + 1] + a1[2 * k + 1] * w1[2 * k + 1] + a0[2 * k + 1] * w2[2 * k + 1];
            ho[k] = pack2(silu(c0) * gg[2 * k], silu(c1) * gg[2 * k + 1]);
          }
          *(uint4*)(H + o + (size_t)u * DFF) = make_uint4(ho[0], ho[1], ho[2], ho[3]);
#pragma unroll
          for (int k = 0; k < 8; ++k) { a2[k] = a1[k]; a1[k] = a0[k]; }
        }
      }
    } else {
      const int b = row0 - MP;
      const size_t o = (size_t)row0 * DFF + f;
      float a0[8], gg[8];
      unpack8(*(const uint4*)(UA + o), a0); unpack8(*(const uint4*)(UG + o), gg);
      const float4* s0p = (const float4*)(sc + (size_t)(b * 2 + 0) * DFF + f); const float4* s1p = (const float4*)(sc + (size_t)(b * 2 + 1) * DFF + f);
      float4* o0 = (float4*)(p.out + O_CSS + ((size_t)(i * 128 + b) * 2 + 0) * DFF + f);
      const float4 p0 = s0p[0], p1 = s0p[1], q0 = s1p[0], q1 = s1p[1];
      o0[0] = q0; o0[1] = q1;
      const float x2[8] = {p0.x, p0.y, p0.z, p0.w, p1.x, p1.y, p1.z, p1.w}, x1[8] = {q0.x, q0.y, q0.z, q0.w, q1.x, q1.y, q1.z, q1.w};
      unsigned ho[4];
#pragma unroll
      for (int k = 0; k < 4; ++k) {
        const float c0 = bb[2 * k] + x2[2 * k] * w0[2 * k] + x1[2 * k] * w1[2 * k] + a0[2 * k] * w2[2 * k];
        const float c1 = bb[2 * k + 1] + x2[2 * k + 1] * w0[2 * k + 1] + x1[2 * k + 1] * w1[2 * k + 1] + a0[2 * k + 1] * w2[2 * k + 1];
        ho[k] = pack2(silu(c0) * gg[2 * k], silu(c1) * gg[2 * k + 1]);
      }
      *(uint4*)(H + o) = make_uint4(ho[0], ho[1], ho[2], ho[3]);
    }
  }
}

DI void ret_u_tile(const Params& p, int tile, u16* lds) {
  const int te = tile & 1, hh = (tile >> 1) & 3, c = (tile >> 3) & 63, b = tile >> 9;
  const u16* VT = (const u16*)(p.ws + R_VT) + (size_t)(b * 2048 + hh * 512 + te * 256) * 8192 + c * 128;
  const u16* KT = (const u16*)(p.ws + R_KT) + (size_t)(b * 1024 + hh * 256) * 8192 + c * 128;
  f32x16 acc[4][2];
  gemm_core(VT, 8192, KT, 8192, 128, lds, acc);
  const int t = tid512(), lane = t & 63, w = t >> 6, wm = w >> 2, wn = w & 3, r = lane & 31, h = lane >> 5;
  u16* UT = (u16*)(p.ws + WS_US) + (size_t)((b * 64 + c) * 4 + hh) * 512 * 256;
#pragma unroll
  for (int mi = 0; mi < 4; ++mi)
#pragma unroll
    for (int ni = 0; ni < 2; ++ni)
#pragma unroll
      for (int reg = 0; reg < 16; ++reg)
        UT[(size_t)(te * 256 + wm * 128 + mi * 32 + crow(reg, h)) * 256 + wn * 64 + ni * 32 + r] = f2bf(acc[mi][ni][reg]);
}

DI float block_sum(float v, float* red) {
  v = wave_sum(v);
  __syncthreads();
  if ((tidx() & 63) == 0) red[tidx() >> 6] = v;
  __syncthreads();
  return red[0] + red[1] + red[2] + red[3];
}

DI void ret_sample_item(const Params& p, int j, int item, u16* lds) {
  const int hh = item & 3, b = item >> 2, t = tidx(), tc = t & 127, par = t >> 7;
  float* qs = (float*)lds; float* ks = qs + 256; float* red = ks + 256; float4* red4 = (float4*)(red + 8);
  const float* __restrict__ P2 = (const float*)(p.ws + WS_PART2);
  __syncthreads();
  float qr = 0.f, kr = 0.f;
  float4 vv = make_float4(0.f, 0.f, 0.f, 0.f), gq = make_float4(0.f, 0.f, 0.f, 0.f);
  {
    const float* pq = P2 + ((size_t)(hh * 16) * 128 + b) * 256 + t;
    const float* pk = P2 + ((size_t)((4 + hh) * 16) * 128 + b) * 256 + t;
    const float* pv = P2 + ((size_t)((8 + 2 * hh + (tc >> 6)) * 16) * 128 + b) * 256 + ((4 * tc) & 255);
    const float* pg = P2 + ((size_t)((16 + 2 * hh + (tc >> 6)) * 16) * 128 + b) * 256 + ((4 * tc) & 255);
    float qb[16], kb[16]; float4 vb4[16], gb4[16];
#pragma unroll
    for (int u = 0; u < 16; ++u) { qb[u] = pq[(size_t)u * 128 * 256]; kb[u] = pk[(size_t)u * 128 * 256]; }
#pragma unroll
    for (int u = 0; u < 16; ++u) { vb4[u] = *(const float4*)(pv + (size_t)u * 128 * 256); gb4[u] = *(const float4*)(pg + (size_t)u * 128 * 256); }
#pragma unroll
    for (int u = 0; u < 16; ++u) {
      qr += qb[u]; kr += kb[u];
      vv.x += vb4[u].x; vv.y += vb4[u].y; vv.z += vb4[u].z; vv.w += vb4[u].w;
      gq.x += gb4[u].x; gq.y += gb4[u].y; gq.z += gb4[u].z; gq.w += gb4[u].w;
    }
  }
  qs[t] = qr; ks[t] = kr;
  __syncthreads();
  float qv, kv;
  {
    const float* cosR = (const float*)(p.ws + WS_TRET); const float* sinR = cosR + 8193 * 128;
    const float c = cosR[8192 * 128 + (t >> 1)], sn = sinR[8192 * 128 + (t >> 1)];
    const float oq = qs[t ^ 1], ok_ = ks[t ^ 1];
    const float rq = (t & 1) ? (qr * c + oq * sn) : (qr * c - oq * sn);
    const float rk = (t & 1) ? (kr * c + ok_ * sn) : (kr * c - ok_ * sn);
    const float lg = lg2gamma(hh);
    qv = rq * exp2f(lg); kv = rk * 0.0625f * exp2f(-lg);
  }
  __syncthreads();
  qs[t] = qv; ks[t] = kv;
  const float qk = block_sum(qv * kv, red);
  const float gamma = 1.f - exp2f(-5.f - (float)hh);
  const float4* __restrict__ s0 = (const float4*)(p.in[I_SR] + ((size_t)((j * 128 + b) * 4 + hh) * 256) * 512) + tc;
  float4* __restrict__ so = (float4*)(p.out + O_RSS + ((size_t)((j * 128 + b) * 4 + hh) * 256) * 512) + tc;
  float4 o = make_float4(0.f, 0.f, 0.f, 0.f);
#pragma unroll 1
  for (int d0 = par; d0 < 256; d0 += 16) {
    float4 sv[8];
#pragma unroll
    for (int u = 0; u < 8; ++u) { const f32x4 t4 = __builtin_nontemporal_load((const f32x4*)(s0 + (size_t)(d0 + 2 * u) * 128)); sv[u] = make_float4(t4[0], t4[1], t4[2], t4[3]); }
#pragma unroll
    for (int u = 0; u < 8; ++u) {
      const float q = qs[d0 + 2 * u], k = ks[d0 + 2 * u];
      o.x += q * sv[u].x; o.y += q * sv[u].y; o.z += q * sv[u].z; o.w += q * sv[u].w;
      float4 n; n.x = gamma * (sv[u].x + k * vv.x); n.y = gamma * (sv[u].y + k * vv.y); n.z = gamma * (sv[u].z + k * vv.z); n.w = gamma * (sv[u].w + k * vv.w);
      { f32x4 n4; n4[0] = n.x; n4[1] = n.y; n4[2] = n.z; n4[3] = n.w; __builtin_nontemporal_store(n4, (f32x4*)(so + (size_t)(d0 + 2 * u) * 128)); }
    }
  }
  red4[t] = o;
  __syncthreads();
  float s1 = 0.f;
  if (par == 0) {
    const float4 o2 = red4[t + 128];
    o.x += o2.x + qk * vv.x; o.y += o2.y + qk * vv.y; o.z += o2.z + qk * vv.z; o.w += o2.w + qk * vv.w;
    s1 = o.x + o.y + o.z + o.w;
  }
  const float mu = block_sum(s1, red) * (1.f / 512.f);
  float s2 = 0.f;
  if (par == 0) { o.x -= mu; o.y -= mu; o.z -= mu; o.w -= mu; s2 = o.x * o.x + o.y * o.y + o.z * o.z + o.w * o.w; }
  const float var = block_sum(s2, red) * (1.f / 512.f);
  const float rs = rsqrtf(var + GN_EPS);
  if (par == 0) {
    u16* OB = (u16*)(p.ws + WS_ACT2) + (size_t)(MP + b) * 2048 + hh * 512 + 4 * tc;
    uint2 ov; ov.x = pack2(o.x * rs * silu(gq.x), o.y * rs * silu(gq.y)); ov.y = pack2(o.z * rs * silu(gq.z), o.w * rs * silu(gq.w));
    *(uint2*)OB = ov;
  }
}

DI void phase_ret_u(const Params& p, int layer, u16* lds) {
  const int j = layer >> 1;
  const int half = __builtin_amdgcn_readfirstlane(tid512() >> 8);
  const int G = (int)gridDim.x, gs = G >> 1, br = bid_real();
  if (br < gs) {
    for (int it = br; it < 256; it += gs) ret_sample_item(p, j, 2 * it + half, lds + half * LDS_HALF_E);
  } else {
    for (int it = br - gs; it < 1024; it += G - gs) ret_u_tile(p, it, lds);
  }
}

DI void phase_ret_scan(const Params& p, int layer) {
  const int j = layer >> 1;
  u16* UT = (u16*)(p.ws + WS_US);
  const size_t cstride = 4ull * 512 * 256;
  for (int v = bidx() * 256 + tidx(); v < 131072; v += NVB * 256) {
    const int d8 = v & 31, e = (v >> 5) & 511, hh = (v >> 14) & 3, b = v >> 16;
    u16* base = UT + ((size_t)(b * 64 * 4 + hh) * 512 + e) * 256 + d8 * 8;
    const float cd = exp2f(128.f * lg2gamma(hh));
    float s[8];
#pragma unroll
    for (int k = 0; k < 8; ++k) s[k] = 0.f;
#pragma unroll 1
    for (int c0 = 0; c0 < 64; c0 += 16) {
      uint4 ub[16];
#pragma unroll
      for (int q = 0; q < 16; ++q) ub[q] = *(const uint4*)(base + (size_t)(c0 + q) * cstride);
#pragma unroll
      for (int q = 0; q < 16; ++q) {
        uint4 o; o.x = pack2(s[0], s[1]); o.y = pack2(s[2], s[3]); o.z = pack2(s[4], s[5]); o.w = pack2(s[6], s[7]);
        *(uint4*)(base + (size_t)(c0 + q) * cstride) = o;
        const unsigned us[4] = {ub[q].x, ub[q].y, ub[q].z, ub[q].w};
#pragma unroll
        for (int k = 0; k < 4; ++k) {
          s[2 * k] = cd * (s[2 * k] + __uint_as_float(us[k] << 16));
          s[2 * k + 1] = cd * (s[2 * k + 1] + __uint_as_float(us[k] & 0xffff0000u));
        }
      }
    }
    float* o = p.out + O_RSP + ((size_t)((j * 2 + b) * 4 + hh) * 256 + d8 * 8) * 512 + e;
#pragma unroll
    for (int k = 0; k < 8; ++k) o[(size_t)k * 512] = s[k];
  }
}

DI void ret_out_item(const Params& p, int item, u16* lds) {
  const int rh = item & 1, hh = (item >> 1) & 3, c = (item >> 3) & 63, b = item >> 9;
  const int t = tidx(), lane = t & 63, w = t >> 6, r = lane & 31, h = lane >> 5;
  const size_t row0 = (size_t)b * 8192 + c * 128, trow0 = row0 + rh * 64;
  const u16* QR = (const u16*)(p.ws + R_Q); const u16* KR = (const u16*)(p.ws + R_K);
  const u16* VT = (const u16*)(p.ws + R_VT) + (size_t)(b * 2048 + hh * 512) * 8192 + c * 128;
  const u16* PT = (const u16*)(p.ws + WS_US) + (size_t)((b * 64 + c) * 4 + hh) * 512 * 256;
  u16* inner = lds;
  float* red1 = (float*)lds;
  float* red2 = red1 + 64 * 132;
  float* smu = red2 + 64 * 132;
  float* srs = smu + 64;
  __syncthreads();
  {
    f32x16 T[2];
#pragma unroll
    for (int ib = 0; ib < 2; ++ib)
#pragma unroll
      for (int i = 0; i < 16; ++i) T[ib][i] = 0.f;
    if (rh == 1 || w < 2) {
      const u16* kp = KR + (row0 + 32 * w + r) * 1024 + hh * 256 + h * 8;
      const u16* qp0 = QR + (trow0 + r) * 1024 + hh * 256 + h * 8;
      const u16* qp1 = qp0 + 32 * 1024;
#pragma unroll 4
      for (int ks = 0; ks < 16; ++ks) {
        const bf16x8 a = *(const bf16x8*)(kp + ks * 16);
        T[0] = MFMA(a, *(const bf16x8*)(qp0 + ks * 16), T[0]);
        T[1] = MFMA(a, *(const bf16x8*)(qp1 + ks * 16), T[1]);
      }
    }
#pragma unroll
    for (int ib = 0; ib < 2; ++ib)
#pragma unroll
      for (int g4 = 0; g4 < 4; ++g4) {
        const int il = 32 * ib + r, ig = rh * 64 + il, j0 = 32 * w + 8 * g4 + 4 * h;
        const float v0 = (j0 + 0 <= ig) ? T[ib][4 * g4 + 0] : 0.f, v1 = (j0 + 1 <= ig) ? T[ib][4 * g4 + 1] : 0.f;
        const float v2 = (j0 + 2 <= ig) ? T[ib][4 * g4 + 2] : 0.f, v3 = (j0 + 3 <= ig) ? T[ib][4 * g4 + 3] : 0.f;
        uint2 v; v.x = pack2(v0, v1); v.y = pack2(v2, v3);
        *(uint2*)(inner + il * 136 + j0) = v;
      }
  }
  __syncthreads();
  f32x16 acc[2][4];
#pragma unroll
  for (int rb = 0; rb < 2; ++rb)
#pragma unroll
    for (int eb = 0; eb < 4; ++eb)
#pragma unroll
      for (int i = 0; i < 16; ++i) acc[rb][eb][i] = 0.f;
#define RO_MFMA8(A0, A1, B0, B1, B2, B3) \
      acc[0][0] = MFMA(A0, B0, acc[0][0]); acc[1][0] = MFMA(A1, B0, acc[1][0]); acc[0][1] = MFMA(A0, B1, acc[0][1]); acc[1][1] = MFMA(A1, B1, acc[1][1]); \
      acc[0][2] = MFMA(A0, B2, acc[0][2]); acc[1][2] = MFMA(A1, B2, acc[1][2]); acc[0][3] = MFMA(A0, B3, acc[0][3]); acc[1][3] = MFMA(A1, B3, acc[1][3]);
  {
    const u16* ap = inner + r * 136 + h * 8;
    const u16* bp = VT + (size_t)(128 * w + r) * 8192 + h * 8;
    const int ngr = rh ? 2 : 1;
#pragma unroll 1
    for (int g = 0; g < ngr; ++g) {
      bf16x8 bb[4][4];
#pragma unroll
      for (int q = 0; q < 4; ++q)
#pragma unroll
        for (int eb = 0; eb < 4; ++eb) bb[q][eb] = *(const bf16x8*)(bp + (size_t)(32 * eb) * 8192 + (4 * g + q) * 16);
      __builtin_amdgcn_sched_barrier(0);
#pragma unroll
      for (int q = 0; q < 4; ++q) {
        const bf16x8 a0 = *(const bf16x8*)(ap + (4 * g + q) * 16), a1 = *(const bf16x8*)(ap + 32 * 136 + (4 * g + q) * 16);
        RO_MFMA8(a0, a1, bb[q][0], bb[q][1], bb[q][2], bb[q][3])
      }
    }
  }
  {
    const u16* ap = QR + (trow0 + r) * 1024 + hh * 256 + h * 8;
    const u16* bp = PT + (size_t)(128 * w + r) * 256 + h * 8;
#pragma unroll 1
    for (int g = 0; g < 4; ++g) {
      bf16x8 bb[4][4], aa[2][2];
#pragma unroll
      for (int q = 0; q < 4; ++q)
#pragma unroll
        for (int eb = 0; eb < 4; ++eb) bb[q][eb] = *(const bf16x8*)(bp + (size_t)(32 * eb) * 256 + (4 * g + q) * 16);
#pragma unroll
      for (int q = 0; q < 2; ++q) { aa[q][0] = *(const bf16x8*)(ap + (4 * g + q) * 16); aa[q][1] = *(const bf16x8*)(ap + 32 * 1024 + (4 * g + q) * 16); }
      __builtin_amdgcn_sched_barrier(0);
#pragma unroll
      for (int q = 0; q < 2; ++q) { RO_MFMA8(aa[q][0], aa[q][1], bb[q][0], bb[q][1], bb[q][2], bb[q][3]) }
#pragma unroll
      for (int q = 0; q < 2; ++q) { aa[q][0] = *(const bf16x8*)(ap + (4 * g + 2 + q) * 16); aa[q][1] = *(const bf16x8*)(ap + 32 * 1024 + (4 * g + 2 + q) * 16); }
#pragma unroll
      for (int q = 0; q < 2; ++q) { RO_MFMA8(aa[q][0], aa[q][1], bb[2 + q][0], bb[2 + q][1], bb[2 + q][2], bb[2 + q][3]) }
    }
  }
#undef RO_MFMA8
  __syncthreads();
#pragma unroll
  for (int rb = 0; rb < 2; ++rb)
#pragma unroll
    for (int reg = 0; reg < 16; ++reg) {
      float s1 = 0.f, s2 = 0.f;
#pragma unroll
      for (int eb = 0; eb < 4; ++eb) { const float v = acc[rb][eb][reg]; s1 += v; s2 += v * v; }
      const int row = 32 * rb + crow(reg, h);
      red1[row * 132 + w * 32 + r] = s1; red2[row * 132 + w * 32 + r] = s2;
    }
  __syncthreads();
  {
    const int row = t >> 2, q = t & 3;
    float s1 = 0.f, s2 = 0.f;
#pragma unroll
    for (int k = 0; k < 32; ++k) { s1 += red1[row * 132 + q * 32 + k]; s2 += red2[row * 132 + q * 32 + k]; }
    s1 += __shfl_xor(s1, 1); s2 += __shfl_xor(s2, 1);
    s1 += __shfl_xor(s1, 2); s2 += __shfl_xor(s2, 2);
    const float mu = s1 * (1.f / 512.f);
    const float var = fmaxf(s2 * (1.f / 512.f) - mu * mu, 0.f);
    if (q == 0) { smu[row] = mu; srs[row] = rsqrtf(var + GN_EPS); }
  }
  __syncthreads();
  const u16* __restrict__ GS = (const u16*)(p.ws + R_GS); u16* __restrict__ OB = (u16*)(p.ws + WS_ACT2);
#pragma unroll
  for (int rb = 0; rb < 2; ++rb)
#pragma unroll
    for (int rq = 0; rq < 4; ++rq) {
      u16 gg[4][4];
#pragma unroll
      for (int q = 0; q < 4; ++q)
#pragma unroll
        for (int eb = 0; eb < 4; ++eb) gg[q][eb] = GS[(trow0 + 32 * rb + crow(4 * rq + q, h)) * 2048 + hh * 512 + 128 * w + r + 32 * eb];
#pragma unroll
      for (int q = 0; q < 4; ++q) {
        const int reg = 4 * rq + q, row = 32 * rb + crow(reg, h);
        const float mu = smu[row], rs = srs[row];
        const size_t o = (trow0 + row) * 2048 + hh * 512 + 128 * w + r;
#pragma unroll
        for (int eb = 0; eb < 4; ++eb) OB[o + 32 * eb] = f2bf((acc[rb][eb][reg] - mu) * rs * bf2f(gg[q][eb]));
      }
    }
}

enum { PH_PREP = 0, PH_QKV, PH_ATTN, PH_AO, PH_RIN, PH_RETU, PH_SCAN, PH_RETO, PH_RO, PH_LNM, PH_FIN, PH_CONV, PH_FOUT, PH_LNF };

DI void run_phase(const Params& p, int ph, int layer, u16* lds, int vb, bool noepi = false, bool fuse_ln = false) {
  u16* hl = lds + __builtin_amdgcn_readfirstlane(tid512() >> 8) * LDS_HALF_E;
  switch (ph) {
    case PH_PREP: phase_prep(p, hl); break;
    case PH_QKV: gemm_phase<G_QKV>(p, layer, lds, vb); break;
    case PH_ATTN: phase_attn(p, layer, hl, vb); break;
    case PH_AO: gemm_phase<G_AO>(p, layer, lds, vb, false, fuse_ln); break;
    case PH_RIN: gemm_phase<G_RIN>(p, layer, lds, vb); break;
    case PH_RETU: phase_ret_u(p, layer, lds); break;
    case PH_SCAN: phase_ret_scan(p, layer); break;
    case PH_RETO: for (int item = bidx(); item < 1024; item += NVB) ret_out_item(p, item, hl); break;
    case PH_RO: gemm_phase<G_RO>(p, layer, lds, vb, false, fuse_ln); break;
    case PH_LNM: phase_ln(p, p.in[I_LMG] + layer * 1024, p.in[I_LMB] + layer * 1024, false, (layer & 1) ? 32 : 16); break;
    case PH_FIN: gemm_phase<G_FIN>(p, layer, lds, vb, noepi); break;
    case PH_CONV: phase_conv(p, layer); break;
    case PH_FOUT: gemm_phase<G_FOUT>(p, layer, lds, vb, false, fuse_ln); break;
    case PH_LNF: phase_ln(p, p.in[I_LFG] + layer * 1024, p.in[I_LFB] + layer * 1024, layer == 3, 44); break;
  }
}

#if !MEGA
__global__ void __launch_bounds__(512, 2) k_phase(Params p, int ph, int layer) {
  __shared__ __attribute__((aligned(16))) u16 lds[LDS_BYTES / 2];
  run_phase(p, ph, layer, lds, (int)blockIdx.x);
}

#else
#ifndef PROBE_MASK
#define PROBE_MASK 0
#endif
#ifndef PROBE_NOEPI
#define PROBE_NOEPI 0
#endif
__global__ void __launch_bounds__(512, 2) k_mega(Params p) {
  __shared__ __attribute__((aligned(16))) u16 lds[LDS_BYTES / 2];
  __shared__ uint4 xb_words;
  cg::grid_group grid = cg::this_grid();
  if (__builtin_amdgcn_workitem_id_x() == 0) xb_words = make_uint4(0u, 0u, 0u, (unsigned)__builtin_amdgcn_workgroup_id_x());
  __syncthreads();
  XcdBarrier xb = xcd_barrier_post((unsigned*)(p.ws + WS_BAR), (volatile LAS unsigned*)&xb_words);
  {
    Params q = p;
    asm volatile("" : "+s"(q.out)); asm volatile("" : "+s"(q.ws));
    const int rep0 = ((PROBE_MASK >> PH_PREP) & 1) ? 2 : 1;
    for (int rr = 0; rr < rep0; ++rr) run_phase(q, PH_PREP, 0, lds, 0);
    if (p.ws == nullptr) grid.sync();
    xcd_barrier(xb);
    if (__builtin_amdgcn_workitem_id_x() == 0) {
      unsigned* bar = (unsigned*)(p.ws + WS_BAR);
      const unsigned G = gridDim.x;
      unsigned cnt = 0u, mine = 0u, dense = 0u; bool uni = true;
#pragma unroll
      for (unsigned j = 0; j < 16; ++j) {
        const unsigned c = xb_ld(&bar[XB_XCNT(j)]);
        cnt += (c > 0u) ? 1u : 0u; mine = (j == xb.x) ? c : mine; dense += (j < xb.x && c > 0u) ? 1u : 0u;
        uni = uni && (c == 0u || c * 8u == G);
      }
      const unsigned rank = xb_words.z;
      xb_words.x = mine > 0u ? mine : 1u; xb_words.y = cnt > 0u ? cnt : 1u;
      xb_words.w = (uni && cnt == 8u && rank < (G >> 3)) ? dense * (G >> 3) + rank : (unsigned)__builtin_amdgcn_workgroup_id_x();
    }
    __syncthreads();
  }
#pragma unroll 1
  for (int step = 1; step < 29; ++step) {
    int ph, layer, idx;
    {
      const int s = step - 1;
      if (s < 6) { layer = 0; idx = s; } else if (s < 14) { layer = 1; idx = s - 6; } else if (s < 20) { layer = 2; idx = s - 14; } else { layer = 3; idx = s - 20; }
      if (layer & 1) ph = (idx < 5) ? (PH_RIN + idx) : (PH_FIN + idx - 5);
      else ph = (idx < 3) ? (PH_QKV + idx) : (PH_FIN + idx - 3);
    }
    Params q = p;
#pragma unroll
    for (int i = 0; i < 19; ++i) asm volatile("" : "+s"(q.in[i]));
    asm volatile("" : "+s"(q.out)); asm volatile("" : "+s"(q.ws));
    const int rep = ((PROBE_MASK >> ph) & 1) ? 2 : 1;
    const int vb = (int)xb_words.w;
    for (int rr = 0; rr < rep; ++rr) run_phase(q, ph, layer, lds, vb, PROBE_NOEPI && rr > 0, true);
    if (step < 28) xcd_barrier(xb);
  }
}
#endif

extern "C" void kernel_launch(void* const* d_in, const int* in_sizes, int n_in, void* d_out, int out_size, void* d_ws, size_t ws_size, hipStream_t stream) {
  static int grid_blocks = 0;
  if (!grid_blocks) {
    int dev = 0, cus = 0, per_cu = 0;
    (void)hipGetDevice(&dev);
    (void)hipDeviceGetAttribute(&cus, hipDeviceAttributeMultiprocessorCount, dev);
#if MEGA
    (void)hipOccupancyMaxActiveBlocksPerMultiprocessor(&per_cu, k_mega, 512, 0);
#else
    (void)hipOccupancyMaxActiveBlocksPerMultiprocessor(&per_cu, k_phase, 512, 0);
#endif
    if (per_cu < 1) per_cu = 1;
    if (per_cu > 1) per_cu = 1;
    grid_blocks = cus * per_cu;
    if (n_in != 19 || ws_size < WS_END) fprintf(stderr, "kernel_launch: unexpected n_in %d or ws %zu < %zu\n", n_in, ws_size, (size_t)WS_END);
  }
  Params p{};
  for (int i = 0; i < 19; ++i) p.in[i] = (const float*)d_in[i];
  p.out = (float*)d_out; p.ws = (unsigned char*)d_ws;
#if MEGA
  (void)hipMemsetAsync((unsigned char*)d_ws + WS_BAR, 0, 16384, stream);
  void* args[] = {&p};
  hipError_t e = hipLaunchCooperativeKernel((void*)k_mega, dim3(grid_blocks), dim3(512), args, 0, stream);
  if (e != hipSuccess) fprintf(stderr, "cooperative launch failed: %s (grid %d)\n", hipGetErrorString(e), grid_blocks);
#else
  auto L = [&](int ph, int layer) { hipLaunchKernelGGL(k_phase, dim3(grid_blocks), dim3(512), 0, stream, p, ph, layer); };
  L(PH_PREP, 0);
  for (int layer = 0; layer < 4; ++layer) {
    if ((layer & 1) == 0) { L(PH_QKV, layer); L(PH_ATTN, layer); L(PH_AO, layer); }
    else { L(PH_RIN, layer); L(PH_RETU, layer); L(PH_SCAN, layer); L(PH_RETO, layer); L(PH_RO, layer); }
    L(PH_LNM, layer); L(PH_FIN, layer); L(PH_CONV, layer); L(PH_FOUT, layer); L(PH_LNF, layer);
  }
#endif
}
```

```cpp
#include <hip/hip_runtime.h>
#include <hip/hip_cooperative_groups.h>
#include <cstdio>
namespace cg = cooperative_groups;

#ifndef MEGA
#define MEGA 1
#endif

typedef unsigned short u16;
using f32x4 = __attribute__((ext_vector_type(4))) float;
using bf16x8 = __attribute__((ext_vector_type(8))) short;
using f32x16 = __attribute__((ext_vector_type(16))) float;
#define DI __device__ __forceinline__
#define MFMA(a, b, c) __builtin_amdgcn_mfma_f32_32x32x16_bf16((a), (b), (c), 0, 0, 0)

constexpr int D = 1024, SEQ = 8192, MP = 16384, MS = 128, MT = MP + MS;
constexpr int DFF = 2816;
constexpr float ALPHA = 1.6817928305074290f;
constexpr float LN_EPS = 1e-5f, GN_EPS = 1e-5f;

constexpr size_t O_YP = 0;
constexpr size_t O_YS = O_YP + (size_t)MP * D;
constexpr size_t O_KWP = O_YS + (size_t)MS * D;
constexpr size_t O_VWP = O_KWP + 2ull * 2 * 128 * 256;
constexpr size_t O_RSP = O_VWP + 2ull * 2 * 128 * 256;
constexpr size_t O_CSP = O_RSP + 2ull * 2 * 4 * 256 * 512;
constexpr size_t O_KWS = O_CSP + 4ull * 2 * 2 * DFF;
constexpr size_t O_VWS = O_KWS + 2ull * 128 * 128 * 256;
constexpr size_t O_RSS = O_VWS + 2ull * 128 * 128 * 256;
constexpr size_t O_CSS = O_RSS + 2ull * 128 * 4 * 256 * 512;

constexpr size_t al(size_t x) { return (x + 255) & ~size_t(255); }
constexpr size_t WS_WQKV = 0;
constexpr size_t WS_WAO = WS_WQKV + 2ull * 1536 * 1024 * 2;
constexpr size_t WS_WRIN = WS_WAO + 2ull * 1024 * 1024 * 2;
constexpr size_t WS_WRO = WS_WRIN + 2ull * 6144 * 1024 * 2;
constexpr size_t WS_WFIN = WS_WRO + 2ull * 1024 * 2048 * 2;
constexpr size_t WS_WFOUT = WS_WFIN + 4ull * 5632 * 1024 * 2;
constexpr size_t WS_TROPE = WS_WFOUT + 4ull * 1024 * 2816 * 2;
constexpr size_t WS_TRET = WS_TROPE + al(2ull * 8193 * 32 * 4);
constexpr size_t WS_X = WS_TRET + al(2ull * 8193 * 128 * 4);
constexpr size_t WS_XB = WS_X + (size_t)MT * 1024 * 4;
constexpr size_t WS_Y = WS_XB + (size_t)MT * 1024 * 2;
constexpr size_t WS_ACT = WS_Y + (size_t)MT * 1024 * 4;
constexpr size_t WS_ACT2 = WS_ACT + 268435456ull;
constexpr size_t WS_US = WS_ACT2 + (size_t)MT * 2816 * 2;
constexpr size_t WS_SMP = WS_US + 134217728ull;
constexpr size_t WS_BAR = WS_SMP + 128ull * 4096 * 4;
constexpr size_t WS_PART = WS_BAR + 16384;
constexpr size_t WS_PART2 = WS_PART + 4ull * 44 * 128 * 256 * 4;
constexpr size_t WS_END = WS_PART2 + 24ull * 16 * 128 * 256 * 4;
constexpr size_t A_Q = WS_ACT;
constexpr size_t A_K = A_Q + (size_t)MT * 1024 * 2;
constexpr size_t A_VT = A_K + (size_t)MP * 256 * 2;
constexpr size_t R_Q = WS_ACT;
constexpr size_t R_K = R_Q + (size_t)MT * 1024 * 2;
constexpr size_t R_KT = R_K + (size_t)MT * 1024 * 2;
constexpr size_t R_VT = R_KT + 2ull * 1024 * 8192 * 2;
constexpr size_t R_GS = R_VT + 2ull * 2048 * 8192 * 2;
static_assert(R_GS + (size_t)MT * 2048 * 2 <= WS_ACT2, "act region");
constexpr size_t F_UA = WS_ACT;
constexpr size_t F_UG = F_UA + (size_t)MT * 2816 * 2;

struct Params {
  const float* in[19];
  float* out;
  unsigned char* ws;
};
enum { I_XP = 0, I_XS, I_CK, I_CV, I_SR, I_SC, I_WQKV, I_SINK, I_WAO, I_WRIN, I_WRO, I_WFIN, I_CW, I_CB, I_WFOUT, I_LMG, I_LMB, I_LFG, I_LFB };

DI int tid512() { int t = __builtin_amdgcn_workitem_id_x(); asm volatile("" : "+v"(t)); return t; }
DI int bid_real() { int b = __builtin_amdgcn_workgroup_id_x(); asm volatile("" : "+s"(b)); return b; }
DI int tidx() { return tid512() & 255; }
DI int bidx() { return 2 * bid_real() + __builtin_amdgcn_readfirstlane(tid512() >> 8); }
#define NVB (2 * (int)gridDim.x)
DI u16 f2bf(float x) { return __builtin_bit_cast(u16, (__bf16)x); }
DI float bf2f(u16 v) { return __uint_as_float(((unsigned)v) << 16); }
DI unsigned pack2(float a, float b) { return (unsigned)f2bf(a) | ((unsigned)f2bf(b) << 16); }
DI int crow(int reg, int h) { return (reg & 3) + 8 * (reg >> 2) + 4 * h; }
DI float silu(float x) { return x / (1.f + __expf(-x)); }
DI float lg2gamma(int hh) { return hh == 0 ? -0.04580368961312479f : hh == 1 ? -0.02272007650008353f : hh == 2 ? -0.011315313227834146f : -0.005646563141142063f; }

DI float wave_max(float v) {
#pragma unroll
  for (int o = 32; o >= 1; o >>= 1) v = fmaxf(v, __shfl_xor(v, o));
  return v;
}
DI float wave_sum(float v) {
#pragma unroll
  for (int o = 32; o >= 1; o >>= 1) v += __shfl_xor(v, o);
  return v;
}

DI void sincos_d(double x, float& s, float& c) {
  const double n = rint(x * 0.63661977236758134308);
  double r = fma(-n, 1.57079632673412561417e+00, x);
  r = fma(-n, 6.07710050650619224932e-11, r);
  const double r2 = r * r;
  double sp = 1.0 / 6227020800.0;
  sp = fma(sp, r2, -1.0 / 39916800.0); sp = fma(sp, r2, 1.0 / 362880.0); sp = fma(sp, r2, -1.0 / 5040.0);
  sp = fma(sp, r2, 1.0 / 120.0); sp = fma(sp, r2, -1.0 / 6.0); sp = fma(sp, r2, 1.0);
  const double sn = sp * r;
  double cp = -1.0 / 87178291200.0;
  cp = fma(cp, r2, 1.0 / 479001600.0); cp = fma(cp, r2, -1.0 / 3628800.0); cp = fma(cp, r2, 1.0 / 40320.0);
  cp = fma(cp, r2, -1.0 / 720.0); cp = fma(cp, r2, 1.0 / 24.0); cp = fma(cp, r2, -0.5); cp = fma(cp, r2, 1.0);
  const int q = ((int)n) & 3;
  const double ss = (q & 1) ? cp : sn, cc = (q & 1) ? sn : cp;
  s = (float)((q == 2 || q == 3) ? -ss : ss);
  c = (float)((q == 1 || q == 2) ? -cc : cc);
}

constexpr int LSTR = 72;
constexpr int TILE_E = 256 * LSTR;
constexpr int LDS_BYTES = 4 * TILE_E * 2;
constexpr int LDS_HALF_E = LDS_BYTES / 4;

DI void gemm_core(const u16* __restrict__ A, size_t lda, const u16* __restrict__ Bt, size_t ldb, int K, u16* lds, f32x16 (&acc)[4][2]) {
  const int t = tid512(), lane = t & 63, w = t >> 6, wm = w >> 2, wn = w & 3, r = lane & 31, h = lane >> 5;
  u16* As = lds; u16* Bs = lds + 2 * TILE_E;
  const int lrow = t >> 3, lk = (t & 7) * 8;
  const u16* Ag = A + (size_t)lrow * lda + lk;
  const u16* Bg = Bt + (size_t)lrow * ldb + lk;
#define GLOAD(P, ko) \
  P##a0 = *(const uint4*)(Ag + (ko)); P##a1 = *(const uint4*)(Ag + (size_t)64 * lda + (ko)); P##a2 = *(const uint4*)(Ag + (size_t)128 * lda + (ko)); P##a3 = *(const uint4*)(Ag + (size_t)192 * lda + (ko)); \
  P##b0 = *(const uint4*)(Bg + (ko)); P##b1 = *(const uint4*)(Bg + (size_t)64 * ldb + (ko)); P##b2 = *(const uint4*)(Bg + (size_t)128 * ldb + (ko)); P##b3 = *(const uint4*)(Bg + (size_t)192 * ldb + (ko));
#define LSTORE(P, buf) { u16* ad_ = As + (buf) * TILE_E + lrow * LSTR + lk; u16* bd_ = Bs + (buf) * TILE_E + lrow * LSTR + lk; \
  *(uint4*)(ad_) = P##a0; *(uint4*)(ad_ + 64 * LSTR) = P##a1; *(uint4*)(ad_ + 128 * LSTR) = P##a2; *(uint4*)(ad_ + 192 * LSTR) = P##a3; \
  *(uint4*)(bd_) = P##b0; *(uint4*)(bd_ + 64 * LSTR) = P##b1; *(uint4*)(bd_ + 128 * LSTR) = P##b2; *(uint4*)(bd_ + 192 * LSTR) = P##b3; }
#define COMPUTE(buf) { \
    const u16* as = As + (buf) * TILE_E + (wm * 128 + r) * LSTR + h * 8; \
    const u16* bs = Bs + (buf) * TILE_E + (wn * 64 + r) * LSTR + h * 8; \
    _Pragma("unroll") for (int kk = 0; kk < 4; ++kk) { \
      const bf16x8 b0 = *(const bf16x8*)(bs + kk * 16), b1 = *(const bf16x8*)(bs + 32 * LSTR + kk * 16); \
      _Pragma("unroll") for (int mi = 0; mi < 4; ++mi) { \
        const bf16x8 a = *(const bf16x8*)(as + mi * 32 * LSTR + kk * 16); \
        acc[mi][0] = MFMA(a, b0, acc[mi][0]); acc[mi][1] = MFMA(a, b1, acc[mi][1]); } } }
  uint4 pa0, pa1, pa2, pa3, pb0, pb1, pb2, pb3;
  const int nk = K >> 6;
  {
    uint4 qa0, qa1, qa2, qa3, qb0, qb1, qb2, qb3;
    GLOAD(q, 0)
    if (nk > 1) { GLOAD(p, 64) }
    __syncthreads();
    LSTORE(q, 0)
  }
#pragma unroll
  for (int a = 0; a < 4; ++a)
#pragma unroll
    for (int b = 0; b < 2; ++b)
#pragma unroll
      for (int i = 0; i < 16; ++i) acc[a][b][i] = 0.f;
  __syncthreads();
#pragma unroll 1
  for (int kt = 0; kt < nk; ++kt) {
    const int buf = kt & 1;
    if (kt + 1 < nk) LSTORE(p, buf ^ 1)
    if (kt + 2 < nk) { const int ko = (kt + 2) << 6; GLOAD(p, ko) }
    __builtin_amdgcn_sched_barrier(0);
    COMPUTE(buf)
    __syncthreads();
  }
#undef COMPUTE
#undef GLOAD
#undef LSTORE
}

DI void epi_qkv(const Params& p, int j, f32x16 (&acc)[2][2], int mb, int nb, int lane) {
  const int r = lane & 31, h = lane >> 5, slot = nb >> 6;
  const float* cosT = (const float*)(p.ws + WS_TROPE); const float* sinT = cosT + 8193 * 32;
  const bool smp = mb >= MP;
  if (slot < 20) {
    u16* Q = (u16*)(p.ws + A_Q); u16* KB = (u16*)(p.ws + A_K);
#pragma unroll
    for (int mi = 0; mi < 2; ++mi) {
      float cc[16], ss[16];
#pragma unroll
      for (int reg = 0; reg < 16; ++reg) {
        const int row = mb + mi * 32 + crow(reg, h);
        const int pos = smp ? 8192 : (row & 8191);
        cc[reg] = cosT[pos * 32 + r]; ss[reg] = sinT[pos * 32 + r];
      }
#pragma unroll
      for (int reg = 0; reg < 16; ++reg) {
        const int row = mb + mi * 32 + crow(reg, h);
        const int pos = smp ? 8192 : (row & 8191);
        const float c = cc[reg], s = ss[reg];
        const float x1 = acc[mi][0][reg], x2 = acc[mi][1][reg];
        const float o1 = x1 * c - x2 * s, o2 = x2 * c + x1 * s;
        if (slot < 16) {
          Q[(size_t)row * 1024 + nb + r] = f2bf(o1 * 0.125f); Q[(size_t)row * 1024 + nb + 32 + r] = f2bf(o2 * 0.125f);
        } else {
          const int kvh = slot - 16;
          if (!smp) {
            KB[(size_t)row * 256 + kvh * 64 + r] = f2bf(o1); KB[(size_t)row * 256 + kvh * 64 + 32 + r] = f2bf(o2);
            if (pos >= 8064) { const int b = row >> 13; float* o = p.out + O_KWP + ((size_t)((j * 2 + b) * 128 + (pos - 8064)) * 4 + kvh) * 64; o[r] = o1; o[32 + r] = o2; }
          } else {
            const int b = row - MP; float* o = p.out + O_KWS + ((size_t)((j * 128 + b) * 128 + 127) * 4 + kvh) * 64; o[r] = o1; o[32 + r] = o2;
          }
        }
      }
    }
  } else {
    const int kvh = slot - 20;
    if (!smp) {
      u16* VT = (u16*)(p.ws + A_VT);
      const int b = mb >> 13;
#pragma unroll
      for (int mi = 0; mi < 2; ++mi)
#pragma unroll
        for (int ni = 0; ni < 2; ++ni)
#pragma unroll
          for (int g4 = 0; g4 < 4; ++g4) {
            const int t0 = (mb & 8191) + mi * 32 + 8 * g4 + 4 * h, d = ni * 32 + r;
            uint2 v; v.x = pack2(acc[mi][ni][4 * g4], acc[mi][ni][4 * g4 + 1]); v.y = pack2(acc[mi][ni][4 * g4 + 2], acc[mi][ni][4 * g4 + 3]);
            *(uint2*)(VT + (size_t)(b * 256 + kvh * 64 + d) * 8192 + t0) = v;
            if (t0 >= 8064) {
#pragma unroll
              for (int q = 0; q < 4; ++q) p.out[O_VWP + ((size_t)((j * 2 + b) * 128 + (t0 + q - 8064)) * 4 + kvh) * 64 + d] = acc[mi][ni][4 * g4 + q];
            }
          }
    } else {
#pragma unroll
      for (int mi = 0; mi < 2; ++mi)
#pragma unroll
        for (int ni = 0; ni < 2; ++ni)
#pragma unroll
          for (int reg = 0; reg < 16; ++reg) {
            const int b = mb - MP + mi * 32 + crow(reg, h);
            p.out[O_VWS + ((size_t)((j * 128 + b) * 128 + 127) * 4 + kvh) * 64 + ni * 32 + r] = acc[mi][ni][reg];
          }
    }
  }
}

DI void epi_res(const Params& p, f32x16 (&acc)[2][2], int mb, int nb, int lane) {
  const int r = lane & 31, h = lane >> 5;
  const float* __restrict__ X = (const float*)(p.ws + WS_X); float* __restrict__ Y = (float*)(p.ws + WS_Y);
#pragma unroll
  for (int mi = 0; mi < 2; ++mi) {
    float xv[2][16];
#pragma unroll
    for (int ni = 0; ni < 2; ++ni)
#pragma unroll
      for (int reg = 0; reg < 16; ++reg) xv[ni][reg] = X[(size_t)(mb + mi * 32 + crow(reg, h)) * 1024 + nb + ni * 32 + r];
#pragma unroll
    for (int ni = 0; ni < 2; ++ni)
#pragma unroll
      for (int reg = 0; reg < 16; ++reg) Y[(size_t)(mb + mi * 32 + crow(reg, h)) * 1024 + nb + ni * 32 + r] = ALPHA * xv[ni][reg] + acc[mi][ni][reg];
  }
}

DI void epi_rin(const Params& p, int j, f32x16 (&acc)[2][2], int mb, int nb, int lane) {
  const int r = lane & 31, h = lane >> 5, slot = nb >> 6;
  const bool smp = mb >= MP;
  const int b = mb >> 13;
  if (slot < 32) {
    const bool isq = slot < 16;
    const int hh = (slot & 15) >> 2, cbase = nb & 255, ncol = nb & 1023;
    const float lg = lg2gamma(hh);
    const float* cosR = (const float*)(p.ws + WS_TRET); const float* sinR = cosR + 8193 * 128;
#pragma unroll
    for (int mi = 0; mi < 2; ++mi)
#pragma unroll
      for (int ni = 0; ni < 2; ++ni) {
        const int pidx = (cbase + ni * 32 + r) >> 1;
        float cc[16], ss[16];
#pragma unroll
        for (int reg = 0; reg < 16; ++reg) {
          const int row = mb + mi * 32 + crow(reg, h);
          const int pos = smp ? 8192 : (row & 8191);
          cc[reg] = cosR[pos * 128 + pidx]; ss[reg] = sinR[pos * 128 + pidx];
        }
#pragma unroll
        for (int reg = 0; reg < 16; ++reg) {
          const int row = mb + mi * 32 + crow(reg, h);
          const int pos = smp ? 8192 : (row & 8191);
          const float mine = acc[mi][ni][reg], other = __shfl_xor(mine, 1);
          const float rot = (r & 1) ? (mine * cc[reg] + other * ss[reg]) : (mine * cc[reg] - other * ss[reg]);
          const float e = (float)((smp ? 0 : (pos & 127)) + 1) * lg;
          acc[mi][ni][reg] = isq ? rot * exp2f(e) : rot * 0.0625f * exp2f(-e);
        }
        __builtin_amdgcn_sched_barrier(0);
      }
    if (smp) {
      float* S = (float*)(p.ws + WS_SMP) + (isq ? 0 : 128 * 1024);
#pragma unroll
      for (int mi = 0; mi < 2; ++mi)
#pragma unroll
        for (int ni = 0; ni < 2; ++ni)
#pragma unroll
          for (int reg = 0; reg < 16; ++reg)
            S[(size_t)(mb - MP + mi * 32 + crow(reg, h)) * 1024 + ncol + ni * 32 + r] = acc[mi][ni][reg];
    } else {
      u16* N = (u16*)(p.ws + (isq ? R_Q : R_K));
#pragma unroll
      for (int mi = 0; mi < 2; ++mi)
#pragma unroll
        for (int ni = 0; ni < 2; ++ni)
#pragma unroll
          for (int reg = 0; reg < 16; ++reg)
            N[(size_t)(mb + mi * 32 + crow(reg, h)) * 1024 + ncol + ni * 32 + r] = f2bf(acc[mi][ni][reg]);
      if (!isq) {
        u16* KT = (u16*)(p.ws + R_KT);
#pragma unroll
        for (int mi = 0; mi < 2; ++mi)
#pragma unroll
          for (int ni = 0; ni < 2; ++ni)
#pragma unroll
            for (int g4 = 0; g4 < 4; ++g4) {
              const int t0 = (mb & 8191) + mi * 32 + 8 * g4 + 4 * h;
              uint2 v; v.x = pack2(acc[mi][ni][4 * g4], acc[mi][ni][4 * g4 + 1]); v.y = pack2(acc[mi][ni][4 * g4 + 2], acc[mi][ni][4 * g4 + 3]);
              *(uint2*)(KT + (size_t)(b * 1024 + ncol + ni * 32 + r) * 8192 + t0) = v;
            }
      }
    }
  } else if (slot < 64) {
    const int cv = nb - 2048;
    if (smp) {
      float* SV = (float*)(p.ws + WS_SMP) + 2 * 128 * 1024;
#pragma unroll
      for (int mi = 0; mi < 2; ++mi)
#pragma unroll
        for (int ni = 0; ni < 2; ++ni)
#pragma unroll
          for (int reg = 0; reg < 16; ++reg)
            SV[(size_t)(mb - MP + mi * 32 + crow(reg, h)) * 2048 + cv + ni * 32 + r] = acc[mi][ni][reg];
    } else {
      u16* VT = (u16*)(p.ws + R_VT);
#pragma unroll
      for (int mi = 0; mi < 2; ++mi)
#pragma unroll
        for (int ni = 0; ni < 2; ++ni)
#pragma unroll
          for (int g4 = 0; g4 < 4; ++g4) {
            const int t0 = (mb & 8191) + mi * 32 + 8 * g4 + 4 * h;
            uint2 v; v.x = pack2(acc[mi][ni][4 * g4], acc[mi][ni][4 * g4 + 1]); v.y = pack2(acc[mi][ni][4 * g4 + 2], acc[mi][ni][4 * g4 + 3]);
            *(uint2*)(VT + (size_t)(b * 2048 + cv + ni * 32 + r) * 8192 + t0) = v;
          }
    }
  } else {
    u16* GS = (u16*)(p.ws + R_GS);
    const int cg_ = nb - 4096;
#pragma unroll
    for (int mi = 0; mi < 2; ++mi)
#pragma unroll
      for (int ni = 0; ni < 2; ++ni)
#pragma unroll
        for (int reg = 0; reg < 16; ++reg)
          GS[(size_t)(mb + mi * 32 + crow(reg, h)) * 2048 + cg_ + ni * 32 + r] = f2bf(silu(acc[mi][ni][reg]));
  }
}

DI void epi_fin(const Params& p, int i, f32x16 (&acc)[2][2], int mb, int nb, int lane) {
  const int r = lane & 31, h = lane >> 5;
  const bool smp = mb >= MP;
  if (nb < DFF) {
    u16* UA = (u16*)(p.ws + F_UA);
#pragma unroll
    for (int mi = 0; mi < 2; ++mi)
#pragma unroll
      for (int ni = 0; ni < 2; ++ni)
#pragma unroll
        for (int reg = 0; reg < 16; ++reg) {
          const int row = mb + mi * 32 + crow(reg, h), col = nb + ni * 32 + r;
          const float v = acc[mi][ni][reg];
          UA[(size_t)row * DFF + col] = f2bf(v);
          if (smp) {
            p.out[O_CSS + ((size_t)(i * 128 + (row - MP)) * 2 + 1) * DFF + col] = v;
          } else {
            const int pos = row & 8191;
            if (pos >= 8190) p.out[O_CSP + ((size_t)(i * 2 + (row >> 13)) * 2 + (pos - 8190)) * DFF + col] = v;
          }
        }
  } else {
    u16* UG = (u16*)(p.ws + F_UG);
#pragma unroll
    for (int mi = 0; mi < 2; ++mi)
#pragma unroll
      for (int ni = 0; ni < 2; ++ni)
#pragma unroll
        for (int reg = 0; reg < 16; ++reg)
          UG[(size_t)(mb + mi * 32 + crow(reg, h)) * DFF + (nb - DFF) + ni * 32 + r] = f2bf(acc[mi][ni][reg]);
  }
}

#define XB_TMO      128
#define XB_XCNT(j)  (256  + 64 * (j))
#define XB_XSUB(j)  (1280 + 64 * (j))
#define XB_XGEN(j)  (2304 + 64 * (j))
#define XB_TOP      3328
#define XB_TOPGEN   3392
#define XCD_BAR_WORDS 3456
#define XB_SPIN_CAP (1u << 20)
#define LAS __attribute__((address_space(3)))
DI unsigned xb_ld(unsigned* p) { return __hip_atomic_load(p, __ATOMIC_RELAXED, __HIP_MEMORY_SCOPE_AGENT); }
DI unsigned xb_add(unsigned* p, unsigned v) { return __hip_atomic_fetch_add(p, v, __ATOMIC_RELAXED, __HIP_MEMORY_SCOPE_AGENT); }
DI unsigned xb_xcc_id() { return (unsigned)__builtin_amdgcn_s_getreg((3 << 11) | 20) & 0xFu; }
#define XB_SPIN(cond, bar) do { unsigned _sp = 0; while (cond) { __builtin_amdgcn_s_sleep(1); \
    if ((++_sp & 255u) == 0u) { if (xb_ld(&(bar)[XB_TMO])) break; if (_sp > XB_SPIN_CAP) { atomicAdd(&(bar)[XB_TMO], 1u); break; } } } } while (0)
struct XcdBarrier { unsigned* bar; unsigned x; volatile LAS unsigned* st; };
DI XcdBarrier xcd_barrier_post(unsigned* bar, volatile LAS unsigned* st) {
  XcdBarrier b; b.bar = bar; b.x = xb_xcc_id(); b.st = st;
  if (__builtin_amdgcn_workitem_id_x() == 0) st[2] = xb_add(&bar[XB_XCNT(b.x)], 1u);
  return b;
}
DI void xcd_barrier_complete(unsigned* bar, unsigned x, unsigned& nloc, unsigned& nx) {
  const unsigned G = gridDim.x;
  unsigned sum, cnt, mine, sp = 0u;
  for (;;) {
    sum = 0u; cnt = 0u; mine = 0u;
#pragma unroll
    for (unsigned j = 0; j < 16; ++j) { const unsigned c = xb_ld(&bar[XB_XCNT(j)]); sum += c; cnt += (c > 0u) ? 1u : 0u; mine = (j == x) ? c : mine; }
    if (sum == G) break;
    __builtin_amdgcn_s_sleep(1);
    if ((++sp & 255u) == 0u) { if (xb_ld(&bar[XB_TMO])) break; if (sp > XB_SPIN_CAP) { atomicAdd(&bar[XB_TMO], 1u); break; } }
  }
  nloc = mine > 0u ? mine : 1u; nx = cnt > 0u ? cnt : 1u;
}
DI void xcd_barrier(const XcdBarrier& b) {
  asm volatile("s_waitcnt vmcnt(0)" ::: "memory");
  __syncthreads();
  if (__builtin_amdgcn_workitem_id_x() == 0) {
    unsigned* bar = b.bar;
    __builtin_amdgcn_s_waitcnt(0);
    unsigned nloc = b.st[0], nx = b.st[1];
    if (nloc == 0u) { xcd_barrier_complete(bar, b.x, nloc, nx); b.st[0] = nloc; b.st[1] = nx; }
    const unsigned old = xb_add(&bar[XB_XSUB(b.x)], 1u);
    const unsigned gen = old / nloc;
    if (old + 1u == (gen + 1u) * nloc) {
      __builtin_amdgcn_fence(__ATOMIC_RELEASE, "agent");
      asm volatile("s_waitcnt vmcnt(0)" ::: "memory");
      const unsigned og = xb_add(&bar[XB_TOP], 1u);
      const unsigned tg = og / nx;
      if (og + 1u == (tg + 1u) * nx) xb_add(&bar[XB_TOPGEN], 1u);
      else XB_SPIN(xb_ld(&bar[XB_TOPGEN]) == tg, bar);
      __builtin_amdgcn_fence(__ATOMIC_ACQUIRE, "agent");
      xb_add(&bar[XB_XGEN(b.x)], 1u);
      asm volatile("s_waitcnt vmcnt(0)" ::: "memory");
    } else {
      XB_SPIN(xb_ld(&bar[XB_XGEN(b.x)]) == gen, bar);
      __builtin_amdgcn_fence(__ATOMIC_ACQUIRE, "agent");
      asm volatile("s_waitcnt vmcnt(0)" ::: "memory");
    }
  }
  __syncthreads();
}

DI void signal_cnt(unsigned* c) {
  asm volatile("s_waitcnt vmcnt(0)" ::: "memory");
  __syncthreads();
  if (__builtin_amdgcn_workitem_id_x() == 0) { __builtin_amdgcn_fence(__ATOMIC_RELEASE, "agent"); asm volatile("s_waitcnt vmcnt(0)" ::: "memory"); (void)xb_add(c, 1u); }
}
DI void wait_cnt(unsigned* c, unsigned target, unsigned* bar) {
  if (__builtin_amdgcn_workitem_id_x() == 0) { XB_SPIN(xb_ld(c) < target, bar); __builtin_amdgcn_fence(__ATOMIC_ACQUIRE, "agent"); asm volatile("s_waitcnt vmcnt(0)" ::: "memory"); }
  __syncthreads();
}
constexpr int LN_CNT_WORD0 = XCD_BAR_WORDS;

DI void ln_row(const Params& p, int row, const float4 (&gv)[4], const float4 (&bv)[4], bool last, int nkk, int lane) {
  const float* Y = (const float*)(p.ws + WS_Y);
  float* X = (float*)(p.ws + WS_X); u16* XB = (u16*)(p.ws + WS_XB);
  float4 v[4];
  if (row < MP) {
    const float4* y = (const float4*)(Y + (size_t)row * 1024);
#pragma unroll
    for (int i = 0; i < 4; ++i) v[i] = y[lane + 64 * i];
  } else {
    const float4* x = (const float4*)(X + (size_t)row * 1024);
#pragma unroll
    for (int i = 0; i < 4; ++i) { const float4 t = x[lane + 64 * i]; v[i].x = ALPHA * t.x; v[i].y = ALPHA * t.y; v[i].z = ALPHA * t.z; v[i].w = ALPHA * t.w; }
    const float* __restrict__ PART = (const float*)(p.ws + WS_PART);
    for (int ks = 0; ks < nkk; ks += 4) {
      float4 t[4][4];
#pragma unroll
      for (int u = 0; u < 4; ++u)
#pragma unroll
        for (int i = 0; i < 4; ++i)
          t[u][i] = *(const float4*)(PART + ((size_t)(i * nkk + ks + u) * 128 + (row - MP)) * 256 + lane * 4);
#pragma unroll
      for (int u = 0; u < 4; ++u)
#pragma unroll
        for (int i = 0; i < 4; ++i) { v[i].x += t[u][i].x; v[i].y += t[u][i].y; v[i].z += t[u][i].z; v[i].w += t[u][i].w; }
    }
  }
  float sm = 0.f;
#pragma unroll
  for (int i = 0; i < 4; ++i) sm += v[i].x + v[i].y + v[i].z + v[i].w;
  const float mu = wave_sum(sm) * (1.f / 1024.f);
  float q = 0.f;
#pragma unroll
  for (int i = 0; i < 4; ++i) { v[i].x -= mu; v[i].y -= mu; v[i].z -= mu; v[i].w -= mu; q += v[i].x * v[i].x + v[i].y * v[i].y + v[i].z * v[i].z + v[i].w * v[i].w; }
  const float rs = rsqrtf(wave_sum(q) * (1.f / 1024.f) + LN_EPS);
  float4* xo = last ? (float4*)(p.out + (row < MP ? O_YP + (size_t)row * 1024 : O_YS + (size_t)(row - MP) * 1024)) : (float4*)(X + (size_t)row * 1024);
#pragma unroll
  for (int i = 0; i < 4; ++i) {
    float4 o;
    o.x = v[i].x * rs * gv[i].x + bv[i].x; o.y = v[i].y * rs * gv[i].y + bv[i].y;
    o.z = v[i].z * rs * gv[i].z + bv[i].z; o.w = v[i].w * rs * gv[i].w + bv[i].w;
    xo[lane + 64 * i] = o;
    if (!last) { uint2 ob; ob.x = pack2(o.x, o.y); ob.y = pack2(o.z, o.w); *(uint2*)(XB + (size_t)row * 1024 + (lane + 64 * i) * 4) = ob; }
  }
}
DI void ln_rows4(const Params& p, int row0, const float4 (&gv)[4], const float4 (&bv)[4], bool last, int lane) {
  const float* Y = (const float*)(p.ws + WS_Y);
  float* X = (float*)(p.ws + WS_X); u16* XB = (u16*)(p.ws + WS_XB);
  float4 v[4][4];
#pragma unroll
  for (int q = 0; q < 4; ++q)
#pragma unroll
    for (int i = 0; i < 4; ++i) v[q][i] = ((const float4*)(Y + (size_t)(row0 + q) * 1024))[lane + 64 * i];
  float sm[4];
#pragma unroll
  for (int q = 0; q < 4; ++q) { sm[q] = 0.f;
#pragma unroll
    for (int i = 0; i < 4; ++i) sm[q] += v[q][i].x + v[q][i].y + v[q][i].z + v[q][i].w; }
#pragma unroll
  for (int o = 32; o >= 1; o >>= 1)
#pragma unroll
    for (int q = 0; q < 4; ++q) sm[q] += __shfl_xor(sm[q], o);
  float qq[4];
#pragma unroll
  for (int q = 0; q < 4; ++q) { const float mu = sm[q] * (1.f / 1024.f); qq[q] = 0.f;
#pragma unroll
    for (int i = 0; i < 4; ++i) { v[q][i].x -= mu; v[q][i].y -= mu; v[q][i].z -= mu; v[q][i].w -= mu; qq[q] += v[q][i].x * v[q][i].x + v[q][i].y * v[q][i].y + v[q][i].z * v[q][i].z + v[q][i].w * v[q][i].w; } }
#pragma unroll
  for (int o = 32; o >= 1; o >>= 1)
#pragma unroll
    for (int q = 0; q < 4; ++q) qq[q] += __shfl_xor(qq[q], o);
#pragma unroll
  for (int q = 0; q < 4; ++q) {
    const int row = row0 + q;
    const float rs = rsqrtf(qq[q] * (1.f / 1024.f) + LN_EPS);
    float4* xo = last ? (float4*)(p.out + O_YP + (size_t)row * 1024) : (float4*)(X + (size_t)row * 1024);
#pragma unroll
    for (int i = 0; i < 4; ++i) {
      float4 o;
      o.x = v[q][i].x * rs * gv[i].x + bv[i].x; o.y = v[q][i].y * rs * gv[i].y + bv[i].y;
      o.z = v[q][i].z * rs * gv[i].z + bv[i].z; o.w = v[q][i].w * rs * gv[i].w + bv[i].w;
      xo[lane + 64 * i] = o;
      if (!last) { uint2 ob; ob.x = pack2(o.x, o.y); ob.y = pack2(o.z, o.w); *(uint2*)(XB + (size_t)row * 1024 + (lane + 64 * i) * 4) = ob; }
    }
  }
}
DI void phase_ln(const Params& p, const float* __restrict__ gam, const float* __restrict__ bet, bool last, int nkk) {
  const int lane = tidx() & 63;
  const int wid = bidx() * 4 + (tidx() >> 6), nw = NVB * 4;
  float4 gv[4], bv[4];
#pragma unroll
  for (int i = 0; i < 4; ++i) { gv[i] = ((const float4*)gam)[lane + 64 * i]; bv[i] = ((const float4*)bet)[lane + 64 * i]; }
  for (int rr = wid; rr < MT; rr += nw) ln_row(p, rr < MS ? MP + rr : rr - MS, gv, bv, last, nkk, lane);
}

enum { G_QKV, G_AO, G_RIN, G_RO, G_FIN, G_FOUT };
template <int G>
DI void gemm_phase(const Params& p, int layer, u16* lds, int vb, bool noepi = false, bool fuse_ln = false) {
  const int j = layer >> 1;
  const u16* A; const u16* Bt; int K, N;
  if (G == G_QKV) { A = (const u16*)(p.ws + WS_XB); Bt = (const u16*)(p.ws + WS_WQKV) + (size_t)j * 1536 * 1024; K = 1024; N = 1536; }
  else if (G == G_AO) { A = (const u16*)(p.ws + WS_ACT2); Bt = (const u16*)(p.ws + WS_WAO) + (size_t)j * 1024 * 1024; K = 1024; N = 1024; }
  else if (G == G_RIN) { A = (const u16*)(p.ws + WS_XB); Bt = (const u16*)(p.ws + WS_WRIN) + (size_t)j * 6144 * 1024; K = 1024; N = 6144; }
  else if (G == G_RO) { A = (const u16*)(p.ws + WS_ACT2); Bt = (const u16*)(p.ws + WS_WRO) + (size_t)j * 1024 * 2048; K = 2048; N = 1024; }
  else if (G == G_FIN) { A = (const u16*)(p.ws + WS_XB); Bt = (const u16*)(p.ws + WS_WFIN) + (size_t)layer * 5632 * 1024; K = 1024; N = 5632; }
  else { A = (const u16*)(p.ws + WS_ACT2); Bt = (const u16*)(p.ws + WS_WFOUT) + (size_t)layer * 1024 * 2816; K = 2816; N = 1024; }
  constexpr bool LNF = (G == G_AO || G == G_RO || G == G_FOUT);
  constexpr bool SPLIT = LNF || (G == G_RIN);
  const int ntn = N >> 8, ntiles = (SPLIT ? 64 : 65) * ntn;
  const int t = tid512(), lane = t & 63, w = t >> 6, wm = w >> 2, wn = w & 3;
  const int per = (int)gridDim.x >> 3;
  const int xcd = vb / per, rank = vb - xcd * per;
  const int lo = (int)(((long long)xcd * ntiles) >> 3), hi = (int)(((long long)(xcd + 1) * ntiles) >> 3);
  for (int L = lo + rank; L < hi; L += per) {
    int tm, tn;
    const int full = 64 * ntn;
    if (L < full) { const int sr = L / (8 * ntn), rem = L - sr * 8 * ntn; tn = rem >> 3; tm = 8 * sr + (rem & 7); }
    else { tn = L - full; tm = 64; }
    f32x16 acc[4][2];
    gemm_core(A + (size_t)tm * 256 * K, K, Bt + (size_t)tn * 256 * K, K, K, lds, acc);
    if (tm == 64 && wm == 1) continue;
    if (noepi) { float sacc = 0.f;
#pragma unroll
      for (int a = 0; a < 4; ++a)
#pragma unroll
        for (int b = 0; b < 2; ++b)
#pragma unroll
          for (int i = 0; i < 16; ++i) sacc += acc[a][b][i];
      if (sacc == 1.2345e30f) p.out[0] = 0.f; continue; }
    const int nb = tn * 256 + wn * 64;
    float* park = (float*)lds + w * 4096 + lane;
#pragma unroll
    for (int mi = 0; mi < 2; ++mi)
#pragma unroll
      for (int ni = 0; ni < 2; ++ni)
#pragma unroll
        for (int i = 0; i < 16; ++i) park[(mi * 32 + ni * 16 + i) * 64] = acc[2 + mi][ni][i];
    f32x16 ac[2][2];
    ac[0][0] = acc[0][0]; ac[0][1] = acc[0][1]; ac[1][0] = acc[1][0]; ac[1][1] = acc[1][1];
#pragma unroll 1
    for (int hf = 0; hf < 2; ++hf) {
      if (hf) {
#pragma unroll
        for (int mi = 0; mi < 2; ++mi)
#pragma unroll
          for (int ni = 0; ni < 2; ++ni)
#pragma unroll
            for (int i = 0; i < 16; ++i) ac[mi][ni][i] = park[(mi * 32 + ni * 16 + i) * 64];
      }
      const int mb = tm * 256 + wm * 128 + hf * 64;
      if (G == G_QKV) epi_qkv(p, j, ac, mb, nb, lane);
      else if (G == G_RIN) epi_rin(p, j, ac, mb, nb, lane);
      else if (G == G_FIN) epi_fin(p, layer, ac, mb, nb, lane);
      else epi_res(p, ac, mb, nb, lane);
    }
    if (LNF && fuse_ln) signal_cnt((unsigned*)(p.ws + WS_BAR) + LN_CNT_WORD0 + (layer * 2 + (G == G_FOUT ? 1 : 0)) * 65 + tm);
  }
  if (SPLIT) {
    const int nkk = K >> 6, r = lane & 31, h = lane >> 5;
    float* PART = (float*)(p.ws + (LNF ? WS_PART : WS_PART2));
    const bool g8 = ((int)gridDim.x & 7) == 0;
    const int vb2 = g8 ? rank * 8 + xcd : vb;
    for (int e = vb2; e < ntn * nkk; e += (int)gridDim.x) {
      const int tn = e / nkk, ks = e - tn * nkk;
      f32x16 acc[4][2];
      gemm_core(A + (size_t)MP * K + ks * 64, K, Bt + (size_t)tn * 256 * K + ks * 64, K, 64, lds, acc);
      if (wm == 0) {
        float* o = PART + (size_t)e * 128 * 256 + wn * 64 + r;
#pragma unroll
        for (int mi = 0; mi < 4; ++mi)
#pragma unroll
          for (int ni = 0; ni < 2; ++ni)
#pragma unroll
            for (int i = 0; i < 16; ++i) o[(size_t)(mi * 32 + crow(i, h)) * 256 + ni * 32] = acc[mi][ni][i];
      }
      if (LNF && fuse_ln) signal_cnt((unsigned*)(p.ws + WS_BAR) + LN_CNT_WORD0 + (layer * 2 + (G == G_FOUT ? 1 : 0)) * 65 + 64);
    }
    if (LNF && fuse_ln) {
      unsigned* bar = (unsigned*)(p.ws + WS_BAR);
      unsigned* cnt = bar + LN_CNT_WORD0 + (layer * 2 + (G == G_FOUT ? 1 : 0)) * 65;
      const float* gam = (G == G_FOUT ? p.in[I_LFG] : p.in[I_LMG]) + layer * 1024;
      const float* bet = (G == G_FOUT ? p.in[I_LFB] : p.in[I_LMB]) + layer * 1024;
      const bool last = (G == G_FOUT) && layer == 3;
      float4 gv[4], bv[4];
#pragma unroll
      for (int i = 0; i < 4; ++i) { gv[i] = ((const float4*)gam)[lane + 64 * i]; bv[i] = ((const float4*)bet)[lane + 64 * i]; }
      for (int L = lo + rank; L < hi; L += per) {
        const int sr = L / (8 * ntn), rem = L - sr * 8 * ntn, tn = rem >> 3, tm = 8 * sr + (rem & 7);
        wait_cnt(cnt + tm, 4u, bar);
        ln_rows4(p, tm * 256 + tn * 64 + w * 8, gv, bv, last, lane);
        ln_rows4(p, tm * 256 + tn * 64 + w * 8 + 4, gv, bv, last, lane);
      }
      const int G_ = (int)gridDim.x;
      int sidx = -1;
      if (g8) { if (rank >= per - 2) sidx = xcd * 2 + rank - (per - 2); }
      else if (vb >= G_ - 16) sidx = vb - (G_ - 16);
      if (sidx >= 0) {
        wait_cnt(cnt + 64, (unsigned)(4 * nkk), bar);
        ln_row(p, MP + sidx * 8 + w, gv, bv, last, nkk, lane);
      }
    }
  }
}

DI void transpose_job(const float* __restrict__ src, u16* __restrict__ dst, int K, int N, float* tl) {
  const int t = tidx();
  const int tn = N >> 6, ntiles = (K >> 6) * tn;
  for (int tile = bidx(); tile < ntiles; tile += NVB) {
    const int k0 = (tile / tn) << 6, n0 = (tile % tn) << 6;
    __syncthreads();
#pragma unroll
    for (int i = 0; i < 16; ++i) { const int k = (t >> 6) + 4 * i; tl[k * 65 + (t & 63)] = __builtin_nontemporal_load(src + (size_t)(k0 + k) * N + n0 + (t & 63)); }
    __syncthreads();
    const int n = t >> 2, kq = (t & 3) * 16;
    uint4 v0, v1;
    v0.x = pack2(tl[(kq + 0) * 65 + n], tl[(kq + 1) * 65 + n]); v0.y = pack2(tl[(kq + 2) * 65 + n], tl[(kq + 3) * 65 + n]);
    v0.z = pack2(tl[(kq + 4) * 65 + n], tl[(kq + 5) * 65 + n]); v0.w = pack2(tl[(kq + 6) * 65 + n], tl[(kq + 7) * 65 + n]);
    v1.x = pack2(tl[(kq + 8) * 65 + n], tl[(kq + 9) * 65 + n]); v1.y = pack2(tl[(kq + 10) * 65 + n], tl[(kq + 11) * 65 + n]);
    v1.z = pack2(tl[(kq + 12) * 65 + n], tl[(kq + 13) * 65 + n]); v1.w = pack2(tl[(kq + 14) * 65 + n], tl[(kq + 15) * 65 + n]);
    u16* o = dst + (size_t)(n0 + n) * K + k0 + kq;
    *(uint4*)o = v0; *(uint4*)(o + 8) = v1;
  }
}

DI void phase_prep(const Params& p, u16* lds) {
  float* tl = (float*)lds;
  for (int j = 0; j < 2; ++j) {
    transpose_job(p.in[I_WQKV] + (size_t)j * 1024 * 1536, (u16*)(p.ws + WS_WQKV) + (size_t)j * 1536 * 1024, 1024, 1536, tl);
    transpose_job(p.in[I_WAO] + (size_t)j * 1024 * 1024, (u16*)(p.ws + WS_WAO) + (size_t)j * 1024 * 1024, 1024, 1024, tl);
    transpose_job(p.in[I_WRIN] + (size_t)j * 1024 * 6144, (u16*)(p.ws + WS_WRIN) + (size_t)j * 6144 * 1024, 1024, 6144, tl);
    transpose_job(p.in[I_WRO] + (size_t)j * 2048 * 1024, (u16*)(p.ws + WS_WRO) + (size_t)j * 1024 * 2048, 2048, 1024, tl);
  }
  for (int i = 0; i < 4; ++i) {
    transpose_job(p.in[I_WFIN] + (size_t)i * 1024 * 5632, (u16*)(p.ws + WS_WFIN) + (size_t)i * 5632 * 1024, 1024, 5632, tl);
    transpose_job(p.in[I_WFOUT] + (size_t)i * 2816 * 1024, (u16*)(p.ws + WS_WFOUT) + (size_t)i * 1024 * 2816, 2816, 1024, tl);
  }
  const size_t gid = (size_t)bidx() * 256 + tidx(), gstride = (size_t)NVB * 256;
  {
    float4* X = (float4*)(p.ws + WS_X); uint2* XB = (uint2*)(p.ws + WS_XB);
    const size_t nv = (size_t)MT * 256, npv = (size_t)MP * 256;
    for (size_t v0 = gid; v0 < nv; v0 += 4 * gstride) {
      float4 xb[4];
#pragma unroll
      for (int u = 0; u < 4; ++u) { const size_t v = v0 + u * gstride; if (v < nv) xb[u] = (v < npv) ? ((const float4*)p.in[I_XP])[v] : ((const float4*)p.in[I_XS])[v - npv]; }
#pragma unroll
      for (int u = 0; u < 4; ++u) { const size_t v = v0 + u * gstride; if (v < nv) { X[v] = xb[u]; uint2 o; o.x = pack2(xb[u].x, xb[u].y); o.y = pack2(xb[u].z, xb[u].w); XB[v] = o; } }
    }
  }
  {
    float* cosT = (float*)(p.ws + WS_TROPE); float* sinT = cosT + 8193 * 32;
    for (size_t v = gid; v < 8193ull * 32; v += gstride) {
      const int pos = (int)(v >> 5), i = (int)(v & 31);
      const double inv = exp(-9.210340371976182736 * (double)i / 32.0);
      float s, c; sincos_d((double)pos * inv, s, c); cosT[v] = c; sinT[v] = s;
    }
    float* cosR = (float*)(p.ws + WS_TRET); float* sinR = cosR + 8193 * 128;
    for (size_t v = gid; v < 8193ull * 128; v += gstride) {
      const int pos = (int)(v >> 7), i = (int)(v & 127);
      const double inv = exp(-9.210340371976182736 * (double)i / 127.0);
      float s, c; sincos_d((double)pos * inv, s, c); cosR[v] = c; sinR[v] = s;
    }
  }
}

DI void attn_prompt_item(const Params& p, int j, int item, u16* lds) {
  const int g = item & 3, kvh = (item >> 2) & 3, qb = (item >> 4) & 63, b = item >> 10;
  const int head = kvh * 4 + g;
  const int t = tidx(), lane = t & 63, w = t >> 6, r = lane & 31, h = lane >> 5;
  u16* Ks = lds;
  u16* Vts = lds + 256 * 72;
  const u16* Q = (const u16*)(p.ws + A_Q); const u16* KB = (const u16*)(p.ws + A_K); const u16* VT = (const u16*)(p.ws + A_VT);
  u16* OB = (u16*)(p.ws + WS_ACT2);
  const int tok0 = qb * 128 - 128;
  __syncthreads();
#pragma unroll
  for (int i = 0; i < 8; ++i) {
    const int c = t + 256 * i, key = c >> 3, part = c & 7, tok = tok0 + key;
    uint4 v = make_uint4(0, 0, 0, 0);
    if (tok >= 0) v = *(const uint4*)(KB + (size_t)(b * 8192 + tok) * 256 + kvh * 64 + part * 8);
    *(uint4*)(Ks + key * 72 + part * 8) = v;
  }
#pragma unroll
  for (int i = 0; i < 8; ++i) {
    const int c = t + 256 * i, d = c >> 5, part = c & 31, tok = tok0 + part * 8;
    uint4 v = make_uint4(0, 0, 0, 0);
    if (tok >= 0) v = *(const uint4*)(VT + (size_t)(b * 256 + kvh * 64 + d) * 8192 + tok);
    *(uint4*)(Vts + d * 264 + part * 8) = v;
  }
  const size_t qrow = (size_t)b * 8192 + qb * 128 + 32 * w + r;
  bf16x8 bq[4];
#pragma unroll
  for (int kk = 0; kk < 4; ++kk) bq[kk] = *(const bf16x8*)(Q + qrow * 1024 + head * 64 + kk * 16 + h * 8);
  __syncthreads();
  f32x16 S[5];
#pragma unroll
  for (int jb = 0; jb < 5; ++jb) {
#pragma unroll
    for (int i = 0; i < 16; ++i) S[jb][i] = 0.f;
    const u16* kp = Ks + (32 * (w + jb) + r) * 72 + h * 8;
#pragma unroll
    for (int kk = 0; kk < 4; ++kk) S[jb] = MFMA(*(const bf16x8*)(kp + kk * 16), bq[kk], S[jb]);
  }
  const float sink = p.in[I_SINK][j * 16 + head];
  float m = -INFINITY;
#pragma unroll
  for (int jb = 0; jb < 5; ++jb)
#pragma unroll
    for (int reg = 0; reg < 16; ++reg) {
      const int cr = crow(reg, h);
      const int rel = 128 + r - 32 * jb - cr;
      const bool valid = (rel >= 0) && (rel <= 128) && (qb > 0 || (32 * (w + jb) + cr) >= 128);
      const float s = valid ? S[jb][reg] : -INFINITY;
      S[jb][reg] = s; m = fmaxf(m, s);
    }
  m = fmaxf(m, __shfl_xor(m, 32));
  m = fmaxf(m, sink);
  float l = 0.f;
#pragma unroll
  for (int jb = 0; jb < 5; ++jb)
#pragma unroll
    for (int reg = 0; reg < 16; ++reg) { const float e = __expf(S[jb][reg] - m); S[jb][reg] = e; l += e; }
  l += __shfl_xor(l, 32);
  const float inv = 1.f / (l + __expf(sink - m));
  f32x16 O[2];
#pragma unroll
  for (int db = 0; db < 2; ++db)
#pragma unroll
    for (int i = 0; i < 16; ++i) O[db][i] = 0.f;
#pragma unroll
  for (int jb = 0; jb < 5; ++jb)
#pragma unroll
    for (int s = 0; s < 2; ++s) {
      uint4 pb;
      pb.x = pack2(S[jb][8 * s + 0], S[jb][8 * s + 1]); pb.y = pack2(S[jb][8 * s + 2], S[jb][8 * s + 3]);
      pb.z = pack2(S[jb][8 * s + 4], S[jb][8 * s + 5]); pb.w = pack2(S[jb][8 * s + 6], S[jb][8 * s + 7]);
      const bf16x8 bfrag = __builtin_bit_cast(bf16x8, pb);
#pragma unroll
      for (int db = 0; db < 2; ++db) {
        const u16* vp = Vts + (32 * db + r) * 264 + 32 * (w + jb) + 16 * s + 4 * h;
        const uint2 lo = *(const uint2*)vp, hi = *(const uint2*)(vp + 8);
        uint4 av; av.x = lo.x; av.y = lo.y; av.z = hi.x; av.w = hi.y;
        O[db] = MFMA(__builtin_bit_cast(bf16x8, av), bfrag, O[db]);
      }
    }
#pragma unroll
  for (int db = 0; db < 2; ++db)
#pragma unroll
    for (int g4 = 0; g4 < 4; ++g4) {
      uint2 v; v.x = pack2(O[db][4 * g4] * inv, O[db][4 * g4 + 1] * inv); v.y = pack2(O[db][4 * g4 + 2] * inv, O[db][4 * g4 + 3] * inv);
      *(uint2*)(OB + qrow * 1024 + head * 64 + 32 * db + 8 * g4 + 4 * h) = v;
    }
}

DI void attn_sample_item(const Params& p, int j, int item, u16* lds) {
  const int kvh = item & 3, b = item >> 2;
  const int t = tidx(), lane = t & 63, g = t >> 6;
  float* Kc = (float*)lds;
  float* Vc = Kc + 129 * 65;
  float* qs = Vc + 129 * 65;
  float* ps = qs + 256;
  const float* ck = p.in[I_CK] + (size_t)(j * 128 + b) * 128 * 256;
  const float* cv = p.in[I_CV] + (size_t)(j * 128 + b) * 128 * 256;
  float* ok = p.out + O_KWS + (size_t)(j * 128 + b) * 128 * 256;
  float* ov = p.out + O_VWS + (size_t)(j * 128 + b) * 128 * 256;
  __syncthreads();
  {
    const int d = t & 63, w0 = t >> 6;
#pragma unroll 1
    for (int i0 = 0; i0 < 32; i0 += 8) {
      float kb[8], vb[8];
#pragma unroll
      for (int u = 0; u < 8; ++u) { const int wq = w0 + 4 * (i0 + u); kb[u] = __builtin_nontemporal_load(ck + wq * 256 + kvh * 64 + d); vb[u] = __builtin_nontemporal_load(cv + wq * 256 + kvh * 64 + d); }
#pragma unroll
      for (int u = 0; u < 8; ++u) {
        const int wq = w0 + 4 * (i0 + u);
        Kc[wq * 65 + d] = kb[u]; Vc[wq * 65 + d] = vb[u];
        if (wq >= 1) { __builtin_nontemporal_store(kb[u], ok + (wq - 1) * 256 + kvh * 64 + d); __builtin_nontemporal_store(vb[u], ov + (wq - 1) * 256 + kvh * 64 + d); }
      }
    }
  }
  if (t < 64) { Kc[128 * 65 + t] = ok[127 * 256 + kvh * 64 + t]; Vc[128 * 65 + t] = ov[127 * 256 + kvh * 64 + t]; }
  qs[t] = bf2f(((const u16*)(p.ws + A_Q))[(size_t)(MP + b) * 1024 + (kvh * 4 + g) * 64 + lane]);
  __syncthreads();
  const float sink = p.in[I_SINK][j * 16 + kvh * 4 + g];
  float s0 = 0.f, s1 = 0.f, s2 = 0.f;
#pragma unroll 8
  for (int d = 0; d < 64; ++d) {
    const float q = qs[g * 64 + d];
    s0 += q * Kc[lane * 65 + d]; s1 += q * Kc[(lane + 64) * 65 + d]; s2 += q * Kc[128 * 65 + d];
  }
  float m = fmaxf(fmaxf(s0, s1), s2);
  m = fmaxf(wave_max(m), sink);
  const float e0 = __expf(s0 - m), e1 = __expf(s1 - m), e2 = __expf(s2 - m);
  float l = wave_sum(e0 + e1) + e2;
  const float inv = 1.f / (l + __expf(sink - m));
  ps[g * 132 + lane] = e0 * inv; ps[g * 132 + 64 + lane] = e1 * inv;
  if (lane == 0) ps[g * 132 + 128] = e2 * inv;
  __syncthreads();
  float o = 0.f;
#pragma unroll 4
  for (int k = 0; k < 129; ++k) o += ps[g * 132 + k] * Vc[k * 65 + lane];
  ((u16*)(p.ws + WS_ACT2))[(size_t)(MP + b) * 1024 + (kvh * 4 + g) * 64 + lane] = f2bf(o);
}

DI void phase_attn(const Params& p, int layer, u16* lds, int vb) {
  const int j = layer >> 1;
  const int vid = 2 * vb + __builtin_amdgcn_readfirstlane(tid512() >> 8);
  for (int item = vid; item < 2048 + 512; item += NVB) {
    if (item < 2048) attn_prompt_item(p, j, item, lds);
    else attn_sample_item(p, j, item - 2048, lds);
  }
}

DI void unpack8(const uint4 x, float (&o)[8]) {
  o[0] = __uint_as_float(x.x << 16); o[1] = __uint_as_float(x.x & 0xffff0000u); o[2] = __uint_as_float(x.y << 16); o[3] = __uint_as_float(x.y & 0xffff0000u);
  o[4] = __uint_as_float(x.z << 16); o[5] = __uint_as_float(x.z & 0xffff0000u); o[6] = __uint_as_float(x.w << 16); o[7] = __uint_as_float(x.w & 0xffff0000u);
}
DI void phase_conv(const Params& p, int i) {
  const u16* __restrict__ UA = (const u16*)(p.ws + F_UA); const u16* __restrict__ UG = (const u16*)(p.ws + F_UG);
  u16* __restrict__ H = (u16*)(p.ws + WS_ACT2);
  const float* cw = p.in[I_CW] + (size_t)i * 3 * DFF; const float* cb = p.in[I_CB] + (size_t)i * DFF;
  const float* sc = p.in[I_SC] + (size_t)i * 128 * 2 * DFF;
  const int gid = bidx() * 256 + tidx(), gstride = NVB * 256;
  for (int it = gid; it < 1024 * 352 + 128 * 352; it += gstride) {
    const bool smp = it >= 1024 * 352;
    const int it2 = smp ? it - 1024 * 352 : it;
    const int ch = it2 / 352, f = (it2 - ch * 352) * 8, row0 = smp ? MP + ch : ch * 16;
    float w0[8], w1[8], w2[8], bb[8];
#pragma unroll
    for (int k = 0; k < 8; ++k) { w0[k] = cw[f + k]; w1[k] = cw[DFF + f + k]; w2[k] = cw[2 * DFF + f + k]; bb[k] = cb[f + k]; }
    if (!smp) {
      float a1[8], a2[8];
      const int pos0 = row0 & 8191;
      if (pos0 >= 2) { unpack8(*(const uint4*)(UA + (size_t)(row0 - 1) * DFF + f), a1); unpack8(*(const uint4*)(UA + (size_t)(row0 - 2) * DFF + f), a2); }
      else {
#pragma unroll
        for (int k = 0; k < 8; ++k) { a1[k] = 0.f; a2[k] = 0.f; }
      }
#pragma unroll 1
      for (int rr = 0; rr < 16; rr += 4) {
        const size_t o = (size_t)(row0 + rr) * DFF + f;
        uint4 xa[4], xg[4];
#pragma unroll
        for (int u = 0; u < 4; ++u) { xa[u] = *(const uint4*)(UA + o + (size_t)u * DFF); xg[u] = *(const uint4*)(UG + o + (size_t)u * DFF); }
#pragma unroll
        for (int u = 0; u < 4; ++u) {
          float a0[8], gg[8];
          unpack8(xa[u], a0); unpack8(xg[u], gg);
          unsigned ho[4];
#pragma unroll
          for (int k = 0; k < 4; ++k) {
            const float c0 = bb[2 * k] + a2[2 * k] * w0[2 * k] + a1[2 * k] * w1[2 * k] + a0[2 * k] * w2[2 * k];
            const float c1 = bb[2 * k + 1] + a2[2 * k + 1] * w0[2 * k + 1] + a1[2 * k + 1] * w1[2 * k + 1] + a0[2 * k + 1] * w2[2 * k + 1];
            ho[k] = pack2(silu(c0) * gg[2 * k], silu(c1) * gg[2 * k + 1]);
          }
          *(uint4*)(H + o + (size_t)u * DFF) = make_uint4(ho[0], ho[1], ho[2], ho[3]);
#pragma unroll
          for (int k = 0; k < 8; ++k) { a2[k] = a1[k]; a1[k] = a0[k]; }
        }
      }
    } else {
      const int b = row0 - MP;
      const size_t o = (size_t)row0 * DFF + f;
      float a0[8], gg[8];
      unpack8(*(const uint4*)(UA + o), a0); unpack8(*(const uint4*)(UG + o), gg);
      const float4* s0p = (const float4*)(sc + (size_t)(b * 2 + 0) * DFF + f); const float4* s1p = (const float4*)(sc + (size_t)(b * 2 + 1) * DFF + f);
      float4* o0 = (float4*)(p.out + O_CSS + ((size_t)(i * 128 + b) * 2 + 0) * DFF + f);
      const float4 p0 = s0p[0], p1 = s0p[1], q0 = s1p[0], q1 = s1p[1];
      o0[0] = q0; o0[1] = q1;
      const float x2[8] = {p0.x, p0.y, p0.z, p0.w, p1.x, p1.y, p1.z, p1.w}, x1[8] = {q0.x, q0.y, q0.z, q0.w, q1.x, q1.y, q1.z, q1.w};
      unsigned ho[4];
#pragma unroll
      for (int k = 0; k < 4; ++k) {
        const float c0 = bb[2 * k] + x2[2 * k] * w0[2 * k] + x1[2 * k] * w1[2 * k] + a0[2 * k] * w2[2 * k];
        const float c1 = bb[2 * k + 1] + x2[2 * k + 1] * w0[2 * k + 1] + x1[2 * k + 1] * w1[2 * k + 1] + a0[2 * k + 1] * w2[2 * k + 1];
        ho[k] = pack2(silu(c0) * gg[2 * k], silu(c1) * gg[2 * k + 1]);
      }
      *(uint4*)(H + o) = make_uint4(ho[0], ho[1], ho[2], ho[3]);
    }
  }
}

DI void ret_u_tile(const Params& p, int tile, u16* lds) {
  const int te = tile & 1, hh = (tile >> 1) & 3, c = (tile >> 3) & 63, b = tile >> 9;
  const u16* VT = (const u16*)(p.ws + R_VT) + (size_t)(b * 2048 + hh * 512 + te * 256) * 8192 + c * 128;
  const u16* KT = (const u16*)(p.ws + R_KT) + (size_t)(b * 1024 + hh * 256) * 8192 + c * 128;
  f32x16 acc[4][2];
  gemm_core(VT, 8192, KT, 8192, 128, lds, acc);
  const int t = tid512(), lane = t & 63, w = t >> 6, wm = w >> 2, wn = w & 3, r = lane & 31, h = lane >> 5;
  u16* UT = (u16*)(p.ws + WS_US) + (size_t)((b * 64 + c) * 4 + hh) * 512 * 256;
#pragma unroll
  for (int mi = 0; mi < 4; ++mi)
#pragma unroll
    for (int ni = 0; ni < 2; ++ni)
#pragma unroll
      for (int reg = 0; reg < 16; ++reg)
        UT[(size_t)(te * 256 + wm * 128 + mi * 32 + crow(reg, h)) * 256 + wn * 64 + ni * 32 + r] = f2bf(acc[mi][ni][reg]);
}

DI float block_sum(float v, float* red) {
  v = wave_sum(v);
  __syncthreads();
  if ((tidx() & 63) == 0) red[tidx() >> 6] = v;
  __syncthreads();
  return red[0] + red[1] + red[2] + red[3];
}

DI void ret_sample_item(const Params& p, int j, int item, u16* lds) {
  const int hh = item & 3, b = item >> 2, t = tidx(), tc = t & 127, par = t >> 7;
  float* qs = (float*)lds; float* ks = qs + 256; float* red = ks + 256; float4* red4 = (float4*)(red + 8);
  const float* __restrict__ P2 = (const float*)(p.ws + WS_PART2);
  __syncthreads();
  float qr = 0.f, kr = 0.f;
  float4 vv = make_float4(0.f, 0.f, 0.f, 0.f), gq = make_float4(0.f, 0.f, 0.f, 0.f);
  {
    const float* pq = P2 + ((size_t)(hh * 16) * 128 + b) * 256 + t;
    const float* pk = P2 + ((size_t)((4 + hh) * 16) * 128 + b) * 256 + t;
    const float* pv = P2 + ((size_t)((8 + 2 * hh + (tc >> 6)) * 16) * 128 + b) * 256 + ((4 * tc) & 255);
    const float* pg = P2 + ((size_t)((16 + 2 * hh + (tc >> 6)) * 16) * 128 + b) * 256 + ((4 * tc) & 255);
    float qb[16], kb[16]; float4 vb4[16], gb4[16];
#pragma unroll
    for (int u = 0; u < 16; ++u) { qb[u] = pq[(size_t)u * 128 * 256]; kb[u] = pk[(size_t)u * 128 * 256]; }
#pragma unroll
    for (int u = 0; u < 16; ++u) { vb4[u] = *(const float4*)(pv + (size_t)u * 128 * 256); gb4[u] = *(const float4*)(pg + (size_t)u * 128 * 256); }
#pragma unroll
    for (int u = 0; u < 16; ++u) {
      qr += qb[u]; kr += kb[u];
      vv.x += vb4[u].x; vv.y += vb4[u].y; vv.z += vb4[u].z; vv.w += vb4[u].w;
      gq.x += gb4[u].x; gq.y += gb4[u].y; gq.z += gb4[u].z; gq.w += gb4[u].w;
    }
  }
  qs[t] = qr; ks[t] = kr;
  __syncthreads();
  float qv, kv;
  {
    const float* cosR = (const float*)(p.ws + WS_TRET); const float* sinR = cosR + 8193 * 128;
    const float c = cosR[8192 * 128 + (t >> 1)], sn = sinR[8192 * 128 + (t >> 1)];
    const float oq = qs[t ^ 1], ok_ = ks[t ^ 1];
    const float rq = (t & 1) ? (qr * c + oq * sn) : (qr * c - oq * sn);
    const float rk = (t & 1) ? (kr * c + ok_ * sn) : (kr * c - ok_ * sn);
    const float lg = lg2gamma(hh);
    qv = rq * exp2f(lg); kv = rk * 0.0625f * exp2f(-lg);
  }
  __syncthreads();
  qs[t] = qv; ks[t] = kv;
  const float qk = block_sum(qv * kv, red);
  const float gamma = 1.f - exp2f(-5.f - (float)hh);
  const float4* __restrict__ s0 = (const float4*)(p.in[I_SR] + ((size_t)((j * 128 + b) * 4 + hh) * 256) * 512) + tc;
  float4* __restrict__ so = (float4*)(p.out + O_RSS + ((size_t)((j * 128 + b) * 4 + hh) * 256) * 512) + tc;
  float4 o = make_float4(0.f, 0.f, 0.f, 0.f);
#pragma unroll 1
  for (int d0 = par; d0 < 256; d0 += 16) {
    float4 sv[8];
#pragma unroll
    for (int u = 0; u < 8; ++u) { const f32x4 t4 = __builtin_nontemporal_load((const f32x4*)(s0 + (size_t)(d0 + 2 * u) * 128)); sv[u] = make_float4(t4[0], t4[1], t4[2], t4[3]); }
#pragma unroll
    for (int u = 0; u < 8; ++u) {
      const float q = qs[d0 + 2 * u], k = ks[d0 + 2 * u];
      o.x += q * sv[u].x; o.y += q * sv[u].y; o.z += q * sv[u].z; o.w += q * sv[u].w;
      float4 n; n.x = gamma * (sv[u].x + k * vv.x); n.y = gamma * (sv[u].y + k * vv.y); n.z = gamma * (sv[u].z + k * vv.z); n.w = gamma * (sv[u].w + k * vv.w);
      { f32x4 n4; n4[0] = n.x; n4[1] = n.y; n4[2] = n.z; n4[3] = n.w; __builtin_nontemporal_store(n4, (f32x4*)(so + (size_t)(d0 + 2 * u) * 128)); }
    }
  }
  red4[t] = o;
  __syncthreads();
  float s1 = 0.f;
  if (par == 0) {
    const float4 o2 = red4[t + 128];
    o.x += o2.x + qk * vv.x; o.y += o2.y + qk * vv.y; o.z += o2.z + qk * vv.z; o.w += o2.w + qk * vv.w;
    s1 = o.x + o.y + o.z + o.w;
  }
  const float mu = block_sum(s1, red) * (1.f / 512.f);
  float s2 = 0.f;
  if (par == 0) { o.x -= mu; o.y -= mu; o.z -= mu; o.w -= mu; s2 = o.x * o.x + o.y * o.y + o.z * o.z + o.w * o.w; }
  const float var = block_sum(s2, red) * (1.f / 512.f);
  const float rs = rsqrtf(var + GN_EPS);
  if (par == 0) {
    u16* OB = (u16*)(p.ws + WS_ACT2) + (size_t)(MP + b) * 2048 + hh * 512 + 4 * tc;
    uint2 ov; ov.x = pack2(o.x * rs * silu(gq.x), o.y * rs * silu(gq.y)); ov.y = pack2(o.z * rs * silu(gq.z), o.w * rs * silu(gq.w));
    *(uint2*)OB = ov;
  }
}

DI void phase_ret_u(const Params& p, int layer, u16* lds) {
  const int j = layer >> 1;
  const int half = __builtin_amdgcn_readfirstlane(tid512() >> 8);
  const int G = (int)gridDim.x, gs = G >> 1, br = bid_real();
  if (br < gs) {
    for (int it = br; it < 256; it += gs) ret_sample_item(p, j, 2 * it + half, lds + half * LDS_HALF_E);
  } else {
    for (int it = br - gs; it < 1024; it += G - gs) ret_u_tile(p, it, lds);
  }
}

DI void phase_ret_scan(const Params& p, int layer) {
  const int j = layer >> 1;
  u16* UT = (u16*)(p.ws + WS_US);
  const size_t cstride = 4ull * 512 * 256;
  for (int v = bidx() * 256 + tidx(); v < 131072; v += NVB * 256) {
    const int d8 = v & 31, e = (v >> 5) & 511, hh = (v >> 14) & 3, b = v >> 16;
    u16* base = UT + ((size_t)(b * 64 * 4 + hh) * 512 + e) * 256 + d8 * 8;
    const float cd = exp2f(128.f * lg2gamma(hh));
    float s[8];
#pragma unroll
    for (int k = 0; k < 8; ++k) s[k] = 0.f;
#pragma unroll 1
    for (int c0 = 0; c0 < 64; c0 += 16) {
      uint4 ub[16];
#pragma unroll
      for (int q = 0; q < 16; ++q) ub[q] = *(const uint4*)(base + (size_t)(c0 + q) * cstride);
#pragma unroll
      for (int q = 0; q < 16; ++q) {
        uint4 o; o.x = pack2(s[0], s[1]); o.y = pack2(s[2], s[3]); o.z = pack2(s[4], s[5]); o.w = pack2(s[6], s[7]);
        *(uint4*)(base + (size_t)(c0 + q) * cstride) = o;
        const unsigned us[4] = {ub[q].x, ub[q].y, ub[q].z, ub[q].w};
#pragma unroll
        for (int k = 0; k < 4; ++k) {
          s[2 * k] = cd * (s[2 * k] + __uint_as_float(us[k] << 16));
          s[2 * k + 1] = cd * (s[2 * k + 1] + __uint_as_float(us[k] & 0xffff0000u));
        }
      }
    }
    float* o = p.out + O_RSP + ((size_t)((j * 2 + b) * 4 + hh) * 256 + d8 * 8) * 512 + e;
#pragma unroll
    for (int k = 0; k < 8; ++k) o[(size_t)k * 512] = s[k];
  }
}

DI void ret_out_item(const Params& p, int item, u16* lds) {
  const int rh = item & 1, hh = (item >> 1) & 3, c = (item >> 3) & 63, b = item >> 9;
  const int t = tidx(), lane = t & 63, w = t >> 6, r = lane & 31, h = lane >> 5;
  const size_t row0 = (size_t)b * 8192 + c * 128, trow0 = row0 + rh * 64;
  const u16* QR = (const u16*)(p.ws + R_Q); const u16* KR = (const u16*)(p.ws + R_K);
  const u16* VT = (const u16*)(p.ws + R_VT) + (size_t)(b * 2048 + hh * 512) * 8192 + c * 128;
  const u16* PT = (const u16*)(p.ws + WS_US) + (size_t)((b * 64 + c) * 4 + hh) * 512 * 256;
  u16* inner = lds;
  float* red1 = (float*)lds;
  float* red2 = red1 + 64 * 132;
  float* smu = red2 + 64 * 132;
  float* srs = smu + 64;
  __syncthreads();
  {
    f32x16 T[2];
#pragma unroll
    for (int ib = 0; ib < 2; ++ib)
#pragma unroll
      for (int i = 0; i < 16; ++i) T[ib][i] = 0.f;
    if (rh == 1 || w < 2) {
      const u16* kp = KR + (row0 + 32 * w + r) * 1024 + hh * 256 + h * 8;
      const u16* qp0 = QR + (trow0 + r) * 1024 + hh * 256 + h * 8;
      const u16* qp1 = qp0 + 32 * 1024;
#pragma unroll 4
      for (int ks = 0; ks < 16; ++ks) {
        const bf16x8 a = *(const bf16x8*)(kp + ks * 16);
        T[0] = MFMA(a, *(const bf16x8*)(qp0 + ks * 16), T[0]);
        T[1] = MFMA(a, *(const bf16x8*)(qp1 + ks * 16), T[1]);
      }
    }
#pragma unroll
    for (int ib = 0; ib < 2; ++ib)
#pragma unroll
      for (int g4 = 0; g4 < 4; ++g4) {
        const int il = 32 * ib + r, ig = rh * 64 + il, j0 = 32 * w + 8 * g4 + 4 * h;
        const float v0 = (j0 + 0 <= ig) ? T[ib][4 * g4 + 0] : 0.f, v1 = (j0 + 1 <= ig) ? T[ib][4 * g4 + 1] : 0.f;
        const float v2 = (j0 + 2 <= ig) ? T[ib][4 * g4 + 2] : 0.f, v3 = (j0 + 3 <= ig) ? T[ib][4 * g4 + 3] : 0.f;
        uint2 v; v.x = pack2(v0, v1); v.y = pack2(v2, v3);
        *(uint2*)(inner + il * 136 + j0) = v;
      }
  }
  __syncthreads();
  f32x16 acc[2][4];
#pragma unroll
  for (int rb = 0; rb < 2; ++rb)
#pragma unroll
    for (int eb = 0; eb < 4; ++eb)
#pragma unroll
      for (int i = 0; i < 16; ++i) acc[rb][eb][i] = 0.f;
#define RO_MFMA8(A0, A1, B0, B1, B2, B3) \
      acc[0][0] = MFMA(A0, B0, acc[0][0]); acc[1][0] = MFMA(A1, B0, acc[1][0]); acc[0][1] = MFMA(A0, B1, acc[0][1]); acc[1][1] = MFMA(A1, B1, acc[1][1]); \
      acc[0][2] = MFMA(A0, B2, acc[0][2]); acc[1][2] = MFMA(A1, B2, acc[1][2]); acc[0][3] = MFMA(A0, B3, acc[0][3]); acc[1][3] = MFMA(A1, B3, acc[1][3]);
  {
    const u16* ap = inner + r * 136 + h * 8;
    const u16* bp = VT + (size_t)(128 * w + r) * 8192 + h * 8;
    const int ngr = rh ? 2 : 1;
#pragma unroll 1
    for (int g = 0; g < ngr; ++g) {
      bf16x8 bb[4][4];
#pragma unroll
      for (int q = 0; q < 4; ++q)
#pragma unroll
        for (int eb = 0; eb < 4; ++eb) bb[q][eb] = *(const bf16x8*)(bp + (size_t)(32 * eb) * 8192 + (4 * g + q) * 16);
      __builtin_amdgcn_sched_barrier(0);
#pragma unroll
      for (int q = 0; q < 4; ++q) {
        const bf16x8 a0 = *(const bf16x8*)(ap + (4 * g + q) * 16), a1 = *(const bf16x8*)(ap + 32 * 136 + (4 * g + q) * 16);
        RO_MFMA8(a0, a1, bb[q][0], bb[q][1], bb[q][2], bb[q][3])
      }
    }
  }
  {
    const u16* ap = QR + (trow0 + r) * 1024 + hh * 256 + h * 8;
    const u16* bp = PT + (size_t)(128 * w + r) * 256 + h * 8;
#pragma unroll 1
    for (int g = 0; g < 4; ++g) {
      bf16x8 bb[4][4], aa[2][2];
#pragma unroll
      for (int q = 0; q < 4; ++q)
#pragma unroll
        for (int eb = 0; eb < 4; ++eb) bb[q][eb] = *(const bf16x8*)(bp + (size_t)(32 * eb) * 256 + (4 * g + q) * 16);
#pragma unroll
      for (int q = 0; q < 2; ++q) { aa[q][0] = *(const bf16x8*)(ap + (4 * g + q) * 16); aa[q][1] = *(const bf16x8*)(ap + 32 * 1024 + (4 * g + q) * 16); }
      __builtin_amdgcn_sched_barrier(0);
#pragma unroll
      for (int q = 0; q < 2; ++q) { RO_MFMA8(aa[q][0], aa[q][1], bb[q][0], bb[q][1], bb[q][2], bb[q][3]) }
#pragma unroll
      for (int q = 0; q < 2; ++q) { aa[q][0] = *(const bf16x8*)(ap + (4 * g + 2 + q) * 16); aa[q][1] = *(const bf16x8*)(ap + 32 * 1024 + (4 * g + 2 + q) * 16); }
#pragma unroll
      for (int q = 0; q < 2; ++q) { RO_MFMA8(aa[q][0], aa[q][1], bb[2 + q][0], bb[2 + q][1], bb[2 + q][2], bb[2 + q][3]) }
    }
  }
#undef RO_MFMA8
  __syncthreads();
#pragma unroll
  for (int rb = 0; rb < 2; ++rb)
#pragma unroll
    for (int reg = 0; reg < 16; ++reg) {
      float s1 = 0.f, s2 = 0.f;
#pragma unroll
      for (int eb = 0; eb < 4; ++eb) { const float v = acc[rb][eb][reg]; s1 += v; s2 += v * v; }
      const int row = 32 * rb + crow(reg, h);
      red1[row * 132 + w * 32 + r] = s1; red2[row * 132 + w * 32 + r] = s2;
    }
  __syncthreads();
  {
    const int row = t >> 2, q = t & 3;
    float s1 = 0.f, s2 = 0.f;
#pragma unroll
    for (int k = 0; k < 32; ++k) { s1 += red1[row * 132 + q * 32 + k]; s2 += red2[row * 132 + q * 32 + k]; }
    s1 += __shfl_xor(s1, 1); s2 += __shfl_xor(s2, 1);
    s1 += __shfl_xor(s1, 2); s2 += __shfl_xor(s2, 2);
    const float mu = s1 * (1.f / 512.f);
    const float var = fmaxf(s2 * (1.f / 512.f) - mu * mu, 0.f);
    if (q == 0) { smu[row] = mu; srs[row] = rsqrtf(var + GN_EPS); }
  }
  __syncthreads();
  const u16* __restrict__ GS = (const u16*)(p.ws + R_GS); u16* __restrict__ OB = (u16*)(p.ws + WS_ACT2);
#pragma unroll
  for (int rb = 0; rb < 2; ++rb)
#pragma unroll
    for (int rq = 0; rq < 4; ++rq) {
      u16 gg[4][4];
#pragma unroll
      for (int q = 0; q < 4; ++q)
#pragma unroll
        for (int eb = 0; eb < 4; ++eb) gg[q][eb] = GS[(trow0 + 32 * rb + crow(4 * rq + q, h)) * 2048 + hh * 512 + 128 * w + r + 32 * eb];
#pragma unroll
      for (int q = 0; q < 4; ++q) {
        const int reg = 4 * rq + q, row = 32 * rb + crow(reg, h);
        const float mu = smu[row], rs = srs[row];
        const size_t o = (trow0 + row) * 2048 + hh * 512 + 128 * w + r;
#pragma unroll
        for (int eb = 0; eb < 4; ++eb) OB[o + 32 * eb] = f2bf((acc[rb][eb][reg] - mu) * rs * bf2f(gg[q][eb]));
      }
    }
}

enum { PH_PREP = 0, PH_QKV, PH_ATTN, PH_AO, PH_RIN, PH_RETU, PH_SCAN, PH_RETO, PH_RO, PH_LNM, PH_FIN, PH_CONV, PH_FOUT, PH_LNF };

DI void run_phase(const Params& p, int ph, int layer, u16* lds, int vb, bool noepi = false, bool fuse_ln = false) {
  u16* hl = lds + __builtin_amdgcn_readfirstlane(tid512() >> 8) * LDS_HALF_E;
  switch (ph) {
    case PH_PREP: phase_prep(p, hl); break;
    case PH_QKV: gemm_phase<G_QKV>(p, layer, lds, vb); break;
    case PH_ATTN: phase_attn(p, layer, hl, vb); break;
    case PH_AO: gemm_phase<G_AO>(p, layer, lds, vb, false, fuse_ln); break;
    case PH_RIN: gemm_phase<G_RIN>(p, layer, lds, vb); break;
    case PH_RETU: phase_ret_u(p, layer, lds); break;
    case PH_SCAN: phase_ret_scan(p, layer); break;
    case PH_RETO: for (int item = bidx(); item < 1024; item += NVB) ret_out_item(p, item, hl); break;
    case PH_RO: gemm_phase<G_RO>(p, layer, lds, vb, false, fuse_ln); break;
    case PH_LNM: phase_ln(p, p.in[I_LMG] + layer * 1024, p.in[I_LMB] + layer * 1024, false, (layer & 1) ? 32 : 16); break;
    case PH_FIN: gemm_phase<G_FIN>(p, layer, lds, vb, noepi); break;
    case PH_CONV: phase_conv(p, layer); break;
    case PH_FOUT: gemm_phase<G_FOUT>(p, layer, lds, vb, false, fuse_ln); break;
    case PH_LNF: phase_ln(p, p.in[I_LFG] + layer * 1024, p.in[I_LFB] + layer * 1024, layer == 3, 44); break;
  }
}

#if !MEGA
__global__ void __launch_bounds__(512, 2) k_phase(Params p, int ph, int layer) {
  __shared__ __attribute__((aligned(16))) u16 lds[LDS_BYTES / 2];
  run_phase(p, ph, layer, lds, (int)blockIdx.x);
}

#else
#ifndef PROBE_MASK
#define PROBE_MASK 0
#endif
#ifndef PROBE_NOEPI
#define PROBE_NOEPI 0
#endif
__global__ void __launch_bounds__(512, 2) k_mega(Params p) {
  __shared__ __attribute__((aligned(16))) u16 lds[LDS_BYTES / 2];
  __shared__ uint4 xb_words;
  cg::grid_group grid = cg::this_grid();
  if (__builtin_amdgcn_workitem_id_x() == 0) xb_words = make_uint4(0u, 0u, 0u, (unsigned)__builtin_amdgcn_workgroup_id_x());
  __syncthreads();
  XcdBarrier xb = xcd_barrier_post((unsigned*)(p.ws + WS_BAR), (volatile LAS unsigned*)&xb_words);
  {
    Params q = p;
    asm volatile("" : "+s"(q.out)); asm volatile("" : "+s"(q.ws));
    const int rep0 = ((PROBE_MASK >> PH_PREP) & 1) ? 2 : 1;
    for (int rr = 0; rr < rep0; ++rr) run_phase(q, PH_PREP, 0, lds, 0);
    if (p.ws == nullptr) grid.sync();
    xcd_barrier(xb);
    if (__builtin_amdgcn_workitem_id_x() == 0) {
      unsigned* bar = (unsigned*)(p.ws + WS_BAR);
      const unsigned G = gridDim.x;
      unsigned cnt = 0u, mine = 0u, dense = 0u; bool uni = true;
#pragma unroll
      for (unsigned j = 0; j < 16; ++j) {
        const unsigned c = xb_ld(&bar[XB_XCNT(j)]);
        cnt += (c > 0u) ? 1u : 0u; mine = (j == xb.x) ? c : mine; dense += (j < xb.x && c > 0u) ? 1u : 0u;
        uni = uni && (c == 0u || c * 8u == G);
      }
      const unsigned rank = xb_words.z;
      xb_words.x = mine > 0u ? mine : 1u; xb_words.y = cnt > 0u ? cnt : 1u;
      xb_words.w = (uni && cnt == 8u && rank < (G >> 3)) ? dense * (G >> 3) + rank : (unsigned)__builtin_amdgcn_workgroup_id_x();
    }
    __syncthreads();
  }
#pragma unroll 1
  for (int step = 1; step < 29; ++step) {
    int ph, layer, idx;
    {
      const int s = step - 1;
      if (s < 6) { layer = 0; idx = s; } else if (s < 14) { layer = 1; idx = s - 6; } else if (s < 20) { layer = 2; idx = s - 14; } else { layer = 3; idx = s - 20; }
      if (layer & 1) ph = (idx < 5) ? (PH_RIN + idx) : (PH_FIN + idx - 5);
      else ph = (idx < 3) ? (PH_QKV + idx) : (PH_FIN + idx - 3);
    }
    Params q = p;
#pragma unroll
    for (int i = 0; i < 19; ++i) asm volatile("" : "+s"(q.in[i]));
    asm volatile("" : "+s"(q.out)); asm volatile("" : "+s"(q.ws));
    const int rep = ((PROBE_MASK >> ph) & 1) ? 2 : 1;
    const int vb = (int)xb_words.w;
    for (int rr = 0; rr < rep; ++rr) run_phase(q, ph, layer, lds, vb, PROBE_NOEPI && rr > 0, true);
    if (step < 28) xcd_barrier(xb);
  }
}
#endif

extern "C" void kernel_launch(void* const* d_in, const int* in_sizes, int n_in, void* d_out, int out_size, void* d_ws, size_t ws_size, hipStream_t stream) {
  static int grid_blocks = 0;
  if (!grid_blocks) {
    int dev = 0, cus = 0, per_cu = 0;
    (void)hipGetDevice(&dev);
    (void)hipDeviceGetAttribute(&cus, hipDeviceAttributeMultiprocessorCount, dev);
#if MEGA
    (void)hipOccupancyMaxActiveBlocksPerMultiprocessor(&per_cu, k_mega, 512, 0);
#else
    (void)hipOccupancyMaxActiveBlocksPerMultiprocessor(&per_cu, k_phase, 512, 0);
#endif
    if (per_cu < 1) per_cu = 1;
    if (per_cu > 1) per_cu = 1;
    grid_blocks = cus * per_cu;
    if (n_in != 19 || ws_size < WS_END) fprintf(stderr, "kernel_launch: unexpected n_in %d or ws %zu < %zu\n", n_in, ws_size, (size_t)WS_END);
  }
  Params p{};
  for (int i = 0; i < 19; ++i) p.in[i] = (const float*)d_in[i];
  p.out = (float*)d_out; p.ws = (unsigned char*)d_ws;
#if MEGA
  (void)hipMemsetAsync((unsigned char*)d_ws + WS_BAR, 0, 16384, stream);
  void* args[] = {&p};
  hipError_t e = hipLaunchCooperativeKernel((void*)k_mega, dim3(grid_blocks), dim3(512), args, 0, stream);
  if (e != hipSuccess) fprintf(stderr, "cooperative launch failed: %s (grid %d)\n", hipGetErrorString(e), grid_blocks);
#else
  auto L = [&](int ph, int layer) { hipLaunchKernelGGL(k_phase, dim3(grid_blocks), dim3(512), 0, stream, p, ph, layer); };
  L(PH_PREP, 0);
  for (int layer = 0; layer < 4; ++layer) {
    if ((layer & 1) == 0) { L(PH_QKV, layer); L(PH_ATTN, layer); L(PH_AO, layer); }
    else { L(PH_RIN, layer); L(PH_RETU, layer); L(PH_SCAN, layer); L(PH_RETO, layer); L(PH_RO, layer); }
    L(PH_LNM, layer); L(PH_FIN, layer); L(PH_CONV, layer); L(PH_FOUT, layer); L(PH_LNF, layer);
  }
#endif
}
```
